# Optimizing an MI355X kernel written in HIP

```python
import jax, jax.numpy as jnp
from jax import lax
import numpy as np

D_MODEL = 1024
BATCH = 8
SEQ = 2048
DEPTH = 2
DEC_BATCH = 128
DEC_SEQ = 1
PAST_LEN = 16384
PAGE_SIZE = 128

D_POOL = D_MODEL // 2
POOL_WINDOWS = (2, 4, 8, 16)
POOL_GROUPS = len(POOL_WINDOWS)
POOL_GW = D_POOL // POOL_GROUPS
POOL_STATE = max(POOL_WINDOWS) - 1
D_RNN = D_MODEL
RNN_HEADS = 8
RNN_HD = D_RNN // RNN_HEADS
CONV_WIDTH = 4
LRU_C = 8.0
D_CHUNK = D_MODEL // 2
CHUNK = 128
CHUNK_GROUPS = 4
CHUNK_GW = D_CHUNK // CHUNK_GROUPS
N_BRANCH = 3
D_FF = 3 * D_MODEL
FFN_CONV = 3
EPS = 1e-6
IN_COLS = D_POOL + 2 * D_RNN + 2 * D_CHUNK + N_BRANCH * D_MODEL
IN_SPLITS = (D_POOL, D_POOL + D_RNN, D_POOL + 2 * D_RNN, D_POOL + 2 * D_RNN + 2 * D_CHUNK)

kernel_name = 'hybrid_pool_rglru_chunkmlp_decode_step'


def rmsnorm(x, g):
    xf = x.astype(jnp.float32)
    y = xf * lax.rsqrt(jnp.mean(xf * xf, axis=-1, keepdims=True) + EPS)
    return (y * g.astype(jnp.float32)).astype(x.dtype)


def causal_dwconv(x_ext, w, b):
    c = x_ext.shape[-1]
    y = lax.conv_general_dilated(x_ext, w[:, None, :].astype(x_ext.dtype), window_strides=(1,),
                                 padding='VALID', dimension_numbers=('NWC', 'WIO', 'NWC'),
                                 feature_group_count=c)
    return y + b


def multiscale_pool(a_ext, pos, pool_w, pool_scale):
    bn, length, _ = a_ext.shape
    t = length - POOL_STATE
    af = a_ext.astype(jnp.float32)
    cs = jnp.concatenate([jnp.zeros((bn, 1, D_POOL), jnp.float32), jnp.cumsum(af, axis=1)], axis=1)
    hi = cs[:, POOL_STATE + 1:]
    lo = jnp.concatenate([cs[:, POOL_STATE + 1 - w: POOL_STATE + 1 - w + t, g * POOL_GW:(g + 1) * POOL_GW]
                          for g, w in enumerate(POOL_WINDOWS)], axis=-1)
    win = jnp.repeat(jnp.array(POOL_WINDOWS, jnp.int32), POOL_GW)
    cnt = jnp.minimum(pos[:, None] + 1, win[None, :]).astype(jnp.float32)
    d = (hi - lo) / cnt - af[:, POOL_STATE:]
    d = d.reshape(bn, t, POOL_GROUPS, POOL_GW)
    y = jnp.einsum('btgi,gij->btgj', d, pool_w.astype(jnp.float32)).reshape(bn, t, D_POOL)
    return (y * pool_scale.astype(jnp.float32)).astype(a_ext.dtype)


def block_diag(x, w, b):
    xh = x.reshape(*x.shape[:-1], RNN_HEADS, RNN_HD)
    return jnp.einsum('bthi,hij->bthj', xh, w).reshape(x.shape) + b


def _lin_combine(left, right):
    a_l, b_l = left
    a_r, b_r = right
    return a_l * a_r, a_r * b_l + b_r


def rg_lru(xc, h0, wa, ba, wx, bx, lam):
    r = jax.nn.sigmoid(block_diag(xc, wa, ba).astype(jnp.float32))
    i = jax.nn.sigmoid(block_diag(xc, wx, bx).astype(jnp.float32))
    log_a = -LRU_C * r * jax.nn.softplus(-lam.astype(jnp.float32))
    a = jnp.exp(log_a)
    b = jnp.sqrt(-jnp.expm1(2.0 * log_a)) * (i * xc.astype(jnp.float32))
    b = b.at[:, 0].add(a[:, 0] * h0.astype(jnp.float32))
    _, h = lax.associative_scan(_lin_combine, (a, b), axis=1)
    return h.astype(xc.dtype), h[:, -1].astype(xc.dtype)


def chunk_mlp(uv, vnorm_g, ws, bs):
    u, v = jnp.split(uv, 2, axis=-1)
    v = rmsnorm(v, vnorm_g)
    bn, t, _ = v.shape
    n_chunks = -(-t // CHUNK)
    tp = n_chunks * CHUNK
    vp = jnp.pad(v, ((0, 0), (0, tp - t), (0, 0))).reshape(bn, n_chunks, CHUNK, CHUNK_GROUPS, CHUNK_GW)
    mask = jnp.tril(jnp.ones((CHUNK, CHUNK), dtype=bool))
    ws_c = jnp.where(mask[None], ws, 0)
    mix = jnp.einsum('gij,bcjgd->bcigd', ws_c, vp) + jnp.swapaxes(bs, 0, 1)[:, :, None]
    mix = mix.reshape(bn, tp, D_CHUNK)[:, :t]
    return u * mix, v


def conv_ffn(xn, prefix, wg, wu, cw, cb, wd):
    g_pre = xn @ wg
    ext = jnp.concatenate([prefix.astype(g_pre.dtype), g_pre], axis=1)
    h = jax.nn.gelu(causal_dwconv(ext, cw, cb)) * (xn @ wu)
    return h @ wd, ext[:, -(FFN_CONV - 1):]


def decoder_layer(x, pos, pool_prefix, rconv_prefix, h0, ffn_prefix, lp):
    xn = rmsnorm(x, lp['norm1_g'])
    z = xn @ lp['w_in']
    a_in, b_x, b_gate, c_uv, gates = jnp.split(z, IN_SPLITS, axis=-1)
    a_ext = jnp.concatenate([pool_prefix.astype(a_in.dtype), a_in], axis=1)
    ya = multiscale_pool(a_ext, pos, lp['pool_w'], lp['pool_scale'])
    b_ext = jnp.concatenate([rconv_prefix.astype(b_x.dtype), b_x], axis=1)
    bc = causal_dwconv(b_ext, lp['rnn_conv_w'], lp['rnn_conv_b'])
    h, h_last = rg_lru(bc, h0, lp['lru_wa'], lp['lru_ba'], lp['lru_wx'], lp['lru_bx'], lp['lru_lambda'])
    yb = jax.nn.gelu(b_gate) * h
    yc, v_rows = chunk_mlp(jax.nn.gelu(c_uv), lp['chunk_vnorm_g'], lp['chunk_ws'], lp['chunk_bs'])
    ga, gb, gc = jnp.split(jax.nn.sigmoid(gates), N_BRANCH, axis=-1)
    merged = ga * (ya @ lp['w_pa']) + gb * (yb @ lp['w_pb']) + gc * (yc @ lp['w_pc'])
    x = x + merged @ lp['w_o']
    f, ffn_state = conv_ffn(rmsnorm(x, lp['norm2_g']), ffn_prefix, lp['ffn_wg'], lp['ffn_wu'],
                            lp['ffn_conv_w'], lp['ffn_conv_b'], lp['ffn_wd'])
    x = x + f
    return x, a_ext[:, -POOL_STATE:], b_ext[:, -(CONV_WIDTH - 1):], h_last, ffn_state, v_rows


def setup_inputs(seed: int = 0) -> dict:
    key = jax.random.key(seed)
    ks = jax.random.split(key, 40)
    f32 = jnp.float32

    def nrm(k, shape, scale):
        return jax.random.normal(k, shape, f32) * scale

    u = jax.random.uniform(ks[16], (DEPTH, D_RNN), f32, minval=0.9, maxval=0.999)
    s = u ** (1.0 / LRU_C)
    lam = jnp.log(s) - jnp.log1p(-s)
    return {
        'x_prompt': nrm(ks[0], (BATCH, SEQ, D_MODEL), 1.0),
        'x_sample': nrm(ks[1], (DEC_BATCH, DEC_SEQ, D_MODEL), 1.0),
        'state_pool': nrm(ks[2], (DEPTH, DEC_BATCH, POOL_STATE, D_POOL), 1.0),
        'state_rnn_conv': nrm(ks[3], (DEPTH, DEC_BATCH, CONV_WIDTH - 1, D_RNN), 1.0),
        'state_rnn_h': nrm(ks[4], (DEPTH, DEC_BATCH, D_RNN), 0.5),
        'state_ffn_conv': nrm(ks[5], (DEPTH, DEC_BATCH, FFN_CONV - 1, D_FF), 1.0),
        'norm1_g': 1.0 + nrm(ks[6], (DEPTH, D_MODEL), 0.05),
        'w_in': nrm(ks[7], (DEPTH, D_MODEL, IN_COLS), D_MODEL ** -0.5),
        'pool_w': nrm(ks[8], (DEPTH, POOL_GROUPS, POOL_GW, POOL_GW), POOL_GW ** -0.5),
        'pool_scale': 1.0 + nrm(ks[9], (DEPTH, D_POOL), 0.05),
        'rnn_conv_w': nrm(ks[10], (DEPTH, CONV_WIDTH, D_RNN), CONV_WIDTH ** -0.5),
        'rnn_conv_b': nrm(ks[11], (DEPTH, D_RNN), 0.01),
        'lru_wa': nrm(ks[12], (DEPTH, RNN_HEADS, RNN_HD, RNN_HD), RNN_HD ** -0.5),
        'lru_ba': nrm(ks[13], (DEPTH, D_RNN), 0.01),
        'lru_wx': nrm(ks[14], (DEPTH, RNN_HEADS, RNN_HD, RNN_HD), RNN_HD ** -0.5),
        'lru_bx': nrm(ks[15], (DEPTH, D_RNN), 0.01),
        'lru_lambda': lam,
        'chunk_vnorm_g': 1.0 + nrm(ks[17], (DEPTH, D_CHUNK), 0.05),
        'chunk_ws': nrm(ks[18], (DEPTH, CHUNK_GROUPS, CHUNK, CHUNK), CHUNK ** -0.5),
        'chunk_bs': 1.0 + nrm(ks[19], (DEPTH, CHUNK_GROUPS, CHUNK), 0.01),
        'w_pa': nrm(ks[20], (DEPTH, D_POOL, D_MODEL), D_POOL ** -0.5),
        'w_pb': nrm(ks[21], (DEPTH, D_RNN, D_MODEL), D_RNN ** -0.5),
        'w_pc': nrm(ks[22], (DEPTH, D_CHUNK, D_MODEL), D_CHUNK ** -0.5),
        'w_o': nrm(ks[23], (DEPTH, D_MODEL, D_MODEL), D_MODEL ** -0.5),
        'norm2_g': 1.0 + nrm(ks[24], (DEPTH, D_MODEL), 0.05),
        'ffn_wg': nrm(ks[25], (DEPTH, D_MODEL, D_FF), D_MODEL ** -0.5),
        'ffn_wu': nrm(ks[26], (DEPTH, D_MODEL, D_FF), D_MODEL ** -0.5),
        'ffn_conv_w': nrm(ks[27], (DEPTH, FFN_CONV, D_FF), FFN_CONV ** -0.5),
        'ffn_conv_b': nrm(ks[28], (DEPTH, D_FF), 0.01),
        'ffn_wd': nrm(ks[29], (DEPTH, D_FF, D_MODEL), D_FF ** -0.5),
        'final_norm_g': 1.0 + nrm(ks[30], (D_MODEL,), 0.05),
    }


def reference(x_prompt, x_sample, state_pool, state_rnn_conv, state_rnn_h, state_ffn_conv,
              norm1_g, w_in, pool_w, pool_scale, rnn_conv_w, rnn_conv_b, lru_wa, lru_ba, lru_wx, lru_bx,
              lru_lambda, chunk_vnorm_g, chunk_ws, chunk_bs, w_pa, w_pb, w_pc, w_o, norm2_g,
              ffn_wg, ffn_wu, ffn_conv_w, ffn_conv_b, ffn_wd, final_norm_g):
    bp, tp = x_prompt.shape[0], x_prompt.shape[1]
    ts = x_sample.shape[1]
    pos_p = jnp.arange(tp, dtype=jnp.int32)
    pos_s = PAST_LEN + jnp.arange(ts, dtype=jnp.int32)
    dt = x_prompt.dtype
    xp, xs = x_prompt, x_sample
    pool_p, pool_s, rc_p, rc_s, h_p, h_s, ff_p, ff_s, cv_s = [], [], [], [], [], [], [], [], []
    for l in range(DEPTH):
        lp = {'norm1_g': norm1_g[l], 'w_in': w_in[l], 'pool_w': pool_w[l], 'pool_scale': pool_scale[l],
              'rnn_conv_w': rnn_conv_w[l], 'rnn_conv_b': rnn_conv_b[l], 'lru_wa': lru_wa[l],
              'lru_ba': lru_ba[l], 'lru_wx': lru_wx[l], 'lru_bx': lru_bx[l], 'lru_lambda': lru_lambda[l],
              'chunk_vnorm_g': chunk_vnorm_g[l], 'chunk_ws': chunk_ws[l], 'chunk_bs': chunk_bs[l],
              'w_pa': w_pa[l], 'w_pb': w_pb[l], 'w_pc': w_pc[l], 'w_o': w_o[l], 'norm2_g': norm2_g[l],
              'ffn_wg': ffn_wg[l], 'ffn_wu': ffn_wu[l], 'ffn_conv_w': ffn_conv_w[l],
              'ffn_conv_b': ffn_conv_b[l], 'ffn_wd': ffn_wd[l]}
        xp, a1, b1, c1, d1, _ = decoder_layer(
            xp, pos_p, jnp.zeros((bp, POOL_STATE, D_POOL), dt), jnp.zeros((bp, CONV_WIDTH - 1, D_RNN), dt),
            jnp.zeros((bp, D_RNN), dt), jnp.zeros((bp, FFN_CONV - 1, D_FF), dt), lp)
        xs, a2, b2, c2, d2, v2 = decoder_layer(
            xs, pos_s, state_pool[l], state_rnn_conv[l], state_rnn_h[l], state_ffn_conv[l], lp)
        pool_p.append(a1); pool_s.append(a2)
        rc_p.append(b1); rc_s.append(b2)
        h_p.append(c1); h_s.append(c2)
        ff_p.append(d1); ff_s.append(d2)
        cv_s.append(v2)
    y_prompt = rmsnorm(xp, final_norm_g)
    y_sample = rmsnorm(xs, final_norm_g)
    return (y_prompt, y_sample,
            jnp.stack(pool_p), jnp.stack(pool_s),
            jnp.stack(rc_p), jnp.stack(rc_s),
            jnp.stack(h_p), jnp.stack(h_s),
            jnp.stack(ff_p), jnp.stack(ff_s),
            jnp.stack(cv_s))
```

```cpp
#include <hip/hip_runtime.h>
#include <hip/hip_cooperative_groups.h>
#include <cstdio>
#include <cstdint>
namespace cg = cooperative_groups;

#define LAS __attribute__((address_space(3)))
typedef unsigned short bf16_t;
typedef short bf16x8 __attribute__((ext_vector_type(8)));
typedef float f32x4 __attribute__((ext_vector_type(4)));
typedef float f32x2 __attribute__((ext_vector_type(2)));
typedef unsigned u32x4 __attribute__((ext_vector_type(4)));
typedef unsigned u32x2 __attribute__((ext_vector_type(2)));

constexpr int DM = 1024, NB = 8, SEQ = 2048, MPR = NB * SEQ, NS = 128, MROWS = MPR + NS, MPAD = 16640, NTM = MPAD / 256;
constexpr int DPOOL = 512, DRNN = 1024, DCH = 512, DFF = 3072, INCOLS = 6656, ZC = 3584;
constexpr int NLAYER = 2, PH_PER_LAYER = 13, NPH = NLAYER * PH_PER_LAYER + 1;
constexpr size_t O_Y = 0;
constexpr size_t O_POOL_P = (size_t)MROWS * DM;
constexpr size_t O_POOL_S = O_POOL_P + (size_t)2 * NB * 15 * DPOOL;
constexpr size_t O_RC_P = O_POOL_S + (size_t)2 * NS * 15 * DPOOL;
constexpr size_t O_RC_S = O_RC_P + (size_t)2 * NB * 3 * DRNN;
constexpr size_t O_H_P = O_RC_S + (size_t)2 * NS * 3 * DRNN;
constexpr size_t O_H_S = O_H_P + (size_t)2 * NB * DRNN;
constexpr size_t O_FF_P = O_H_S + (size_t)2 * NS * DRNN;
constexpr size_t O_FF_S = O_FF_P + (size_t)2 * NB * 2 * DFF;
constexpr size_t O_CV_S = O_FF_S + (size_t)2 * NS * 2 * DFF;
constexpr size_t UE = (size_t)MPAD * 512, UB = UE * 2;
constexpr size_t WS_SP = 4096;
constexpr size_t WS_XN = 1u << 20;
constexpr size_t WS_Z = WS_XN + 2 * UB;
constexpr size_t WS_Y = WS_Z + 7 * UB;
constexpr size_t WS_W = WS_Y + 4 * UB;
constexpr size_t WS_H = WS_Z + 6 * UB;
constexpr size_t W_IN = 0;
constexpr size_t W_PA = W_IN + (size_t)INCOLS * DM;
constexpr size_t W_PB = W_PA + (size_t)DM * DPOOL;
constexpr size_t W_PC = W_PB + (size_t)DM * DRNN;
constexpr size_t W_O = W_PC + (size_t)DM * DCH;
constexpr size_t W_G = W_O + (size_t)DM * DM;
constexpr size_t W_U = W_G + (size_t)DFF * DM;
constexpr size_t W_D = W_U + (size_t)DFF * DM;
constexpr size_t W_RI = W_D + (size_t)DM * DFF;
constexpr size_t W_END = W_RI + (size_t)8 * 256 * 256;
constexpr size_t WS_END = WS_W + W_END * 2;
static_assert(WS_END <= (256u << 20), "workspace");
static_assert(WS_H + 6 * UB <= WS_W + (W_G)*2, "h overlay must not reach wg/wu/wd");
constexpr int LDS_BYTES = 131072 + 2048;

struct Params { const float* in[31]; float* out; unsigned char* ws; int ph_lo, ph_hi; };

__device__ __forceinline__ float bf_lo(unsigned w) { return __builtin_bit_cast(float, w << 16); }
__device__ __forceinline__ float bf_hi(unsigned w) { return __builtin_bit_cast(float, w & 0xffff0000u); }
__device__ __forceinline__ float bf2f(bf16_t b) { return __builtin_bit_cast(float, (unsigned)b << 16); }
typedef __bf16 bf16x2_t __attribute__((ext_vector_type(2)));
__device__ __forceinline__ unsigned pk2(float lo, float hi) { f32x2 v = {lo, hi}; bf16x2_t b = __builtin_convertvector(v, bf16x2_t); return __builtin_bit_cast(unsigned, b); }
__device__ __forceinline__ bf16_t f2bf(float f) { return (bf16_t)(pk2(f, 0.f) & 0xffffu); }
struct F8 { f32x4 a, b; };
__device__ __forceinline__ F8 unpack8(u32x4 w) { F8 r; r.a[0] = bf_lo(w.x); r.a[1] = bf_hi(w.x); r.a[2] = bf_lo(w.y); r.a[3] = bf_hi(w.y); r.b[0] = bf_lo(w.z); r.b[1] = bf_hi(w.z); r.b[2] = bf_lo(w.w); r.b[3] = bf_hi(w.w); return r; }
__device__ __forceinline__ u32x4 pack8(f32x4 a, f32x4 b) { u32x4 w; w.x = pk2(a[0], a[1]); w.y = pk2(a[2], a[3]); w.z = pk2(b[0], b[1]); w.w = pk2(b[2], b[3]); return w; }
__device__ __forceinline__ float gelu_t(float x) {
    const float u = 0.7978845608f * (x + 0.044715f * x * x * x);
    const float e = __builtin_amdgcn_exp2f(-2.885390082f * u);
    return x * __builtin_amdgcn_rcpf(1.f + e);
}
__device__ __forceinline__ f32x4 gelu4(f32x4 v) { f32x4 r; r[0] = gelu_t(v[0]); r[1] = gelu_t(v[1]); r[2] = gelu_t(v[2]); r[3] = gelu_t(v[3]); return r; }
__device__ __forceinline__ float sigm(float x) { return __builtin_amdgcn_rcpf(1.f + __builtin_amdgcn_exp2f(-1.442695041f * x)); }
__device__ __forceinline__ f32x4 sigm4(f32x4 v) { f32x4 r; r[0] = sigm(v[0]); r[1] = sigm(v[1]); r[2] = sigm(v[2]); r[3] = sigm(v[3]); return r; }
__device__ __forceinline__ float wave_sum(float v) {
#pragma unroll
    for (int o = 1; o < 64; o <<= 1) v += __shfl_xor(v, o);
    return v;
}

namespace pg8 {
constexpr int BM = 256, BK = 64, HALF = 128, HTB = HALF * BK * 2, STAGE_BYTES = 8 * HTB, NXCD = 8, WGM = 8;
__device__ __forceinline__ int lds_byte(int r, int c) { const int st = (r >> 4) * 2 + (c >> 5), rr = r & 15, cc = c & 31, ob = rr * 64 + cc * 2; return st * 1024 + (ob ^ (((ob >> 9) & 1) << 5)); }
__device__ __forceinline__ void stage_rc(int b, int& R, int& C) { const int st = b / 1024, sb = b % 1024, swz = sb ^ (((sb >> 9) & 1) << 5); R = (st >> 1) * 16 + swz / 64; C = (st & 1) * 32 + (swz % 64) / 2; }
__device__ __forceinline__ int perm32(int rho) { const int n = rho >> 4, i = rho & 15; return 8 * (i >> 2) + 4 * n + (i & 3); }

struct Unit { int pm, pn, ka; };
struct Gemm { const bf16_t* A; const bf16_t* Bt; int lda, ldb, K; };

struct Order {
    int nM, nN, nwg, G, c, mode;
    __device__ __forceinline__ void init(int nM_, int nN_, int G_, int c_, int mode_) { nM = nM_; nN = nN_; nwg = nM * nN; G = G_; c = c_; mode = mode_; }
    __device__ __forceinline__ bool next(int i, Unit& u) const {
        const long L = (long)i * G + c; if (L >= nwg) return false;
        int wgid = (int)L; { const int q = nwg / NXCD, r = nwg % NXCD, xcd = wgid % NXCD, off = wgid / NXCD; wgid = (xcd < r ? xcd * (q + 1) : r * (q + 1) + (xcd - r) * q) + off; }
        const int nig = WGM * nN, gid = wgid / nig, fm = gid * WGM, gsz = (nM - fm) < WGM ? (nM - fm) : WGM;
        u.pm = fm + ((wgid % nig) % gsz); u.pn = (wgid % nig) / gsz; u.ka = mode ? ((u.pn & ~1) * 128) : 0; return true;
    }
};

template <class Epi>
__device__ __forceinline__ void gemm_phase(LAS unsigned char* lds, const Gemm g, const Order& S, const Epi& E) {
    int tid = threadIdx.x; asm volatile("" : "+v"(tid));
    const int wid = __builtin_amdgcn_readfirstlane(tid >> 6), lane = tid & 63, wr = wid >> 2, wc = wid & 3, fr = lane & 15, fq = lane >> 4;
    const int K = g.K, nt = K / BK;
    unsigned voffA[2], voffB[2];
#pragma unroll
    for (int i = 0; i < 2; ++i) { int R, C; stage_rc(tid * 16 + i * 8192, R, C); const int Rb = Epi::PERM ? ((R & ~31) + perm32(R & 31)) : R;
        voffA[i] = (unsigned)(R * g.lda + C) * 2u; voffB[i] = (unsigned)(Rb * g.ldb + C) * 2u; }
    const size_t kstep = (size_t)(BK * 2);
    const size_t hstepA = (size_t)HALF * g.lda * 2, tstepA = 2 * hstepA;
    const size_t hstepB = (size_t)HALF * g.ldb * 2, tstepB = 2 * hstepB;
    const unsigned ldsw = (unsigned)wid * 1024u;
    const int aoff = lds_byte(wr * 64 + fr, fq * 8), boff = lds_byte(wc * 32 + fr, fq * 8);
#define PG8_SA(b, h) (((b) * 2 + (h)) * HTB)
#define PG8_SB(b, h) ((4 + (b) * 2 + (h)) * HTB)
#define PG8_STAGE(bufoff, gbase, voff) do { _Pragma("unroll") for (int _i = 0; _i < 2; ++_i) \
        __builtin_amdgcn_global_load_lds((const unsigned*)((const char*)(gbase) + (voff)[_i]), (LAS unsigned*)(lds + (bufoff) + ldsw + _i * 8192), 16, 0, 0); } while (0)
#define PG8_LDA(dst, b, h) do { _Pragma("unroll") for (int m = 0; m < 4; ++m) _Pragma("unroll") for (int k = 0; k < 2; ++k) dst[m][k] = *(const LAS bf16x8*)(lds + PG8_SA(b, h) + aoff + m * 2048 + k * 1024); } while (0)
#define PG8_LDB(dst, b, h) do { _Pragma("unroll") for (int n = 0; n < 2; ++n) _Pragma("unroll") for (int k = 0; k < 2; ++k) dst[n][k] = *(const LAS bf16x8*)(lds + PG8_SB(b, h) + boff + n * 2048 + k * 1024); } while (0)
#define PG8_MMA(ai, bj, At, Bt) do { __builtin_amdgcn_s_setprio(1); _Pragma("unroll") for (int m = 0; m < 4; ++m) _Pragma("unroll") for (int n = 0; n < 2; ++n) _Pragma("unroll") for (int k = 0; k < 2; ++k) \
        acc[ai][bj][m][n] = __builtin_amdgcn_mfma_f32_16x16x32_bf16(Bt[n][k], At[m][k], acc[ai][bj][m][n], 0, 0, 0); __builtin_amdgcn_s_setprio(0); } while (0)
#define PG8_WAIT_V(n) asm volatile("s_waitcnt vmcnt(" #n ")" ::: "memory")
#define PG8_WAIT_L(n) asm volatile("s_waitcnt lgkmcnt(" #n ")" ::: "memory")
#define PG8_BAR __builtin_amdgcn_s_barrier()
#define PG8_SCHED __builtin_amdgcn_sched_barrier(0)
    Unit cur, nxt; int ui = 0;
    if (!S.next(0, cur)) return;
    f32x4 acc[2][2][4][2];
#pragma unroll
    for (int a = 0; a < 2; ++a)
#pragma unroll
        for (int b = 0; b < 2; ++b)
#pragma unroll
            for (int m = 0; m < 4; ++m)
#pragma unroll
                for (int n = 0; n < 2; ++n) acc[a][b][m][n] = (f32x4){0.f, 0.f, 0.f, 0.f};
    bf16x8 At[4][2], B0[2][2], B1[2][2];
    const char* cA = (const char*)g.A + (size_t)cur.pm * tstepA + (size_t)cur.ka * 2; const char* cB = (const char*)g.Bt + (size_t)cur.pn * tstepB;
    PG8_STAGE(PG8_SB(0, 0), cB, voffB); PG8_STAGE(PG8_SB(0, 1), cB + hstepB, voffB); PG8_STAGE(PG8_SA(0, 0), cA, voffA); PG8_STAGE(PG8_SA(0, 1), cA + hstepA, voffA);
    if (wr == 1) PG8_BAR;
    PG8_WAIT_V(2); PG8_BAR;
    PG8_STAGE(PG8_SB(1, 0), cB + kstep, voffB); PG8_STAGE(PG8_SA(1, 0), cA + kstep, voffA); PG8_STAGE(PG8_SB(1, 1), cB + hstepB + kstep, voffB);
    PG8_WAIT_V(6); PG8_BAR;
    for (;;) {
        const bool has_next = S.next(ui + 1, nxt);
        const char* nA = has_next ? (const char*)g.A + (size_t)nxt.pm * tstepA + (size_t)nxt.ka * 2 : cA; const char* nB = has_next ? (const char*)g.Bt + (size_t)nxt.pn * tstepB : cB;
#pragma unroll 1
        for (int t = 0; t < nt; t += 2) {
            const bool last = (t == nt - 2);
            const char* a1 = cA + (size_t)(t + 1) * kstep;
            const char* a2 = last ? nA : cA + (size_t)(t + 2) * kstep; const char* b2 = last ? nB : cB + (size_t)(t + 2) * kstep;
            const char* a3 = a2 + kstep; const char* b3 = b2 + kstep;
            PG8_LDB(B0, 0, 0); PG8_LDB(B1, 0, 1); PG8_SCHED; PG8_LDA(At, 0, 0); PG8_STAGE(PG8_SA(1, 1), a1 + hstepA, voffA);
            PG8_WAIT_V(8); PG8_WAIT_L(0); PG8_BAR; PG8_MMA(0, 0, At, B0); PG8_MMA(0, 1, At, B1); PG8_BAR; PG8_SCHED;
            PG8_LDA(At, 0, 1); PG8_STAGE(PG8_SB(0, 0), b2, voffB); PG8_STAGE(PG8_SB(0, 1), b2 + hstepB, voffB); PG8_STAGE(PG8_SA(0, 0), a2, voffA);
            PG8_WAIT_V(8); PG8_WAIT_L(0); PG8_BAR; PG8_MMA(1, 0, At, B0); PG8_MMA(1, 1, At, B1); PG8_BAR; PG8_SCHED;
            PG8_LDB(B0, 1, 0); PG8_LDB(B1, 1, 1); PG8_SCHED; PG8_LDA(At, 1, 0); PG8_STAGE(PG8_SA(0, 1), a2 + hstepA, voffA);
            PG8_WAIT_V(8); PG8_WAIT_L(0); PG8_BAR; PG8_MMA(0, 0, At, B0); PG8_MMA(0, 1, At, B1); PG8_BAR; PG8_SCHED;
            PG8_LDA(At, 1, 1); PG8_STAGE(PG8_SB(1, 0), b3, voffB); PG8_STAGE(PG8_SB(1, 1), b3 + hstepB, voffB); PG8_STAGE(PG8_SA(1, 0), a3, voffA);
            PG8_WAIT_V(8); PG8_WAIT_L(0); PG8_BAR; PG8_MMA(1, 0, At, B0); PG8_MMA(1, 1, At, B1); PG8_BAR; PG8_SCHED;
        }
        if (wr == 0) PG8_BAR;
        { int fr2 = fr, fq2 = fq; asm volatile("" : "+v"(fr2), "+v"(fq2));
          E(acc, cur, wr, wc, fr2, fq2); }
        if (!has_next) break;
#pragma unroll
        for (int a = 0; a < 2; ++a)
#pragma unroll
            for (int b = 0; b < 2; ++b)
#pragma unroll
                for (int m = 0; m < 4; ++m)
#pragma unroll
                    for (int n = 0; n < 2; ++n) acc[a][b][m][n] = (f32x4){0.f, 0.f, 0.f, 0.f};
        cur = nxt; cA = nA; cB = nB; ++ui;
        if (wr == 1) PG8_BAR;
    }
    PG8_WAIT_V(0);
    PG8_BAR;
#undef PG8_SA
#undef PG8_SB
#undef PG8_STAGE
#undef PG8_LDA
#undef PG8_LDB
#undef PG8_MMA
#undef PG8_WAIT_V
#undef PG8_WAIT_L
#undef PG8_BAR
#undef PG8_SCHED
}
}
using pg8::Unit;

#define EPI_ARGS const f32x4 (&acc)[2][2][4][2], const Unit& u, int wr, int wc, int fr, int fq
struct EpiZ {
    static constexpr bool PERM = true;
    bf16_t* Z; float* out; int l;
    __device__ __forceinline__ void operator()(EPI_ARGS) const {
        const int pn = u.pn; bf16_t* base; int ld, ct; bool act;
        if (pn < 2) { base = Z; ld = 512; ct = pn * 256; act = false; }
        else if (pn < 6) { base = Z + UE; ld = 1024; ct = (pn - 2) * 256; act = false; }
        else if (pn < 10) { base = Z + 3 * UE; ld = 1024; ct = (pn - 6) * 256; act = true; }
        else if (pn < 12) { base = Z + 5 * UE; ld = 512; ct = (pn - 10) * 256; act = true; }
        else { base = Z + 6 * UE; ld = 512; ct = (pn - 12) * 256; act = true; }
        const bool st = (pn < 6) && (((u.pm & 7) == 7) || u.pm == 64);
#pragma unroll
        for (int ai = 0; ai < 2; ++ai)
#pragma unroll
            for (int m = 0; m < 4; ++m) {
                const int row = u.pm * 256 + ai * 128 + wr * 64 + m * 16 + fr;
#pragma unroll
                for (int bj = 0; bj < 2; ++bj) {
                    f32x4 v0 = acc[ai][bj][m][0], v1 = acc[ai][bj][m][1];
                    const int c = ct + bj * 128 + wc * 32 + 8 * fq;
                    if (st) {
                        float* o = nullptr;
                        if (row < MPR) { const int t = row & 2047, b = row >> 11;
                            if (pn < 2) { if (t >= 2033) o = out + O_POOL_P + ((size_t)(l * NB + b) * 15 + (t - 2033)) * DPOOL + c; }
                            else { if (t >= 2045) o = out + O_RC_P + ((size_t)(l * NB + b) * 3 + (t - 2045)) * DRNN + c; } }
                        else if (row < MROWS) { const int s = row - MPR;
                            if (pn < 2) o = out + O_POOL_S + ((size_t)(l * NS + s) * 15 + 14) * DPOOL + c;
                            else o = out + O_RC_S + ((size_t)(l * NS + s) * 3 + 2) * DRNN + c; }
                        if (o) { *(f32x4*)o = v0; *(f32x4*)(o + 4) = v1; }
                    }
                    if (act) { v0 = gelu4(v0); v1 = gelu4(v1); }
                    *(u32x4*)(base + (size_t)row * ld + c) = pack8(v0, v1);
                    asm volatile("" ::: "memory");
                }
            }
    }
};
struct EpiRI {
    static constexpr bool PERM = true;
    const bf16_t* BC; bf16_t* LA; bf16_t* BV; const float* ba; const float* bx; const float* sp;
    __device__ __forceinline__ void operator()(EPI_ARGS) const {
        const int ch = u.pn * 128 + wc * 32 + 8 * fq;
#pragma unroll
        for (int n = 0; n < 2; ++n) {
            const f32x4 ba0 = *(const f32x4*)(ba + ch + 4 * n), bx0 = *(const f32x4*)(bx + ch + 4 * n), sp0 = *(const f32x4*)(sp + ch + 4 * n);
#pragma unroll
            for (int ai = 0; ai < 2; ++ai)
#pragma unroll
                for (int m = 0; m < 4; ++m) {
                    const int row = u.pm * 256 + ai * 128 + wr * 64 + m * 16 + fr;
                    const u32x2 xw = *(const u32x2*)(BC + (size_t)row * DRNN + ch + 4 * n);
                    const f32x4 xc = (f32x4){bf_lo(xw.x), bf_hi(xw.x), bf_lo(xw.y), bf_hi(xw.y)};
                    const f32x4 r0 = sigm4(acc[ai][0][m][n] + ba0), i0 = sigm4(acc[ai][1][m][n] + bx0);
                    const f32x4 la0 = r0 * sp0; f32x4 b0;
#pragma unroll
                    for (int j = 0; j < 4; ++j) { const float x = -2.f * la0[j];
                        const float em = x < 0.03f ? x * (1.f - x * (0.5f - x * (0.16666667f - x * 0.041666668f))) : 1.f - __expf(-x);
                        b0[j] = __builtin_sqrtf(em) * i0[j] * xc[j]; }
                    u32x2 wl, wb; wl.x = pk2(la0[0], la0[1]); wl.y = pk2(la0[2], la0[3]); wb.x = pk2(b0[0], b0[1]); wb.y = pk2(b0[2], b0[3]);
                    *(u32x2*)(LA + (size_t)row * DRNN + ch + 4 * n) = wl;
                    *(u32x2*)(BV + (size_t)row * DRNN + ch + 4 * n) = wb;
                    asm volatile("" ::: "memory");
                }
        }
    }
};
struct EpiG {
    static constexpr bool PERM = true;
    bf16_t* G;
    __device__ __forceinline__ void operator()(EPI_ARGS) const {
#pragma unroll
        for (int ai = 0; ai < 2; ++ai)
#pragma unroll
            for (int m = 0; m < 4; ++m) {
                const int row = u.pm * 256 + ai * 128 + wr * 64 + m * 16 + fr;
#pragma unroll
                for (int bj = 0; bj < 2; ++bj) {
                    const int c = u.pn * 256 + bj * 128 + wc * 32 + 8 * fq;
                    *(u32x4*)(G + (size_t)row * 3072 + c) = pack8(sigm4(acc[ai][bj][m][0]), sigm4(acc[ai][bj][m][1]));
                    asm volatile("" ::: "memory");
                }
            }
    }
};
struct EpiP {
    static constexpr bool PERM = true;
    bf16_t* G; int goff;
    __device__ __forceinline__ void operator()(EPI_ARGS) const {
#pragma unroll
        for (int ai = 0; ai < 2; ++ai)
#pragma unroll
            for (int m = 0; m < 4; ++m) {
                const int row = u.pm * 256 + ai * 128 + wr * 64 + m * 16 + fr;
#pragma unroll
                for (int bj = 0; bj < 2; ++bj) {
                    const int c = goff + u.pn * 256 + bj * 128 + wc * 32 + 8 * fq;
                    u32x4* p = (u32x4*)(G + (size_t)row * 3072 + c);
                    const F8 gt = unpack8(*p);
                    *p = pack8(gt.a * acc[ai][bj][m][0], gt.b * acc[ai][bj][m][1]);
                    asm volatile("" ::: "memory");
                }
            }
    }
};
struct EpiX {
    static constexpr bool PERM = false;
    const float* xin_p; const float* xin_s; float* xout;
    __device__ __forceinline__ void operator()(EPI_ARGS) const {
#pragma unroll
        for (int ai = 0; ai < 2; ++ai)
#pragma unroll
            for (int m = 0; m < 4; ++m) {
                const int row = u.pm * 256 + ai * 128 + wr * 64 + m * 16 + fr;
                if (row < MROWS) {
                    const float* src = row < MPR ? xin_p + (size_t)row * DM : xin_s + (size_t)(row - MPR) * DM;
                    float* dst = xout + (size_t)row * DM;
#pragma unroll
                    for (int bj = 0; bj < 2; ++bj)
#pragma unroll
                        for (int n = 0; n < 2; ++n) {
                            const int c = u.pn * 256 + bj * 128 + wc * 32 + 16 * n + 4 * fq;
                            *(f32x4*)(dst + c) = *(const f32x4*)(src + c) + acc[ai][bj][m][n];
                        }
                    asm volatile("" ::: "memory");
                }
            }
    }
};
struct EpiGpre {
    static constexpr bool PERM = true;
    bf16_t* GP; float* out; int l;
    __device__ __forceinline__ void operator()(EPI_ARGS) const {
        const bool st = ((u.pm & 7) == 7) || u.pm == 64;
#pragma unroll
        for (int ai = 0; ai < 2; ++ai)
#pragma unroll
            for (int m = 0; m < 4; ++m) {
                const int row = u.pm * 256 + ai * 128 + wr * 64 + m * 16 + fr;
#pragma unroll
                for (int bj = 0; bj < 2; ++bj) {
                    const f32x4 v0 = acc[ai][bj][m][0], v1 = acc[ai][bj][m][1];
                    const int c = u.pn * 256 + bj * 128 + wc * 32 + 8 * fq;
                    if (st) {
                        float* o = nullptr;
                        if (row < MPR) { const int t = row & 2047, b = row >> 11; if (t >= 2046) o = out + O_FF_P + ((size_t)(l * NB + b) * 2 + (t - 2046)) * DFF + c; }
                        else if (row < MROWS) { const int s = row - MPR; o = out + O_FF_S + ((size_t)(l * NS + s) * 2 + 1) * DFF + c; }
                        if (o) { *(f32x4*)o = v0; *(f32x4*)(o + 4) = v1; }
                    }
                    *(u32x4*)(GP + (size_t)row * 3072 + c) = pack8(v0, v1);
                    asm volatile("" ::: "memory");
                }
            }
    }
};
struct EpiH {
    static constexpr bool PERM = true;
    const bf16_t* GP; bf16_t* H; const float* cw; const float* cb; const float* st;
    __device__ __forceinline__ void operator()(EPI_ARGS) const {
#pragma unroll
        for (int bj = 0; bj < 2; ++bj) {
            const int c = u.pn * 256 + bj * 128 + wc * 32 + 8 * fq;
            const f32x4 w00 = *(const f32x4*)(cw + c), w01 = *(const f32x4*)(cw + c + 4);
            const f32x4 w10 = *(const f32x4*)(cw + DFF + c), w11 = *(const f32x4*)(cw + DFF + c + 4);
            const f32x4 w20 = *(const f32x4*)(cw + 2 * DFF + c), w21 = *(const f32x4*)(cw + 2 * DFF + c + 4);
            const f32x4 cb0 = *(const f32x4*)(cb + c), cb1 = *(const f32x4*)(cb + c + 4);
#pragma unroll
            for (int ai = 0; ai < 2; ++ai)
#pragma unroll
                for (int m = 0; m < 4; ++m) {
                    const int row = u.pm * 256 + ai * 128 + wr * 64 + m * 16 + fr;
                    const F8 g0 = unpack8(*(const u32x4*)(GP + (size_t)row * 3072 + c));
                    f32x4 s0 = cb0 + w20 * g0.a, s1 = cb1 + w21 * g0.b;
                    if (row < MPR) { const int t = row & 2047;
                        if (t >= 1) { const F8 g1 = unpack8(*(const u32x4*)(GP + (size_t)(row - 1) * 3072 + c)); s0 += w10 * g1.a; s1 += w11 * g1.b; }
                        if (t >= 2) { const F8 g2 = unpack8(*(const u32x4*)(GP + (size_t)(row - 2) * 3072 + c)); s0 += w00 * g2.a; s1 += w01 * g2.b; } }
                    else if (row < MROWS) { const float* sp = st + (size_t)(row - MPR) * 2 * DFF + c;
                        s0 += w00 * *(const f32x4*)sp + w10 * *(const f32x4*)(sp + DFF); s1 += w01 * *(const f32x4*)(sp + 4) + w11 * *(const f32x4*)(sp + DFF + 4); }
                    *(u32x4*)(H + (size_t)row * 3072 + c) = pack8(gelu4(s0) * acc[ai][bj][m][0], gelu4(s1) * acc[ai][bj][m][1]);
                    asm volatile("" ::: "memory");
                }
        }
    }
};

__device__ __forceinline__ void transpose_item(const float* W, int K, int N, bf16_t* WT, LAS float* scr, int item, int lane) {
    const int nblk = N / 32, kb = item / nblk, nb = item % nblk, k0 = 64 * kb, n0 = 32 * nb;
#pragma unroll 8
    for (int i = 0; i < 32; ++i) { const int kk = 2 * i + (lane >> 5); scr[kk * 33 + (lane & 31)] = W[(size_t)(k0 + kk) * N + n0 + (lane & 31)]; }
    asm volatile("s_waitcnt lgkmcnt(0)" ::: "memory");
    const int c = lane & 7;
#pragma unroll
    for (int j = 0; j < 4; ++j) { const int n = (lane >> 3) + 8 * j; const LAS float* s = scr + (8 * c) * 33 + n;
        u32x4 o; o.x = pk2(s[0 * 33], s[1 * 33]); o.y = pk2(s[2 * 33], s[3 * 33]); o.z = pk2(s[4 * 33], s[5 * 33]); o.w = pk2(s[6 * 33], s[7 * 33]);
        *(u32x4*)(WT + (size_t)(n0 + n) * K + k0 + 8 * c) = o; }
    asm volatile("s_waitcnt lgkmcnt(0)" ::: "memory");
}
__device__ __forceinline__ void rms_row_bf16(const float* xrow, const float* g, bf16_t* orow, int lane) {
    const f32x4* xr = (const f32x4*)xrow + lane; f32x4 v[4]; float s = 0.f;
#pragma unroll
    for (int j = 0; j < 4; ++j) { v[j] = xr[64 * j]; s += (v[j][0] * v[j][0] + v[j][1] * v[j][1]) + (v[j][2] * v[j][2] + v[j][3] * v[j][3]); }
    const float rstd = rsqrtf(wave_sum(s) * (1.f / DM) + 1e-6f);
    const f32x4* gr = (const f32x4*)g + lane; u32x2* o8 = (u32x2*)orow + lane;
#pragma unroll
    for (int j = 0; j < 4; ++j) { const f32x4 o = v[j] * rstd * gr[64 * j]; u32x2 w; w.x = pk2(o[0], o[1]); w.y = pk2(o[2], o[3]); o8[64 * j] = w; }
}
__device__ __forceinline__ void rms_rows(const float* xp, const float* xs, const float* g, bf16_t* XN, int gw, int ngw, int lane) {
    for (int row = gw; row < MPAD; row += ngw) {
        if (row < MROWS) rms_row_bf16(row < MPR ? xp + (size_t)row * DM : xs + (size_t)(row - MPR) * DM, g, XN + (size_t)row * DM, lane);
        else { u32x2* o8 = (u32x2*)(XN + (size_t)row * DM) + lane; u32x2 z; z.x = 0u; z.y = 0u;
#pragma unroll
            for (int j = 0; j < 4; ++j) o8[64 * j] = z; }
    }
}

__device__ __forceinline__ void phase_prep(const Params& p, int l, LAS unsigned char* lds, const float* xp, const float* xs, int bid, int G) {
    int tid = threadIdx.x; asm volatile("" : "+v"(tid));
    const int wave = tid >> 6, lane = tid & 63;
    const int gw = bid * 8 + wave, ngw = G * 8;
    bf16_t* W = (bf16_t*)(p.ws + WS_W);
    LAS float* scr = (LAS float*)(lds + wave * 8448);
    const float* w_in = p.in[7] + (size_t)l * DM * INCOLS; const float* w_pb = p.in[21] + (size_t)l * DRNN * DM; const float* w_pc = p.in[22] + (size_t)l * DCH * DM;
    const float* w_o = p.in[23] + (size_t)l * DM * DM; const float* wg = p.in[25] + (size_t)l * DM * DFF; const float* wu = p.in[26] + (size_t)l * DM * DFF; const float* wd = p.in[29] + (size_t)l * DFF * DM;
    constexpr int I_IN = (DM / 64) * (INCOLS / 32), I_PB = (DRNN / 64) * (DM / 32), I_PC = (DCH / 64) * (DM / 32), I_O = (DM / 64) * (DM / 32), I_G = (DM / 64) * (DFF / 32), I_D = (DFF / 64) * (DM / 32);
    constexpr int NITEMS = I_IN + I_PB + I_PC + I_O + 2 * I_G + I_D;
    for (int it = gw; it < NITEMS; it += ngw) {
        int r = it;
        if (r < I_IN) { transpose_item(w_in, DM, INCOLS, W + W_IN, scr, r, lane); continue; } r -= I_IN;
        if (r < I_PB) { transpose_item(w_pb, DRNN, DM, W + W_PB, scr, r, lane); continue; } r -= I_PB;
        if (r < I_PC) { transpose_item(w_pc, DCH, DM, W + W_PC, scr, r, lane); continue; } r -= I_PC;
        if (r < I_O) { transpose_item(w_o, DM, DM, W + W_O, scr, r, lane); continue; } r -= I_O;
        if (r < I_G) { transpose_item(wg, DM, DFF, W + W_G, scr, r, lane); continue; } r -= I_G;
        if (r < I_G) { transpose_item(wu, DM, DFF, W + W_U, scr, r, lane); continue; } r -= I_G;
        transpose_item(wd, DFF, DM, W + W_D, scr, r, lane);
    }
    const int gt = bid * 512 + tid, ngt = G * 512;
    { const float* pw = p.in[8] + (size_t)l * 4 * 128 * 128; const float* ps = p.in[9] + (size_t)l * DPOOL; const float* w_pa = p.in[20] + (size_t)l * DPOOL * DM;
      for (int idx = gt; idx < DPOOL * DM; idx += ngt) { const int n = idx & 1023, kp = idx >> 10, g = kp >> 7;
          const float* pr = pw + (size_t)kp * 128; const float* sr = ps + g * 128; const float* wr_ = w_pa + (size_t)g * 128 * DM + n; float s = 0.f;
#pragma unroll 8
          for (int j = 0; j < 128; ++j) s += pr[j] * sr[j] * wr_[(size_t)j * DM];
          W[W_PA + (size_t)n * DPOOL + kp] = f2bf(s); } }
    { const float* wa = p.in[12] + (size_t)l * 8 * 128 * 128; const float* wx = p.in[14] + (size_t)l * 8 * 128 * 128;
      for (int idx = gt; idx < 8 * 256 * 256; idx += ngt) { const int k = idx & 255, n = (idx >> 8) & 255, h = idx >> 16; float v = 0.f;
          if ((k >> 7) == (h & 1)) v = (n < 128 ? wa : wx)[((size_t)h * 128 + (k & 127)) * 128 + (n & 127)];
          W[W_RI + idx] = f2bf(v); } }
    if (gt < DRNN) ((float*)(p.ws + WS_SP))[gt] = -8.f * log1pf(__expf(-p.in[16][(size_t)l * DRNN + gt]));
    rms_rows(xp, xs, p.in[6] + (size_t)l * DM, (bf16_t*)(p.ws + WS_XN), gw, ngw, lane);
}

__device__ __forceinline__ void phase_mix(const Params& p, int l, LAS unsigned char* lds, int bid, int G) {
    int tid = threadIdx.x; asm volatile("" : "+v"(tid));
    const int wave = tid >> 6, lane = tid & 63;
    const bf16_t* Za = (const bf16_t*)(p.ws + WS_Z); const bf16_t* Zbx = Za + UE; const bf16_t* Zgu = Za + 5 * UE; const bf16_t* Zgv = Za + 6 * UE;
    bf16_t* Y0 = (bf16_t*)(p.ws + WS_Y); bf16_t* Yd = Y0 + 2 * UE; bf16_t* Yc = Y0 + 3 * UE;
    const float* vg = p.in[17] + (size_t)l * DCH; const float* cws = p.in[18] + (size_t)l * 4 * 128 * 128; const float* cbs = p.in[19] + (size_t)l * 4 * 128;
    if (bid < 128) {
        const int r0 = bid * 128;
        LAS float* rstd = (LAS float*)lds; LAS bf16_t* VT = (LAS bf16_t*)(lds + 1024);
        { const int j = tid >> 2, q = tid & 3; const u32x4* src = (const u32x4*)(Zgv + (size_t)(r0 + j) * DCH + q * 128); float s = 0.f;
#pragma unroll
          for (int i = 0; i < 16; ++i) { const F8 v = unpack8(src[i]); s += (v.a[0] * v.a[0] + v.a[1] * v.a[1]) + (v.a[2] * v.a[2] + v.a[3] * v.a[3]) + (v.b[0] * v.b[0] + v.b[1] * v.b[1]) + (v.b[2] * v.b[2] + v.b[3] * v.b[3]); }
          s += __shfl_xor(s, 1); s += __shfl_xor(s, 2);
          if (q == 0) rstd[j] = rsqrtf(s * (1.f / DCH) + 1e-6f); }
        __syncthreads();
        const int fr = lane & 15, fq = lane >> 4;
        for (int g = 0; g < 4; ++g) {
            { const int j = tid >> 2, q = tid & 3; const float rs = rstd[j];
              const u32x4* src = (const u32x4*)(Zgv + (size_t)(r0 + j) * DCH + g * 128 + q * 32); const float* gg = vg + g * 128 + q * 32;
#pragma unroll
              for (int i = 0; i < 4; ++i) { const F8 v = unpack8(src[i]); const f32x4 g0 = *(const f32x4*)(gg + 8 * i), g1 = *(const f32x4*)(gg + 8 * i + 4);
                  const int d = q * 32 + 8 * i;
#pragma unroll
                  for (int e = 0; e < 4; ++e) { VT[(d + e) * 136 + j] = f2bf(v.a[e] * rs * g0[e]); VT[(d + 4 + e) * 136 + j] = f2bf(v.b[e] * rs * g1[e]); } } }
            __syncthreads();
            const int i = 16 * wave + fr; bf16x8 af[4];
#pragma unroll
            for (int ks = 0; ks < 4; ++ks) { const int k0 = 32 * ks + 8 * fq; const float* wrow = cws + ((size_t)g * 128 + i) * 128 + k0;
                const f32x4 a0 = *(const f32x4*)wrow, a1 = *(const f32x4*)(wrow + 4); u32x4 w;
                w.x = pk2(k0 + 0 <= i ? a0[0] : 0.f, k0 + 1 <= i ? a0[1] : 0.f); w.y = pk2(k0 + 2 <= i ? a0[2] : 0.f, k0 + 3 <= i ? a0[3] : 0.f);
                w.z = pk2(k0 + 4 <= i ? a1[0] : 0.f, k0 + 5 <= i ? a1[1] : 0.f); w.w = pk2(k0 + 6 <= i ? a1[2] : 0.f, k0 + 7 <= i ? a1[3] : 0.f);
                af[ks] = __builtin_bit_cast(bf16x8, w); }
            const float bsv = cbs[g * 128 + i];
#pragma unroll
            for (int dt = 0; dt < 8; ++dt) {
                f32x4 c4 = (f32x4){0.f, 0.f, 0.f, 0.f};
#pragma unroll
                for (int ks = 0; ks < 4; ++ks) { const bf16x8 vf = *(const LAS bf16x8*)(VT + (16 * dt + fr) * 136 + 32 * ks + 8 * fq);
                    c4 = __builtin_amdgcn_mfma_f32_16x16x32_bf16(vf, af[ks], c4, 0, 0, 0); }
                const size_t off = (size_t)(r0 + i) * DCH + g * 128 + 16 * dt + 4 * fq;
                const u32x2 uu = *(const u32x2*)(Zgu + off); u32x2 o;
                o.x = pk2(bf_lo(uu.x) * (c4[0] + bsv), bf_hi(uu.x) * (c4[1] + bsv)); o.y = pk2(bf_lo(uu.y) * (c4[2] + bsv), bf_hi(uu.y) * (c4[3] + bsv));
                *(u32x2*)(Yc + off) = o;
            }
            __syncthreads();
        }
    } else if (bid < 144) {
        const int s = (bid - 128) * 8 + wave, row = MPR + s, c = lane * 8, g = lane >> 4;
        const F8 v = unpack8(*(const u32x4*)(Zgv + (size_t)row * DCH + c));
        float ss = (v.a[0] * v.a[0] + v.a[1] * v.a[1]) + (v.a[2] * v.a[2] + v.a[3] * v.a[3]) + (v.b[0] * v.b[0] + v.b[1] * v.b[1]) + (v.b[2] * v.b[2] + v.b[3] * v.b[3]);
        const float rs = rsqrtf(wave_sum(ss) * (1.f / DCH) + 1e-6f);
        const f32x4 vn0 = v.a * rs * *(const f32x4*)(vg + c), vn1 = v.b * rs * *(const f32x4*)(vg + c + 4);
        float* ov = p.out + O_CV_S + ((size_t)l * NS + s) * DCH + c; *(f32x4*)ov = vn0; *(f32x4*)(ov + 4) = vn1;
        const float w00 = cws[(size_t)g * 128 * 128], b0 = cbs[g * 128];
        const F8 uu = unpack8(*(const u32x4*)(Zgu + (size_t)row * DCH + c));
        *(u32x4*)(Yc + (size_t)row * DCH + c) = pack8(uu.a * (vn0 * w00 + b0), uu.b * (vn1 * w00 + b0));
    }
    const int gt = bid * 512 + tid, ngt = G * 512;
    { const float* cw = p.in[10] + (size_t)l * 4 * DRNN; const float* cb = p.in[11] + (size_t)l * DRNN; const float* st = p.in[3] + (size_t)l * NS * 3 * DRNN;
      for (int idx = gt; idx < MROWS * 128; idx += ngt) { const int row = idx >> 7, c = (idx & 127) * 8;
          f32x4 s0 = *(const f32x4*)(cb + c), s1 = *(const f32x4*)(cb + c + 4);
          { const F8 x = unpack8(*(const u32x4*)(Zbx + (size_t)row * DRNN + c)); s0 += *(const f32x4*)(cw + 3 * DRNN + c) * x.a; s1 += *(const f32x4*)(cw + 3 * DRNN + c + 4) * x.b; }
          if (row < MPR) { const int t = row & 2047;
#pragma unroll
              for (int j = 1; j < 4; ++j) if (t >= j) { const F8 x = unpack8(*(const u32x4*)(Zbx + (size_t)(row - j) * DRNN + c)); s0 += *(const f32x4*)(cw + (3 - j) * DRNN + c) * x.a; s1 += *(const f32x4*)(cw + (3 - j) * DRNN + c + 4) * x.b; } }
          else { const float* sp = st + (size_t)(row - MPR) * 3 * DRNN + c;
#pragma unroll
              for (int k = 0; k < 3; ++k) { s0 += *(const f32x4*)(cw + k * DRNN + c) * *(const f32x4*)(sp + k * DRNN); s1 += *(const f32x4*)(cw + k * DRNN + c + 4) * *(const f32x4*)(sp + k * DRNN + 4); } }
          *(u32x4*)(Y0 + (size_t)row * DRNN + c) = pack8(s0, s1); } }
    { const float* st = p.in[2] + (size_t)l * NS * 15 * DPOOL;
      for (int idx = gt; idx < MROWS * 64; idx += ngt) { const int row = idx >> 6, c = (idx & 63) * 8, w = 2 << (c >> 7);
          const F8 cur = unpack8(*(const u32x4*)(Za + (size_t)row * DPOOL + c)); f32x4 s0 = cur.a, s1 = cur.b; float cnt;
          if (row < MPR) { const int t = row & 2047; const int nb = t < w - 1 ? t : w - 1; cnt = (float)(nb + 1);
              for (int j = 1; j <= nb; ++j) { const F8 x = unpack8(*(const u32x4*)(Za + (size_t)(row - j) * DPOOL + c)); s0 += x.a; s1 += x.b; } }
          else { const float* sp = st + (size_t)(row - MPR) * 15 * DPOOL + c; cnt = (float)w;
              for (int j = 1; j < w; ++j) { s0 += *(const f32x4*)(sp + (15 - j) * DPOOL); s1 += *(const f32x4*)(sp + (15 - j) * DPOOL + 4); } }
          const float ic = 1.f / cnt;
          *(u32x4*)(Yd + (size_t)row * DPOOL + c) = pack8(s0 * ic - cur.a, s1 * ic - cur.b); } }
    { const float* sp = p.in[2] + (size_t)l * NS * 15 * DPOOL; float* o = p.out + O_POOL_S + (size_t)l * NS * 15 * DPOOL;
      for (int idx = gt; idx < NS * 14 * (DPOOL / 4); idx += ngt) { const int c = (idx & 127) * 4, r = (idx >> 7) % 14, s = (idx >> 7) / 14;
          *(f32x4*)(o + ((size_t)s * 15 + r) * DPOOL + c) = *(const f32x4*)(sp + ((size_t)s * 15 + r + 1) * DPOOL + c); } }
    { const float* sp = p.in[3] + (size_t)l * NS * 3 * DRNN; float* o = p.out + O_RC_S + (size_t)l * NS * 3 * DRNN;
      for (int idx = gt; idx < NS * 2 * (DRNN / 4); idx += ngt) { const int c = (idx & 255) * 4, r = (idx >> 8) & 1, s = idx >> 9;
          *(f32x4*)(o + ((size_t)s * 3 + r) * DRNN + c) = *(const f32x4*)(sp + ((size_t)s * 3 + r + 1) * DRNN + c); } }
    { const float* sp = p.in[5] + (size_t)l * NS * 2 * DFF; float* o = p.out + O_FF_S + (size_t)l * NS * 2 * DFF;
      for (int idx = gt; idx < NS * (DFF / 4); idx += ngt) { const int c = (idx % 768) * 4, s = idx / 768;
          *(f32x4*)(o + ((size_t)s * 2) * DFF + c) = *(const f32x4*)(sp + ((size_t)s * 2 + 1) * DFF + c); } }
}

__device__ __forceinline__ void phase_scan(const Params& p, int l, LAS unsigned char* lds, int bid, int G) {
    int tid = threadIdx.x; asm volatile("" : "+v"(tid));
    const int wave = tid >> 6, lane = tid & 63;
    const bf16_t* LA = (const bf16_t*)(p.ws + WS_Z) + UE; const bf16_t* BV = (const bf16_t*)(p.ws + WS_Z) + 5 * UE; const bf16_t* GB = (const bf16_t*)(p.ws + WS_Z) + 3 * UE;
    bf16_t* Y0 = (bf16_t*)(p.ws + WS_Y);
    if (bid < 128) {
        const int b = bid >> 4, ch = (bid & 15) * 64 + lane;
        const size_t base = ((size_t)b * SEQ + wave * 256) * DRNN + ch;
        LAS float* sP = (LAS float*)lds; LAS float* sH = sP + 512;
        float P = 1.f, h = 0.f;
#pragma unroll 16
        for (int t = 0; t < 256; ++t) { const float a = __expf(bf2f(LA[base + (size_t)t * DRNN])), bb = bf2f(BV[base + (size_t)t * DRNN]); h = a * h + bb; P *= a; }
        sP[wave * 64 + lane] = P; sH[wave * 64 + lane] = h;
        __syncthreads();
        h = 0.f;
        for (int k = 0; k < wave; ++k) h = sP[k * 64 + lane] * h + sH[k * 64 + lane];
#pragma unroll 16
        for (int t = 0; t < 256; ++t) { const float a = __expf(bf2f(LA[base + (size_t)t * DRNN])), bb = bf2f(BV[base + (size_t)t * DRNN]); h = a * h + bb;
            Y0[base + (size_t)t * DRNN] = f2bf(bf2f(GB[base + (size_t)t * DRNN]) * h); }
        if (wave == 7) p.out[O_H_P + ((size_t)l * NB + b) * DRNN + ch] = h;
    } else {
        const float* h0 = p.in[4] + (size_t)l * NS * DRNN; float* oh = p.out + O_H_S + (size_t)l * NS * DRNN;
        for (int idx = (bid - 128) * 512 + tid; idx < NS * DRNN; idx += (G - 128) * 512) { const size_t off = (size_t)MPR * DRNN + idx;
            const float a = __expf(bf2f(LA[off])), h = a * h0[idx] + bf2f(BV[off]); oh[idx] = h; Y0[off] = f2bf(bf2f(GB[off]) * h); }
    }
}

__device__ __forceinline__ void phase_merge(const Params& p, int bid, int NG) {
    const bf16_t* G = (const bf16_t*)(p.ws + WS_Z); bf16_t* XN = (bf16_t*)(p.ws + WS_XN);
    int tid = threadIdx.x; asm volatile("" : "+v"(tid));
    for (int idx = bid * 512 + tid; idx < MPAD * 128; idx += NG * 512) { const int row = idx >> 7, c = (idx & 127) * 8;
        const bf16_t* gr = G + (size_t)row * 3072 + c; const F8 a = unpack8(*(const u32x4*)gr), b = unpack8(*(const u32x4*)(gr + 1024)), d = unpack8(*(const u32x4*)(gr + 2048));
        *(u32x4*)(XN + (size_t)row * DM + c) = pack8(a.a + b.a + d.a, a.b + b.b + d.b); }
}

__device__ __forceinline__ void phase_final(const Params& p, int bid, int G) {
    int tid = threadIdx.x; asm volatile("" : "+v"(tid));
    const int wave = tid >> 6, lane = tid & 63; const float* g = p.in[30];
    for (int row = bid * 8 + wave; row < MROWS; row += G * 8) {
        f32x4* xr = (f32x4*)(p.out + (size_t)row * DM) + lane; f32x4 v[4]; float s = 0.f;
#pragma unroll
        for (int j = 0; j < 4; ++j) { v[j] = xr[64 * j]; s += (v[j][0] * v[j][0] + v[j][1] * v[j][1]) + (v[j][2] * v[j][2] + v[j][3] * v[j][3]); }
        const float rstd = rsqrtf(wave_sum(s) * (1.f / DM) + 1e-6f); const f32x4* gr = (const f32x4*)g + lane;
#pragma unroll
        for (int j = 0; j < 4; ++j) xr[64 * j] = v[j] * rstd * gr[64 * j];
    }
}

__global__ void __launch_bounds__(512, 2) mega(Params pk) {
    extern __shared__ __attribute__((aligned(16))) unsigned char shm[];
    LAS unsigned char* lds = (LAS unsigned char*)shm;
    cg::grid_group grid = cg::this_grid();
    for (int ph = pk.ph_lo; ph < pk.ph_hi; ++ph) {
        Params p = pk; int G = gridDim.x, bid = blockIdx.x;
        asm volatile("" : "+s"(p.ws), "+s"(p.out), "+s"(G), "+s"(bid));
        bf16_t* XN = (bf16_t*)(p.ws + WS_XN); bf16_t* Z = (bf16_t*)(p.ws + WS_Z); bf16_t* Y0 = (bf16_t*)(p.ws + WS_Y); bf16_t* W = (bf16_t*)(p.ws + WS_W); bf16_t* H = (bf16_t*)(p.ws + WS_H);
        if (ph == NPH - 1) { phase_final(p, bid, G); }
        else {
            const int l = ph / PH_PER_LAYER, k = ph % PH_PER_LAYER;
            const float* xp = l == 0 ? p.in[0] : p.out; const float* xs = l == 0 ? p.in[1] : p.out + (size_t)MPR * DM;
            pg8::Order S; pg8::Gemm g;
            switch (k) {
            case 0: phase_prep(p, l, lds, xp, xs, bid, G); break;
            case 1: { S.init(NTM, ZC / 256, G, bid, 0); g = {XN, W + W_IN, DM, DM, DM}; EpiZ E{Z, p.out, l}; pg8::gemm_phase(lds, g, S, E); } break;
            case 2: phase_mix(p, l, lds, bid, G); break;
            case 3: { S.init(NTM, 8, G, bid, 1); g = {Y0, W + W_RI, DRNN, 256, 256};
                      EpiRI E{Y0, Z + UE, Z + 5 * UE, p.in[13] + (size_t)l * DRNN, p.in[15] + (size_t)l * DRNN, (const float*)(p.ws + WS_SP)}; pg8::gemm_phase(lds, g, S, E); } break;
            case 4: phase_scan(p, l, lds, bid, G); break;
            case 5: { S.init(NTM, 12, G, bid, 0); g = {XN, W + W_IN + (size_t)ZC * DM, DM, DM, DM}; EpiG E{Z}; pg8::gemm_phase(lds, g, S, E); } break;
            case 6: { { S.init(NTM, 4, G, bid, 0); g = {Y0 + 2 * UE, W + W_PA, DPOOL, DPOOL, DPOOL}; EpiP E{Z, 0}; pg8::gemm_phase(lds, g, S, E); }
                      { S.init(NTM, 4, G, (bid + 8) % G, 0); g = {Y0, W + W_PB, DRNN, DRNN, DRNN}; EpiP E{Z, 1024}; pg8::gemm_phase(lds, g, S, E); }
                      { S.init(NTM, 4, G, (bid + 16) % G, 0); g = {Y0 + 3 * UE, W + W_PC, DCH, DCH, DCH}; EpiP E{Z, 2048}; pg8::gemm_phase(lds, g, S, E); } } break;
            case 7: phase_merge(p, bid, G); break;
            case 8: { S.init(NTM, 4, G, bid, 0); g = {XN, W + W_O, DM, DM, DM}; EpiX E{xp, xs, p.out}; pg8::gemm_phase(lds, g, S, E); } break;
            case 9: { int tid = threadIdx.x; asm volatile("" : "+v"(tid)); const int wave = tid >> 6, lane = tid & 63; rms_rows(p.out, p.out + (size_t)MPR * DM, p.in[24] + (size_t)l * DM, XN, bid * 8 + wave, G * 8, lane); } break;
            case 10: { S.init(NTM, 12, G, bid, 0); g = {XN, W + W_G, DM, DM, DM}; EpiGpre E{Z, p.out, l}; pg8::gemm_phase(lds, g, S, E); } break;
            case 11: { S.init(NTM, 12, G, bid, 0); g = {XN, W + W_U, DM, DM, DM};
                       EpiH E{Z, H, p.in[27] + (size_t)l * 3 * DFF, p.in[28] + (size_t)l * DFF, p.in[5] + (size_t)l * NS * 2 * DFF}; pg8::gemm_phase(lds, g, S, E); } break;
            default: { S.init(NTM, 4, G, bid, 0); g = {H, W + W_D, DFF, DFF, DFF}; EpiX E{p.out, p.out + (size_t)MPR * DM, p.out}; pg8::gemm_phase(lds, g, S, E); } break;
            }
        }
        if (ph + 1 < pk.ph_hi) grid.sync();
    }
}

extern "C" void kernel_launch(void* const* d_in, const int* in_sizes, int n_in, void* d_out, int out_size, void* d_ws, size_t ws_size, hipStream_t stream) {
    static int grid = 0;
    if (grid == 0) {
        int dev = 0, cus = 0, per_cu = 0;
        hipGetDevice(&dev);
        hipDeviceGetAttribute(&cus, hipDeviceAttributeMultiprocessorCount, dev);
        if (hipFuncSetAttribute((const void*)mega, hipFuncAttributeMaxDynamicSharedMemorySize, LDS_BYTES) != hipSuccess) fprintf(stderr, "kernel_launch: hipFuncSetAttribute failed\n");
        if (hipOccupancyMaxActiveBlocksPerMultiprocessor(&per_cu, (const void*)mega, 512, LDS_BYTES) != hipSuccess || per_cu < 1) { fprintf(stderr, "kernel_launch: occupancy query says %d blocks per CU\n", per_cu); per_cu = 1; }
        (void)hipGetLastError();
        grid = cus;
        if (n_in != 31 || ws_size < WS_END) fprintf(stderr, "kernel_launch: unexpected n_in %d / ws_size %zu (need %zu)\n", n_in, ws_size, (size_t)WS_END);
    }
    Params p{};
    for (int i = 0; i < 31; ++i) p.in[i] = (const float*)d_in[i];
    p.out = (float*)d_out; p.ws = (unsigned char*)d_ws; p.ph_lo = 0; p.ph_hi = NPH;
    void* args[] = {&p};
    hipError_t e = hipLaunchCooperativeKernel((const void*)mega, dim3(grid), dim3(512), args, LDS_BYTES, stream);
    if (e != hipSuccess) fprintf(stderr, "cooperative launch failed: %s (grid %d)\n", hipGetErrorString(e), grid);
}
```

```cpp
#include <hip/hip_runtime.h>
#include <hip/hip_cooperative_groups.h>
#include <cstdio>
#include <cstdint>
namespace cg = cooperative_groups;

#define LAS __attribute__((address_space(3)))
typedef unsigned short bf16_t;
typedef short bf16x8 __attribute__((ext_vector_type(8)));
typedef float f32x4 __attribute__((ext_vector_type(4)));
typedef float f32x2 __attribute__((ext_vector_type(2)));
typedef unsigned u32x4 __attribute__((ext_vector_type(4)));
typedef unsigned u32x2 __attribute__((ext_vector_type(2)));

constexpr int DM = 1024, NB = 8, SEQ = 2048, MPR = NB * SEQ, NS = 128, MROWS = MPR + NS, MPAD = 16640, NTM = MPAD / 256;
constexpr int DPOOL = 512, DRNN = 1024, DCH = 512, DFF = 3072, INCOLS = 6656, ZC = 3584;
constexpr int NLAYER = 2, PH_PER_LAYER = 13, NPH = NLAYER * PH_PER_LAYER + 1;
constexpr size_t O_Y = 0;
constexpr size_t O_POOL_P = (size_t)MROWS * DM;
constexpr size_t O_POOL_S = O_POOL_P + (size_t)2 * NB * 15 * DPOOL;
constexpr size_t O_RC_P = O_POOL_S + (size_t)2 * NS * 15 * DPOOL;
constexpr size_t O_RC_S = O_RC_P + (size_t)2 * NB * 3 * DRNN;
constexpr size_t O_H_P = O_RC_S + (size_t)2 * NS * 3 * DRNN;
constexpr size_t O_H_S = O_H_P + (size_t)2 * NB * DRNN;
constexpr size_t O_FF_P = O_H_S + (size_t)2 * NS * DRNN;
constexpr size_t O_FF_S = O_FF_P + (size_t)2 * NB * 2 * DFF;
constexpr size_t O_CV_S = O_FF_S + (size_t)2 * NS * 2 * DFF;
constexpr size_t UE = (size_t)MPAD * 512, UB = UE * 2;
constexpr size_t WS_BAR = 16384;
constexpr size_t WS_SP = 4096;
constexpr size_t WS_XN = 1u << 20;
constexpr size_t WS_Z = WS_XN + 2 * UB;
constexpr size_t WS_Y = WS_Z + 7 * UB;
constexpr size_t WS_W = WS_Y + 4 * UB;
constexpr size_t WS_H = WS_Z + 6 * UB;
constexpr size_t W_IN = 0;
constexpr size_t W_PA = W_IN + (size_t)INCOLS * DM;
constexpr size_t W_PB = W_PA + (size_t)DM * DPOOL;
constexpr size_t W_PC = W_PB + (size_t)DM * DRNN;
constexpr size_t W_O = W_PC + (size_t)DM * DCH;
constexpr size_t W_G = W_O + (size_t)DM * DM;
constexpr size_t W_U = W_G + (size_t)DFF * DM;
constexpr size_t W_D = W_U + (size_t)DFF * DM;
constexpr size_t W_RI = W_D + (size_t)DM * DFF;
constexpr size_t W_END = W_RI + (size_t)8 * 256 * 256;
constexpr size_t WS_END = WS_W + W_END * 2;
static_assert(WS_END <= (256u << 20), "workspace");
static_assert(WS_H + 6 * UB <= WS_W + (W_G)*2, "h overlay must not reach wg/wu/wd");
constexpr int LDS_BYTES = 131072 + 2048;
#ifndef REPMASK
#define REPMASK 0u
#endif
#ifndef EXTRA_SYNCS
#define EXTRA_SYNCS 0
#endif

struct Params { const float* in[31]; float* out; unsigned char* ws; int ph_lo, ph_hi; };

__device__ __forceinline__ float bf_lo(unsigned w) { return __builtin_bit_cast(float, w << 16); }
__device__ __forceinline__ float bf_hi(unsigned w) { return __builtin_bit_cast(float, w & 0xffff0000u); }
__device__ __forceinline__ float bf2f(bf16_t b) { return __builtin_bit_cast(float, (unsigned)b << 16); }
typedef __bf16 bf16x2_t __attribute__((ext_vector_type(2)));
__device__ __forceinline__ unsigned pk2(float lo, float hi) { f32x2 v = {lo, hi}; bf16x2_t b = __builtin_convertvector(v, bf16x2_t); return __builtin_bit_cast(unsigned, b); }
__device__ __forceinline__ bf16_t f2bf(float f) { return (bf16_t)(pk2(f, 0.f) & 0xffffu); }
struct F8 { f32x4 a, b; };
__device__ __forceinline__ F8 unpack8(u32x4 w) { F8 r; r.a[0] = bf_lo(w.x); r.a[1] = bf_hi(w.x); r.a[2] = bf_lo(w.y); r.a[3] = bf_hi(w.y); r.b[0] = bf_lo(w.z); r.b[1] = bf_hi(w.z); r.b[2] = bf_lo(w.w); r.b[3] = bf_hi(w.w); return r; }
__device__ __forceinline__ u32x4 pack8(f32x4 a, f32x4 b) { u32x4 w; w.x = pk2(a[0], a[1]); w.y = pk2(a[2], a[3]); w.z = pk2(b[0], b[1]); w.w = pk2(b[2], b[3]); return w; }
__device__ __forceinline__ float gelu_t(float x) {
    const float u = 0.7978845608f * (x + 0.044715f * x * x * x);
    const float e = __builtin_amdgcn_exp2f(-2.885390082f * u);
    return x * __builtin_amdgcn_rcpf(1.f + e);
}
__device__ __forceinline__ f32x4 gelu4(f32x4 v) { f32x4 r; r[0] = gelu_t(v[0]); r[1] = gelu_t(v[1]); r[2] = gelu_t(v[2]); r[3] = gelu_t(v[3]); return r; }
__device__ __forceinline__ float sigm(float x) { return __builtin_amdgcn_rcpf(1.f + __builtin_amdgcn_exp2f(-1.442695041f * x)); }
__device__ __forceinline__ f32x4 sigm4(f32x4 v) { f32x4 r; r[0] = sigm(v[0]); r[1] = sigm(v[1]); r[2] = sigm(v[2]); r[3] = sigm(v[3]); return r; }
__device__ __forceinline__ float wave_sum(float v) {
#pragma unroll
    for (int o = 1; o < 64; o <<= 1) v += __shfl_xor(v, o);
    return v;
}

namespace pg8 {
constexpr int BM = 256, BK = 64, HALF = 128, HTB = HALF * BK * 2, STAGE_BYTES = 8 * HTB, NXCD = 8, WGM = 8;
__device__ __forceinline__ int lds_byte(int r, int c) { const int st = (r >> 4) * 2 + (c >> 5), rr = r & 15, cc = c & 31, ob = rr * 64 + cc * 2; return st * 1024 + (ob ^ (((ob >> 9) & 1) << 5)); }
__device__ __forceinline__ void stage_rc(int b, int& R, int& C) { const int st = b / 1024, sb = b % 1024, swz = sb ^ (((sb >> 9) & 1) << 5); R = (st >> 1) * 16 + swz / 64; C = (st & 1) * 32 + (swz % 64) / 2; }
__device__ __forceinline__ int perm32(int rho) { const int n = rho >> 4, i = rho & 15; return 8 * (i >> 2) + 4 * n + (i & 3); }

struct Unit { int pm, pn, ka; };
struct Gemm { const bf16_t* A; const bf16_t* Bt; int lda, ldb, K; };

struct Order {
    int nM, nN, nwg, G, c, mode;
    __device__ __forceinline__ void init(int nM_, int nN_, int G_, int c_, int mode_) { nM = nM_; nN = nN_; nwg = nM * nN; G = G_; c = c_; mode = mode_; }
    __device__ __forceinline__ bool next(int i, Unit& u) const {
        const long L = (long)i * G + c; if (L >= nwg) return false;
        int wgid = (int)L; { const int q = nwg / NXCD, r = nwg % NXCD, xcd = wgid % NXCD, off = wgid / NXCD; wgid = (xcd < r ? xcd * (q + 1) : r * (q + 1) + (xcd - r) * q) + off; }
        const int nig = WGM * nN, gid = wgid / nig, fm = gid * WGM, gsz = (nM - fm) < WGM ? (nM - fm) : WGM;
        u.pm = fm + ((wgid % nig) % gsz); u.pn = (wgid % nig) / gsz; u.ka = mode ? ((u.pn & ~1) * 128) : 0; return true;
    }
};

template <class Epi>
__device__ __forceinline__ void gemm_phase(LAS unsigned char* lds, const Gemm g, const Order& S, const Epi& E) {
    int tid = threadIdx.x; asm volatile("" : "+v"(tid));
    const int wid = __builtin_amdgcn_readfirstlane(tid >> 6), lane = tid & 63, wr = wid >> 2, wc = wid & 3, fr = lane & 15, fq = lane >> 4;
    const int K = g.K, nt = K / BK;
    unsigned voffA[2], voffB[2];
#pragma unroll
    for (int i = 0; i < 2; ++i) { int R, C; stage_rc(tid * 16 + i * 8192, R, C); const int Rb = Epi::PERM ? ((R & ~31) + perm32(R & 31)) : R;
        voffA[i] = (unsigned)(R * g.lda + C) * 2u; voffB[i] = (unsigned)(Rb * g.ldb + C) * 2u; }
    const size_t kstep = (size_t)(BK * 2);
    const size_t hstepA = (size_t)HALF * g.lda * 2, tstepA = 2 * hstepA;
    const size_t hstepB = (size_t)HALF * g.ldb * 2, tstepB = 2 * hstepB;
    const unsigned ldsw = (unsigned)wid * 1024u;
    const int aoff = lds_byte(wr * 64 + fr, fq * 8), boff = lds_byte(wc * 32 + fr, fq * 8);
#define PG8_SA(b, h) (((b) * 2 + (h)) * HTB)
#define PG8_SB(b, h) ((4 + (b) * 2 + (h)) * HTB)
#define PG8_STAGE(bufoff, gbase, voff) do { _Pragma("unroll") for (int _i = 0; _i < 2; ++_i) \
        __builtin_amdgcn_global_load_lds((const unsigned*)((const char*)(gbase) + (voff)[_i]), (LAS unsigned*)(lds + (bufoff) + ldsw + _i * 8192), 16, 0, 0); } while (0)
#define PG8_LDA(dst, b, h) do { _Pragma("unroll") for (int m = 0; m < 4; ++m) _Pragma("unroll") for (int k = 0; k < 2; ++k) dst[m][k] = *(const LAS bf16x8*)(lds + PG8_SA(b, h) + aoff + m * 2048 + k * 1024); } while (0)
#define PG8_LDB(dst, b, h) do { _Pragma("unroll") for (int n = 0; n < 2; ++n) _Pragma("unroll") for (int k = 0; k < 2; ++k) dst[n][k] = *(const LAS bf16x8*)(lds + PG8_SB(b, h) + boff + n * 2048 + k * 1024); } while (0)
#define PG8_MMA(ai, bj, At, Bt) do { __builtin_amdgcn_s_setprio(1); _Pragma("unroll") for (int m = 0; m < 4; ++m) _Pragma("unroll") for (int n = 0; n < 2; ++n) _Pragma("unroll") for (int k = 0; k < 2; ++k) \
        acc[ai][bj][m][n] = __builtin_amdgcn_mfma_f32_16x16x32_bf16(Bt[n][k], At[m][k], acc[ai][bj][m][n], 0, 0, 0); __builtin_amdgcn_s_setprio(0); } while (0)
#define PG8_WAIT_V(n) asm volatile("s_waitcnt vmcnt(" #n ")" ::: "memory")
#define PG8_WAIT_L(n) asm volatile("s_waitcnt lgkmcnt(" #n ")" ::: "memory")
#define PG8_BAR __builtin_amdgcn_s_barrier()
#define PG8_SCHED __builtin_amdgcn_sched_barrier(0)
    Unit cur, nxt; int ui = 0;
    if (!S.next(0, cur)) return;
    f32x4 acc[2][2][4][2];
#pragma unroll
    for (int a = 0; a < 2; ++a)
#pragma unroll
        for (int b = 0; b < 2; ++b)
#pragma unroll
            for (int m = 0; m < 4; ++m)
#pragma unroll
                for (int n = 0; n < 2; ++n) acc[a][b][m][n] = (f32x4){0.f, 0.f, 0.f, 0.f};
    bf16x8 At[4][2], B0[2][2], B1[2][2];
    const char* cA = (const char*)g.A + (size_t)cur.pm * tstepA + (size_t)cur.ka * 2; const char* cB = (const char*)g.Bt + (size_t)cur.pn * tstepB;
    PG8_STAGE(PG8_SB(0, 0), cB, voffB); PG8_STAGE(PG8_SB(0, 1), cB + hstepB, voffB); PG8_STAGE(PG8_SA(0, 0), cA, voffA); PG8_STAGE(PG8_SA(0, 1), cA + hstepA, voffA);
    if (wr == 1) PG8_BAR;
    PG8_WAIT_V(2); PG8_BAR;
    PG8_STAGE(PG8_SB(1, 0), cB + kstep, voffB); PG8_STAGE(PG8_SA(1, 0), cA + kstep, voffA); PG8_STAGE(PG8_SB(1, 1), cB + hstepB + kstep, voffB);
    PG8_WAIT_V(6); PG8_BAR;
    for (;;) {
        const bool has_next = S.next(ui + 1, nxt);
        const char* nA = has_next ? (const char*)g.A + (size_t)nxt.pm * tstepA + (size_t)nxt.ka * 2 : cA; const char* nB = has_next ? (const char*)g.Bt + (size_t)nxt.pn * tstepB : cB;
#pragma unroll 1
        for (int t = 0; t < nt; t += 2) {
            const bool last = (t == nt - 2);
            const char* a1 = cA + (size_t)(t + 1) * kstep;
            const char* a2 = last ? nA : cA + (size_t)(t + 2) * kstep; const char* b2 = last ? nB : cB + (size_t)(t + 2) * kstep;
            const char* a3 = a2 + kstep; const char* b3 = b2 + kstep;
            PG8_LDB(B0, 0, 0); PG8_LDB(B1, 0, 1); PG8_SCHED; PG8_LDA(At, 0, 0); PG8_STAGE(PG8_SA(1, 1), a1 + hstepA, voffA);
            PG8_WAIT_V(8); PG8_WAIT_L(0); PG8_BAR; PG8_MMA(0, 0, At, B0); PG8_MMA(0, 1, At, B1); PG8_BAR; PG8_SCHED;
            PG8_LDA(At, 0, 1); PG8_STAGE(PG8_SB(0, 0), b2, voffB); PG8_STAGE(PG8_SB(0, 1), b2 + hstepB, voffB); PG8_STAGE(PG8_SA(0, 0), a2, voffA);
            PG8_WAIT_V(8); PG8_WAIT_L(0); PG8_BAR; PG8_MMA(1, 0, At, B0); PG8_MMA(1, 1, At, B1); PG8_BAR; PG8_SCHED;
            PG8_LDB(B0, 1, 0); PG8_LDB(B1, 1, 1); PG8_SCHED; PG8_LDA(At, 1, 0); PG8_STAGE(PG8_SA(0, 1), a2 + hstepA, voffA);
            PG8_WAIT_V(8); PG8_WAIT_L(0); PG8_BAR; PG8_MMA(0, 0, At, B0); PG8_MMA(0, 1, At, B1); PG8_BAR; PG8_SCHED;
            PG8_LDA(At, 1, 1); PG8_STAGE(PG8_SB(1, 0), b3, voffB); PG8_STAGE(PG8_SB(1, 1), b3 + hstepB, voffB); PG8_STAGE(PG8_SA(1, 0), a3, voffA);
            PG8_WAIT_V(8); PG8_WAIT_L(0); PG8_BAR; PG8_MMA(1, 0, At, B0); PG8_MMA(1, 1, At, B1); PG8_BAR; PG8_SCHED;
        }
        if (wr == 0) PG8_BAR;
        { int fr2 = fr, fq2 = fq; asm volatile("" : "+v"(fr2), "+v"(fq2));
          E(acc, cur, wr, wc, fr2, fq2); }
        if (!has_next) break;
#pragma unroll
        for (int a = 0; a < 2; ++a)
#pragma unroll
            for (int b = 0; b < 2; ++b)
#pragma unroll
                for (int m = 0; m < 4; ++m)
#pragma unroll
                    for (int n = 0; n < 2; ++n) acc[a][b][m][n] = (f32x4){0.f, 0.f, 0.f, 0.f};
        cur = nxt; cA = nA; cB = nB; ++ui;
        if (wr == 1) PG8_BAR;
    }
    PG8_WAIT_V(0);
    PG8_BAR;
#undef PG8_SA
#undef PG8_SB
#undef PG8_STAGE
#undef PG8_LDA
#undef PG8_LDB
#undef PG8_MMA
#undef PG8_WAIT_V
#undef PG8_WAIT_L
#undef PG8_BAR
#undef PG8_SCHED
}
}
using pg8::Unit;

#define EPI_ARGS const f32x4 (&acc)[2][2][4][2], const Unit& u, int wr, int wc, int fr, int fq
struct EpiZ {
    static constexpr bool PERM = true;
    bf16_t* Z; float* out; int l;
    __device__ __forceinline__ void operator()(EPI_ARGS) const {
        const int pn = u.pn; bf16_t* base; int ld, ct; bool act;
        if (pn < 2) { base = Z; ld = 512; ct = pn * 256; act = false; }
        else if (pn < 6) { base = Z + UE; ld = 1024; ct = (pn - 2) * 256; act = false; }
        else if (pn < 10) { base = Z + 3 * UE; ld = 1024; ct = (pn - 6) * 256; act = true; }
        else if (pn < 12) { base = Z + 5 * UE; ld = 512; ct = (pn - 10) * 256; act = true; }
        else { base = Z + 6 * UE; ld = 512; ct = (pn - 12) * 256; act = true; }
        const bool st = (pn < 6) && (((u.pm & 7) == 7) || u.pm == 64);
#pragma unroll
        for (int ai = 0; ai < 2; ++ai)
#pragma unroll
            for (int m = 0; m < 4; ++m) {
                const int row = u.pm * 256 + ai * 128 + wr * 64 + m * 16 + fr;
#pragma unroll
                for (int bj = 0; bj < 2; ++bj) {
                    f32x4 v0 = acc[ai][bj][m][0], v1 = acc[ai][bj][m][1];
                    const int c = ct + bj * 128 + wc * 32 + 8 * fq;
                    if (st) {
                        float* o = nullptr;
                        if (row < MPR) { const int t = row & 2047, b = row >> 11;
                            if (pn < 2) { if (t >= 2033) o = out + O_POOL_P + ((size_t)(l * NB + b) * 15 + (t - 2033)) * DPOOL + c; }
                            else { if (t >= 2045) o = out + O_RC_P + ((size_t)(l * NB + b) * 3 + (t - 2045)) * DRNN + c; } }
                        else if (row < MROWS) { const int s = row - MPR;
                            if (pn < 2) o = out + O_POOL_S + ((size_t)(l * NS + s) * 15 + 14) * DPOOL + c;
                            else o = out + O_RC_S + ((size_t)(l * NS + s) * 3 + 2) * DRNN + c; }
                        if (o) { *(f32x4*)o = v0; *(f32x4*)(o + 4) = v1; }
                    }
                    if (act) { v0 = gelu4(v0); v1 = gelu4(v1); }
                    *(u32x4*)(base + (size_t)row * ld + c) = pack8(v0, v1);
                    asm volatile("" ::: "memory");
                }
            }
    }
};
struct EpiRI {
    static constexpr bool PERM = true;
    const bf16_t* BC; bf16_t* LA; bf16_t* BV; const float* ba; const float* bx; const float* sp;
    __device__ __forceinline__ void operator()(EPI_ARGS) const {
        const int ch = u.pn * 128 + wc * 32 + 8 * fq;
#pragma unroll
        for (int n = 0; n < 2; ++n) {
            const f32x4 ba0 = *(const f32x4*)(ba + ch + 4 * n), bx0 = *(const f32x4*)(bx + ch + 4 * n), sp0 = *(const f32x4*)(sp + ch + 4 * n);
#pragma unroll
            for (int ai = 0; ai < 2; ++ai)
#pragma unroll
                for (int m = 0; m < 4; ++m) {
                    const int row = u.pm * 256 + ai * 128 + wr * 64 + m * 16 + fr;
                    const u32x2 xw = *(const u32x2*)(BC + (size_t)row * DRNN + ch + 4 * n);
                    const f32x4 xc = (f32x4){bf_lo(xw.x), bf_hi(xw.x), bf_lo(xw.y), bf_hi(xw.y)};
                    const f32x4 r0 = sigm4(acc[ai][0][m][n] + ba0), i0 = sigm4(acc[ai][1][m][n] + bx0);
                    const f32x4 la0 = r0 * sp0; f32x4 b0;
#pragma unroll
                    for (int j = 0; j < 4; ++j) { const float x = -2.f * la0[j];
                        const float em = x < 0.03f ? x * (1.f - x * (0.5f - x * (0.16666667f - x * 0.041666668f))) : 1.f - __expf(-x);
                        b0[j] = __builtin_sqrtf(em) * i0[j] * xc[j]; }
                    u32x2 wl, wb; wl.x = pk2(la0[0], la0[1]); wl.y = pk2(la0[2], la0[3]); wb.x = pk2(b0[0], b0[1]); wb.y = pk2(b0[2], b0[3]);
                    *(u32x2*)(LA + (size_t)row * DRNN + ch + 4 * n) = wl;
                    *(u32x2*)(BV + (size_t)row * DRNN + ch + 4 * n) = wb;
                    asm volatile("" ::: "memory");
                }
        }
    }
};
struct EpiG {
    static constexpr bool PERM = true;
    bf16_t* G;
    __device__ __forceinline__ void operator()(EPI_ARGS) const {
#pragma unroll
        for (int ai = 0; ai < 2; ++ai)
#pragma unroll
            for (int m = 0; m < 4; ++m) {
                const int row = u.pm * 256 + ai * 128 + wr * 64 + m * 16 + fr;
#pragma unroll
                for (int bj = 0; bj < 2; ++bj) {
                    const int c = u.pn * 256 + bj * 128 + wc * 32 + 8 * fq;
                    *(u32x4*)(G + (size_t)row * 3072 + c) = pack8(sigm4(acc[ai][bj][m][0]), sigm4(acc[ai][bj][m][1]));
                    asm volatile("" ::: "memory");
                }
            }
    }
};
struct EpiP {
    static constexpr bool PERM = true;
    bf16_t* G; int goff;
    __device__ __forceinline__ void operator()(EPI_ARGS) const {
#pragma unroll
        for (int ai = 0; ai < 2; ++ai)
#pragma unroll
            for (int m = 0; m < 4; ++m) {
                const int row = u.pm * 256 + ai * 128 + wr * 64 + m * 16 + fr;
#pragma unroll
                for (int bj = 0; bj < 2; ++bj) {
                    const int c = goff + u.pn * 256 + bj * 128 + wc * 32 + 8 * fq;
                    u32x4* p = (u32x4*)(G + (size_t)row * 3072 + c);
                    const F8 gt = unpack8(*p);
                    *p = pack8(gt.a * acc[ai][bj][m][0], gt.b * acc[ai][bj][m][1]);
                    asm volatile("" ::: "memory");
                }
            }
    }
};
struct EpiX {
    static constexpr bool PERM = false;
    const float* xin_p; const float* xin_s; float* xout;
    __device__ __forceinline__ void operator()(EPI_ARGS) const {
#pragma unroll
        for (int ai = 0; ai < 2; ++ai)
#pragma unroll
            for (int m = 0; m < 4; ++m) {
                const int row = u.pm * 256 + ai * 128 + wr * 64 + m * 16 + fr;
                if (row < MROWS) {
                    const float* src = row < MPR ? xin_p + (size_t)row * DM : xin_s + (size_t)(row - MPR) * DM;
                    float* dst = xout + (size_t)row * DM;
#pragma unroll
                    for (int bj = 0; bj < 2; ++bj)
#pragma unroll
                        for (int n = 0; n < 2; ++n) {
                            const int c = u.pn * 256 + bj * 128 + wc * 32 + 16 * n + 4 * fq;
                            *(f32x4*)(dst + c) = *(const f32x4*)(src + c) + acc[ai][bj][m][n];
                        }
                    asm volatile("" ::: "memory");
                }
            }
    }
};
struct EpiGpre {
    static constexpr bool PERM = true;
    bf16_t* GP; float* out; int l;
    __device__ __forceinline__ void operator()(EPI_ARGS) const {
        const bool st = ((u.pm & 7) == 7) || u.pm == 64;
#pragma unroll
        for (int ai = 0; ai < 2; ++ai)
#pragma unroll
            for (int m = 0; m < 4; ++m) {
                const int row = u.pm * 256 + ai * 128 + wr * 64 + m * 16 + fr;
#pragma unroll
                for (int bj = 0; bj < 2; ++bj) {
                    const f32x4 v0 = acc[ai][bj][m][0], v1 = acc[ai][bj][m][1];
                    const int c = u.pn * 256 + bj * 128 + wc * 32 + 8 * fq;
                    if (st) {
                        float* o = nullptr;
                        if (row < MPR) { const int t = row & 2047, b = row >> 11; if (t >= 2046) o = out + O_FF_P + ((size_t)(l * NB + b) * 2 + (t - 2046)) * DFF + c; }
                        else if (row < MROWS) { const int s = row - MPR; o = out + O_FF_S + ((size_t)(l * NS + s) * 2 + 1) * DFF + c; }
                        if (o) { *(f32x4*)o = v0; *(f32x4*)(o + 4) = v1; }
                    }
                    *(u32x4*)(GP + (size_t)row * 3072 + c) = pack8(v0, v1);
                    asm volatile("" ::: "memory");
                }
            }
    }
};
struct EpiH {
    static constexpr bool PERM = true;
    const bf16_t* GP; bf16_t* H; const float* cw; const float* cb; const float* st;
    __device__ __forceinline__ void operator()(EPI_ARGS) const {
#pragma unroll
        for (int bj = 0; bj < 2; ++bj) {
            const int c = u.pn * 256 + bj * 128 + wc * 32 + 8 * fq;
            const f32x4 w00 = *(const f32x4*)(cw + c), w01 = *(const f32x4*)(cw + c + 4);
            const f32x4 w10 = *(const f32x4*)(cw + DFF + c), w11 = *(const f32x4*)(cw + DFF + c + 4);
            const f32x4 w20 = *(const f32x4*)(cw + 2 * DFF + c), w21 = *(const f32x4*)(cw + 2 * DFF + c + 4);
            const f32x4 cb0 = *(const f32x4*)(cb + c), cb1 = *(const f32x4*)(cb + c + 4);
#pragma unroll
            for (int ai = 0; ai < 2; ++ai)
#pragma unroll
                for (int m = 0; m < 4; ++m) {
                    const int row = u.pm * 256 + ai * 128 + wr * 64 + m * 16 + fr;
                    const F8 g0 = unpack8(*(const u32x4*)(GP + (size_t)row * 3072 + c));
                    f32x4 s0 = cb0 + w20 * g0.a, s1 = cb1 + w21 * g0.b;
                    if (row < MPR) { const int t = row & 2047;
                        if (t >= 1) { const F8 g1 = unpack8(*(const u32x4*)(GP + (size_t)(row - 1) * 3072 + c)); s0 += w10 * g1.a; s1 += w11 * g1.b; }
                        if (t >= 2) { const F8 g2 = unpack8(*(const u32x4*)(GP + (size_t)(row - 2) * 3072 + c)); s0 += w00 * g2.a; s1 += w01 * g2.b; } }
                    else if (row < MROWS) { const float* sp = st + (size_t)(row - MPR) * 2 * DFF + c;
                        s0 += w00 * *(const f32x4*)sp + w10 * *(const f32x4*)(sp + DFF); s1 += w01 * *(const f32x4*)(sp + 4) + w11 * *(const f32x4*)(sp + DFF + 4); }
                    *(u32x4*)(H + (size_t)row * 3072 + c) = pack8(gelu4(s0) * acc[ai][bj][m][0], gelu4(s1) * acc[ai][bj][m][1]);
                    asm volatile("" ::: "memory");
                }
        }
    }
};

__device__ __forceinline__ void transpose_item(const float* W, int K, int N, bf16_t* WT, LAS float* scr, int item, int lane) {
    const int nblk = N / 32, kb = item / nblk, nb = item % nblk, k0 = 64 * kb, n0 = 32 * nb;
#pragma unroll 8
    for (int i = 0; i < 32; ++i) { const int kk = 2 * i + (lane >> 5); scr[kk * 33 + (lane & 31)] = W[(size_t)(k0 + kk) * N + n0 + (lane & 31)]; }
    asm volatile("s_waitcnt lgkmcnt(0)" ::: "memory");
    const int c = lane & 7;
#pragma unroll
    for (int j = 0; j < 4; ++j) { const int n = (lane >> 3) + 8 * j; const LAS float* s = scr + (8 * c) * 33 + n;
        u32x4 o; o.x = pk2(s[0 * 33], s[1 * 33]); o.y = pk2(s[2 * 33], s[3 * 33]); o.z = pk2(s[4 * 33], s[5 * 33]); o.w = pk2(s[6 * 33], s[7 * 33]);
        *(u32x4*)(WT + (size_t)(n0 + n) * K + k0 + 8 * c) = o; }
    asm volatile("s_waitcnt lgkmcnt(0)" ::: "memory");
}
__device__ __forceinline__ void rms_row_bf16(const float* xrow, const float* g, bf16_t* orow, int lane) {
    const f32x4* xr = (const f32x4*)xrow + lane; f32x4 v[4]; float s = 0.f;
#pragma unroll
    for (int j = 0; j < 4; ++j) { v[j] = xr[64 * j]; s += (v[j][0] * v[j][0] + v[j][1] * v[j][1]) + (v[j][2] * v[j][2] + v[j][3] * v[j][3]); }
    const float rstd = rsqrtf(wave_sum(s) * (1.f / DM) + 1e-6f);
    const f32x4* gr = (const f32x4*)g + lane; u32x2* o8 = (u32x2*)orow + lane;
#pragma unroll
    for (int j = 0; j < 4; ++j) { const f32x4 o = v[j] * rstd * gr[64 * j]; u32x2 w; w.x = pk2(o[0], o[1]); w.y = pk2(o[2], o[3]); o8[64 * j] = w; }
}
__device__ __forceinline__ void rms_rows(const float* xp, const float* xs, const float* g, bf16_t* XN, int gw, int ngw, int lane) {
    for (int row = gw; row < MPAD; row += ngw) {
        if (row < MROWS) rms_row_bf16(row < MPR ? xp + (size_t)row * DM : xs + (size_t)(row - MPR) * DM, g, XN + (size_t)row * DM, lane);
        else { u32x2* o8 = (u32x2*)(XN + (size_t)row * DM) + lane; u32x2 z; z.x = 0u; z.y = 0u;
#pragma unroll
            for (int j = 0; j < 4; ++j) o8[64 * j] = z; }
    }
}

__device__ __forceinline__ void phase_prep(const Params& p, int l, LAS unsigned char* lds, const float* xp, const float* xs, int bid, int G) {
    int tid = threadIdx.x; asm volatile("" : "+v"(tid));
    const int wave = tid >> 6, lane = tid & 63;
    const int gw = bid * 8 + wave, ngw = G * 8;
    bf16_t* W = (bf16_t*)(p.ws + WS_W);
    LAS float* scr = (LAS float*)(lds + wave * 8448);
    const float* w_in = p.in[7] + (size_t)l * DM * INCOLS; const float* w_pb = p.in[21] + (size_t)l * DRNN * DM; const float* w_pc = p.in[22] + (size_t)l * DCH * DM;
    const float* w_o = p.in[23] + (size_t)l * DM * DM; const float* wg = p.in[25] + (size_t)l * DM * DFF; const float* wu = p.in[26] + (size_t)l * DM * DFF; const float* wd = p.in[29] + (size_t)l * DFF * DM;
    constexpr int I_IN = (DM / 64) * (INCOLS / 32), I_PB = (DRNN / 64) * (DM / 32), I_PC = (DCH / 64) * (DM / 32), I_O = (DM / 64) * (DM / 32), I_G = (DM / 64) * (DFF / 32), I_D = (DFF / 64) * (DM / 32);
    constexpr int NITEMS = I_IN + I_PB + I_PC + I_O + 2 * I_G + I_D;
    for (int it = gw; it < NITEMS; it += ngw) {
        int r = it;
        if (r < I_IN) { transpose_item(w_in, DM, INCOLS, W + W_IN, scr, r, lane); continue; } r -= I_IN;
        if (r < I_PB) { transpose_item(w_pb, DRNN, DM, W + W_PB, scr, r, lane); continue; } r -= I_PB;
        if (r < I_PC) { transpose_item(w_pc, DCH, DM, W + W_PC, scr, r, lane); continue; } r -= I_PC;
        if (r < I_O) { transpose_item(w_o, DM, DM, W + W_O, scr, r, lane); continue; } r -= I_O;
        if (r < I_G) { transpose_item(wg, DM, DFF, W + W_G, scr, r, lane); continue; } r -= I_G;
        if (r < I_G) { transpose_item(wu, DM, DFF, W + W_U, scr, r, lane); continue; } r -= I_G;
        transpose_item(wd, DFF, DM, W + W_D, scr, r, lane);
    }
    const int gt = bid * 512 + tid, ngt = G * 512;
    { const float* pw = p.in[8] + (size_t)l * 4 * 128 * 128; const float* ps = p.in[9] + (size_t)l * DPOOL; const float* w_pa = p.in[20] + (size_t)l * DPOOL * DM;
      for (int idx = gt; idx < DPOOL * DM; idx += ngt) { const int n = idx & 1023, kp = idx >> 10, g = kp >> 7;
          const float* pr = pw + (size_t)kp * 128; const float* sr = ps + g * 128; const float* wr_ = w_pa + (size_t)g * 128 * DM + n; float s = 0.f;
#pragma unroll 8
          for (int j = 0; j < 128; ++j) s += pr[j] * sr[j] * wr_[(size_t)j * DM];
          W[W_PA + (size_t)n * DPOOL + kp] = f2bf(s); } }
    { const float* wa = p.in[12] + (size_t)l * 8 * 128 * 128; const float* wx = p.in[14] + (size_t)l * 8 * 128 * 128;
      for (int idx = gt; idx < 8 * 256 * 256; idx += ngt) { const int k = idx & 255, n = (idx >> 8) & 255, h = idx >> 16; float v = 0.f;
          if ((k >> 7) == (h & 1)) v = (n < 128 ? wa : wx)[((size_t)h * 128 + (k & 127)) * 128 + (n & 127)];
          W[W_RI + idx] = f2bf(v); } }
    if (gt < DRNN) ((float*)(p.ws + WS_SP))[gt] = -8.f * log1pf(__expf(-p.in[16][(size_t)l * DRNN + gt]));
    rms_rows(xp, xs, p.in[6] + (size_t)l * DM, (bf16_t*)(p.ws + WS_XN), gw, ngw, lane);
}

__device__ __forceinline__ void phase_mix(const Params& p, int l, LAS unsigned char* lds, int bid, int G) {
    int tid = threadIdx.x; asm volatile("" : "+v"(tid));
    const int wave = tid >> 6, lane = tid & 63;
    const bf16_t* Za = (const bf16_t*)(p.ws + WS_Z); const bf16_t* Zbx = Za + UE; const bf16_t* Zgu = Za + 5 * UE; const bf16_t* Zgv = Za + 6 * UE;
    bf16_t* Y0 = (bf16_t*)(p.ws + WS_Y); bf16_t* Yd = Y0 + 2 * UE; bf16_t* Yc = Y0 + 3 * UE;
    const float* vg = p.in[17] + (size_t)l * DCH; const float* cws = p.in[18] + (size_t)l * 4 * 128 * 128; const float* cbs = p.in[19] + (size_t)l * 4 * 128;
    if (bid < 128) {
        const int r0 = bid * 128;
        LAS float* rstd = (LAS float*)lds; LAS bf16_t* VT = (LAS bf16_t*)(lds + 1024);
        { const int j = tid >> 2, q = tid & 3; const u32x4* src = (const u32x4*)(Zgv + (size_t)(r0 + j) * DCH + q * 128); float s = 0.f;
#pragma unroll
          for (int i = 0; i < 16; ++i) { const F8 v = unpack8(src[i]); s += (v.a[0] * v.a[0] + v.a[1] * v.a[1]) + (v.a[2] * v.a[2] + v.a[3] * v.a[3]) + (v.b[0] * v.b[0] + v.b[1] * v.b[1]) + (v.b[2] * v.b[2] + v.b[3] * v.b[3]); }
          s += __shfl_xor(s, 1); s += __shfl_xor(s, 2);
          if (q == 0) rstd[j] = rsqrtf(s * (1.f / DCH) + 1e-6f); }
        __syncthreads();
        const int fr = lane & 15, fq = lane >> 4;
        for (int g = 0; g < 4; ++g) {
            { const int j = tid >> 2, q = tid & 3; const float rs = rstd[j];
              const u32x4* src = (const u32x4*)(Zgv + (size_t)(r0 + j) * DCH + g * 128 + q * 32); const float* gg = vg + g * 128 + q * 32;
#pragma unroll
              for (int i = 0; i < 4; ++i) { const F8 v = unpack8(src[i]); const f32x4 g0 = *(const f32x4*)(gg + 8 * i), g1 = *(const f32x4*)(gg + 8 * i + 4);
                  const int d = q * 32 + 8 * i;
#pragma unroll
                  for (int e = 0; e < 4; ++e) { VT[(d + e) * 136 + j] = f2bf(v.a[e] * rs * g0[e]); VT[(d + 4 + e) * 136 + j] = f2bf(v.b[e] * rs * g1[e]); } } }
            __syncthreads();
            const int i = 16 * wave + fr; bf16x8 af[4];
#pragma unroll
            for (int ks = 0; ks < 4; ++ks) { const int k0 = 32 * ks + 8 * fq; const float* wrow = cws + ((size_t)g * 128 + i) * 128 + k0;
                const f32x4 a0 = *(const f32x4*)wrow, a1 = *(const f32x4*)(wrow + 4); u32x4 w;
                w.x = pk2(k0 + 0 <= i ? a0[0] : 0.f, k0 + 1 <= i ? a0[1] : 0.f); w.y = pk2(k0 + 2 <= i ? a0[2] : 0.f, k0 + 3 <= i ? a0[3] : 0.f);
                w.z = pk2(k0 + 4 <= i ? a1[0] : 0.f, k0 + 5 <= i ? a1[1] : 0.f); w.w = pk2(k0 + 6 <= i ? a1[2] : 0.f, k0 + 7 <= i ? a1[3] : 0.f);
                af[ks] = __builtin_bit_cast(bf16x8, w); }
            const float bsv = cbs[g * 128 + i];
#pragma unroll
            for (int dt = 0; dt < 8; ++dt) {
                f32x4 c4 = (f32x4){0.f, 0.f, 0.f, 0.f};
#pragma unroll
                for (int ks = 0; ks < 4; ++ks) { const bf16x8 vf = *(const LAS bf16x8*)(VT + (16 * dt + fr) * 136 + 32 * ks + 8 * fq);
                    c4 = __builtin_amdgcn_mfma_f32_16x16x32_bf16(vf, af[ks], c4, 0, 0, 0); }
                const size_t off = (size_t)(r0 + i) * DCH + g * 128 + 16 * dt + 4 * fq;
                const u32x2 uu = *(const u32x2*)(Zgu + off); u32x2 o;
                o.x = pk2(bf_lo(uu.x) * (c4[0] + bsv), bf_hi(uu.x) * (c4[1] + bsv)); o.y = pk2(bf_lo(uu.y) * (c4[2] + bsv), bf_hi(uu.y) * (c4[3] + bsv));
                *(u32x2*)(Yc + off) = o;
            }
            __syncthreads();
        }
    } else if (bid < 144) {
        const int s = (bid - 128) * 8 + wave, row = MPR + s, c = lane * 8, g = lane >> 4;
        const F8 v = unpack8(*(const u32x4*)(Zgv + (size_t)row * DCH + c));
        float ss = (v.a[0] * v.a[0] + v.a[1] * v.a[1]) + (v.a[2] * v.a[2] + v.a[3] * v.a[3]) + (v.b[0] * v.b[0] + v.b[1] * v.b[1]) + (v.b[2] * v.b[2] + v.b[3] * v.b[3]);
        const float rs = rsqrtf(wave_sum(ss) * (1.f / DCH) + 1e-6f);
        const f32x4 vn0 = v.a * rs * *(const f32x4*)(vg + c), vn1 = v.b * rs * *(const f32x4*)(vg + c + 4);
        float* ov = p.out + O_CV_S + ((size_t)l * NS + s) * DCH + c; *(f32x4*)ov = vn0; *(f32x4*)(ov + 4) = vn1;
        const float w00 = cws[(size_t)g * 128 * 128], b0 = cbs[g * 128];
        const F8 uu = unpack8(*(const u32x4*)(Zgu + (size_t)row * DCH + c));
        *(u32x4*)(Yc + (size_t)row * DCH + c) = pack8(uu.a * (vn0 * w00 + b0), uu.b * (vn1 * w00 + b0));
    }
    if (bid >= 128) {
    const int et = (bid - 128) * 512 + tid, net = (G - 128) * 512;
    { const float* cw = p.in[10] + (size_t)l * 4 * DRNN; const float* cb = p.in[11] + (size_t)l * DRNN; const float* st = p.in[3] + (size_t)l * NS * 3 * DRNN;
      for (int idx = et; idx < (MPR / 8) * 128; idx += net) { const int r0 = (idx >> 7) * 8, c = (idx & 127) * 8, t0 = r0 & 2047;
          const f32x4 w00 = *(const f32x4*)(cw + c), w01 = *(const f32x4*)(cw + c + 4), w10 = *(const f32x4*)(cw + DRNN + c), w11 = *(const f32x4*)(cw + DRNN + c + 4);
          const f32x4 w20 = *(const f32x4*)(cw + 2 * DRNN + c), w21 = *(const f32x4*)(cw + 2 * DRNN + c + 4), w30 = *(const f32x4*)(cw + 3 * DRNN + c), w31 = *(const f32x4*)(cw + 3 * DRNN + c + 4);
          const f32x4 b0 = *(const f32x4*)(cb + c), b1 = *(const f32x4*)(cb + c + 4);
          F8 x1, x2, x3; const u32x4 zz = (u32x4){0u, 0u, 0u, 0u};
          x3 = unpack8(t0 >= 3 ? *(const u32x4*)(Zbx + (size_t)(r0 - 3) * DRNN + c) : zz); x2 = unpack8(t0 >= 2 ? *(const u32x4*)(Zbx + (size_t)(r0 - 2) * DRNN + c) : zz); x1 = unpack8(t0 >= 1 ? *(const u32x4*)(Zbx + (size_t)(r0 - 1) * DRNN + c) : zz);
#pragma unroll
          for (int i = 0; i < 8; ++i) { const F8 x0 = unpack8(*(const u32x4*)(Zbx + (size_t)(r0 + i) * DRNN + c));
              *(u32x4*)(Y0 + (size_t)(r0 + i) * DRNN + c) = pack8(b0 + w30 * x0.a + w20 * x1.a + w10 * x2.a + w00 * x3.a, b1 + w31 * x0.b + w21 * x1.b + w11 * x2.b + w01 * x3.b);
              x3 = x2; x2 = x1; x1 = x0; } }
      for (int idx = et; idx < NS * 128; idx += net) { const int row = MPR + (idx >> 7), c = (idx & 127) * 8;
          f32x4 s0 = *(const f32x4*)(cb + c), s1 = *(const f32x4*)(cb + c + 4);
          { const F8 x = unpack8(*(const u32x4*)(Zbx + (size_t)row * DRNN + c)); s0 += *(const f32x4*)(cw + 3 * DRNN + c) * x.a; s1 += *(const f32x4*)(cw + 3 * DRNN + c + 4) * x.b; }
          const float* sp = st + (size_t)(row - MPR) * 3 * DRNN + c;
#pragma unroll
          for (int k = 0; k < 3; ++k) { s0 += *(const f32x4*)(cw + k * DRNN + c) * *(const f32x4*)(sp + k * DRNN); s1 += *(const f32x4*)(cw + k * DRNN + c + 4) * *(const f32x4*)(sp + k * DRNN + 4); }
          *(u32x4*)(Y0 + (size_t)row * DRNN + c) = pack8(s0, s1); } }
    { const float* st = p.in[2] + (size_t)l * NS * 15 * DPOOL;
      for (int idx = et; idx < (MPR / 8) * 64; idx += net) { const int g = (idx >> 6) & 3, rb = ((idx >> 8) << 2) + ((idx >> 4) & 3), c = g * 128 + (idx & 15) * 8, w = 2 << g, r0 = rb * 8, t0 = r0 & 2047;
          f32x4 s0 = (f32x4){0.f, 0.f, 0.f, 0.f}, s1 = s0;
#pragma unroll
          for (int j = 1; j < 16; ++j) if (j < w && t0 >= j) { const F8 x = unpack8(*(const u32x4*)(Za + (size_t)(r0 - j) * DPOOL + c)); s0 += x.a; s1 += x.b; }
#pragma unroll
          for (int i = 0; i < 8; ++i) { const F8 cur = unpack8(*(const u32x4*)(Za + (size_t)(r0 + i) * DPOOL + c)); s0 += cur.a; s1 += cur.b;
              const int t = t0 + i; const float ic = 1.f / (float)(t + 1 < w ? t + 1 : w);
              *(u32x4*)(Yd + (size_t)(r0 + i) * DPOOL + c) = pack8(s0 * ic - cur.a, s1 * ic - cur.b);
              if (t >= w - 1) { const F8 old = unpack8(*(const u32x4*)(Za + (size_t)(r0 + i - (w - 1)) * DPOOL + c)); s0 -= old.a; s1 -= old.b; } } }
      for (int idx = et; idx < NS * 64; idx += net) { const int row = MPR + (idx >> 6), c = (idx & 63) * 8, w = 2 << (c >> 7);
          const F8 cur = unpack8(*(const u32x4*)(Za + (size_t)row * DPOOL + c)); f32x4 s0 = cur.a, s1 = cur.b;
          const float* sp = st + (size_t)(row - MPR) * 15 * DPOOL + c;
          for (int j = 1; j < w; ++j) { s0 += *(const f32x4*)(sp + (15 - j) * DPOOL); s1 += *(const f32x4*)(sp + (15 - j) * DPOOL + 4); }
          const float ic = 1.f / (float)w;
          *(u32x4*)(Yd + (size_t)row * DPOOL + c) = pack8(s0 * ic - cur.a, s1 * ic - cur.b); } }
    }
    const int gt = bid * 512 + tid, ngt = G * 512;
    { const float* sp = p.in[2] + (size_t)l * NS * 15 * DPOOL; float* o = p.out + O_POOL_S + (size_t)l * NS * 15 * DPOOL;
      for (int idx = gt; idx < NS * 14 * (DPOOL / 4); idx += ngt) { const int c = (idx & 127) * 4, r = (idx >> 7) % 14, s = (idx >> 7) / 14;
          *(f32x4*)(o + ((size_t)s * 15 + r) * DPOOL + c) = *(const f32x4*)(sp + ((size_t)s * 15 + r + 1) * DPOOL + c); } }
    { const float* sp = p.in[3] + (size_t)l * NS * 3 * DRNN; float* o = p.out + O_RC_S + (size_t)l * NS * 3 * DRNN;
      for (int idx = gt; idx < NS * 2 * (DRNN / 4); idx += ngt) { const int c = (idx & 255) * 4, r = (idx >> 8) & 1, s = idx >> 9;
          *(f32x4*)(o + ((size_t)s * 3 + r) * DRNN + c) = *(const f32x4*)(sp + ((size_t)s * 3 + r + 1) * DRNN + c); } }
    { const float* sp = p.in[5] + (size_t)l * NS * 2 * DFF; float* o = p.out + O_FF_S + (size_t)l * NS * 2 * DFF;
      for (int idx = gt; idx < NS * (DFF / 4); idx += ngt) { const int c = (idx % 768) * 4, s = idx / 768;
          *(f32x4*)(o + ((size_t)s * 2) * DFF + c) = *(const f32x4*)(sp + ((size_t)s * 2 + 1) * DFF + c); } }
}

__device__ __forceinline__ void phase_scan(const Params& p, int l, LAS unsigned char* lds, int bid, int G) {
    int tid = threadIdx.x; asm volatile("" : "+v"(tid));
    const bf16_t* LA = (const bf16_t*)(p.ws + WS_Z) + UE; const bf16_t* BV = (const bf16_t*)(p.ws + WS_Z) + 5 * UE; const bf16_t* GB = (const bf16_t*)(p.ws + WS_Z) + 3 * UE;
    bf16_t* Y0 = (bf16_t*)(p.ws + WS_Y);
    LAS float* sP = (LAS float*)lds; LAS float* sH = sP + 4096; LAS float* sC = sH + 4096; LAS float* sPg = sC + 4096; LAS float* sHg = sPg + 512;
    for (int item = bid; item < 256; item += G) {
        const int b = item >> 5, c0 = (item & 31) * 32, seg = tid >> 2, lg = tid & 3;
        const size_t base = ((size_t)b * SEQ + seg * 16) * DRNN + c0 + lg * 8;
        f32x4 P0 = (f32x4){1.f, 1.f, 1.f, 1.f}, P1 = P0, h0 = (f32x4){0.f, 0.f, 0.f, 0.f}, h1 = h0;
#pragma unroll
        for (int t = 0; t < 16; ++t) { const F8 la = unpack8(*(const u32x4*)(LA + base + (size_t)t * DRNN)), bv = unpack8(*(const u32x4*)(BV + base + (size_t)t * DRNN));
            f32x4 a0, a1;
#pragma unroll
            for (int e = 0; e < 4; ++e) { a0[e] = __builtin_amdgcn_exp2f(1.442695041f * la.a[e]); a1[e] = __builtin_amdgcn_exp2f(1.442695041f * la.b[e]); }
            h0 = a0 * h0 + bv.a; h1 = a1 * h1 + bv.b; P0 *= a0; P1 *= a1; }
        { const int o = seg * 32 + lg * 8; *(LAS f32x4*)(sP + o) = P0; *(LAS f32x4*)(sP + o + 4) = P1; *(LAS f32x4*)(sH + o) = h0; *(LAS f32x4*)(sH + o + 4) = h1; }
        __syncthreads();
        const int ch = tid & 31, sg = tid >> 5;
        { float Pg = 1.f, hg = 0.f;
#pragma unroll
          for (int k = 0; k < 8; ++k) { const float pp = sP[(sg * 8 + k) * 32 + ch], hh = sH[(sg * 8 + k) * 32 + ch]; hg = pp * hg + hh; Pg *= pp; }
          sPg[sg * 32 + ch] = Pg; sHg[sg * 32 + ch] = hg; }
        __syncthreads();
        { float carry = 0.f;
          for (int k = 0; k < sg; ++k) carry = sPg[k * 32 + ch] * carry + sHg[k * 32 + ch];
#pragma unroll
          for (int k = 0; k < 8; ++k) { const int o = (sg * 8 + k) * 32 + ch; sC[o] = carry; carry = sP[o] * carry + sH[o]; }
          if (sg == 15) p.out[O_H_P + ((size_t)l * NB + b) * DRNN + c0 + ch] = carry; }
        __syncthreads();
        { const int o = seg * 32 + lg * 8; h0 = *(LAS f32x4*)(sC + o); h1 = *(LAS f32x4*)(sC + o + 4); }
#pragma unroll
        for (int t = 0; t < 16; ++t) { const F8 la = unpack8(*(const u32x4*)(LA + base + (size_t)t * DRNN)), bv = unpack8(*(const u32x4*)(BV + base + (size_t)t * DRNN)), gt = unpack8(*(const u32x4*)(GB + base + (size_t)t * DRNN));
            f32x4 a0, a1;
#pragma unroll
            for (int e = 0; e < 4; ++e) { a0[e] = __builtin_amdgcn_exp2f(1.442695041f * la.a[e]); a1[e] = __builtin_amdgcn_exp2f(1.442695041f * la.b[e]); }
            h0 = a0 * h0 + bv.a; h1 = a1 * h1 + bv.b;
            *(u32x4*)(Y0 + base + (size_t)t * DRNN) = pack8(gt.a * h0, gt.b * h1); }
        __syncthreads();
    }
    { const float* hin = p.in[4] + (size_t)l * NS * DRNN; float* oh = p.out + O_H_S + (size_t)l * NS * DRNN;
      for (int idx = bid * 512 + tid; idx < NS * DRNN; idx += G * 512) { const size_t off = (size_t)MPR * DRNN + idx;
          const float a = __expf(bf2f(LA[off])), h = a * hin[idx] + bf2f(BV[off]); oh[idx] = h; Y0[off] = f2bf(bf2f(GB[off]) * h); } }
}

__device__ __forceinline__ void phase_merge(const Params& p, int bid, int NG) {
    const bf16_t* G = (const bf16_t*)(p.ws + WS_Z); bf16_t* XN = (bf16_t*)(p.ws + WS_XN);
    int tid = threadIdx.x; asm volatile("" : "+v"(tid));
    for (int idx = bid * 512 + tid; idx < MPAD * 128; idx += NG * 512) { const int row = idx >> 7, c = (idx & 127) * 8;
        const bf16_t* gr = G + (size_t)row * 3072 + c; const F8 a = unpack8(*(const u32x4*)gr), b = unpack8(*(const u32x4*)(gr + 1024)), d = unpack8(*(const u32x4*)(gr + 2048));
        *(u32x4*)(XN + (size_t)row * DM + c) = pack8(a.a + b.a + d.a, a.b + b.b + d.b); }
}

__device__ __forceinline__ void phase_final(const Params& p, int bid, int G) {
    int tid = threadIdx.x; asm volatile("" : "+v"(tid));
    const int wave = tid >> 6, lane = tid & 63; const float* g = p.in[30];
    for (int row = bid * 8 + wave; row < MROWS; row += G * 8) {
        f32x4* xr = (f32x4*)(p.out + (size_t)row * DM) + lane; f32x4 v[4]; float s = 0.f;
#pragma unroll
        for (int j = 0; j < 4; ++j) { v[j] = xr[64 * j]; s += (v[j][0] * v[j][0] + v[j][1] * v[j][1]) + (v[j][2] * v[j][2] + v[j][3] * v[j][3]); }
        const float rstd = rsqrtf(wave_sum(s) * (1.f / DM) + 1e-6f); const f32x4* gr = (const f32x4*)g + lane;
#pragma unroll
        for (int j = 0; j < 4; ++j) xr[64 * j] = v[j] * rstd * gr[64 * j];
    }
}


#define XB_TMO      128
#define XB_XCNT(j)  (256  + 64 * (j))
#define XB_XSUB(j)  (1280 + 64 * (j))
#define XB_XGEN(j)  (2304 + 64 * (j))
#define XB_TOP      3328
#define XB_TOPGEN   3392
#define XCD_BAR_WORDS 3456
#define XB_SPIN_CAP (1u << 18)
__device__ __forceinline__ unsigned xb_ld(unsigned* p)              { return __hip_atomic_load(p, __ATOMIC_RELAXED, __HIP_MEMORY_SCOPE_AGENT); }
__device__ __forceinline__ unsigned xb_add(unsigned* p, unsigned v) { return __hip_atomic_fetch_add(p, v, __ATOMIC_RELAXED, __HIP_MEMORY_SCOPE_AGENT); }
__device__ __forceinline__ unsigned xb_xcc_id() { return (unsigned)__builtin_amdgcn_s_getreg((3 << 11) | 20) & 0xFu; }
#define XB_SPIN(cond, bar) do { unsigned _sp = 0; while (cond) { __builtin_amdgcn_s_sleep(1); \
    if ((++_sp & 255u) == 0u) { if (xb_ld(&(bar)[XB_TMO])) break; if (_sp > XB_SPIN_CAP) { atomicAdd(&(bar)[XB_TMO], 1u); break; } } } } while (0)
__device__ __forceinline__ void xcd_barrier_complete(unsigned* bar, unsigned x, unsigned G, unsigned& nloc, unsigned& nx) {
    unsigned sum, cnt, mine, sp = 0u;
    for (;;) {
        sum = 0u; cnt = 0u; mine = 0u;
#pragma unroll
        for (unsigned j = 0; j < 16; ++j) { const unsigned c = xb_ld(&bar[XB_XCNT(j)]); sum += c; cnt += (c > 0u) ? 1u : 0u; mine = (j == x) ? c : mine; }
        if (sum == G) break;
        __builtin_amdgcn_s_sleep(1);
        if ((++sp & 255u) == 0u) { if (xb_ld(&bar[XB_TMO])) break; if (sp > XB_SPIN_CAP) { atomicAdd(&bar[XB_TMO], 1u); break; } }
    }
    nloc = mine > 0u ? mine : 1u; nx = cnt > 0u ? cnt : 1u;
}
__device__ __forceinline__ void xcd_barrier(unsigned* bar, volatile LAS unsigned* st, unsigned G) {
    asm volatile("s_waitcnt vmcnt(0)" ::: "memory");
    __syncthreads();
    if (threadIdx.x == 0) {
        const unsigned x = xb_xcc_id();
        __builtin_amdgcn_s_waitcnt(0);
        unsigned nloc = st[0], nx = st[1];
        if (nloc == 0u) { xcd_barrier_complete(bar, x, G, nloc, nx); st[0] = nloc; st[1] = nx; }
        const unsigned old = xb_add(&bar[XB_XSUB(x)], 1u);
        const unsigned gen = old / nloc;
        if (old + 1u == (gen + 1u) * nloc) {
            __builtin_amdgcn_fence(__ATOMIC_RELEASE, "agent");
            asm volatile("s_waitcnt vmcnt(0)" ::: "memory");
            const unsigned og = xb_add(&bar[XB_TOP], 1u);
            const unsigned tg = og / nx;
            if (og + 1u == (tg + 1u) * nx) xb_add(&bar[XB_TOPGEN], 1u);
            else XB_SPIN(xb_ld(&bar[XB_TOPGEN]) == tg, bar);
            __builtin_amdgcn_fence(__ATOMIC_ACQUIRE, "agent");
            xb_add(&bar[XB_XGEN(x)], 1u);
            asm volatile("s_waitcnt vmcnt(0)" ::: "memory");
        } else {
            XB_SPIN(xb_ld(&bar[XB_XGEN(x)]) == gen, bar);
            __builtin_amdgcn_fence(__ATOMIC_ACQUIRE, "agent");
            asm volatile("s_waitcnt vmcnt(0)" ::: "memory");
        }
    }
    __syncthreads();
}

__global__ void __launch_bounds__(512, 2) mega(Params pk) {
    extern __shared__ __attribute__((aligned(16))) unsigned char shm[];
    LAS unsigned char* lds = (LAS unsigned char*)shm;
    cg::grid_group grid = cg::this_grid();
    volatile LAS unsigned* bst = (volatile LAS unsigned*)(lds + 131072 + 1024);
    if (threadIdx.x < 2) bst[threadIdx.x] = 0u;
    if (blockIdx.x == 0) for (int i = threadIdx.x; i < XCD_BAR_WORDS; i += 512) ((unsigned*)(pk.ws + WS_BAR))[i] = 0u;
    __syncthreads();
    bool posted = false;
    for (int ph = pk.ph_lo; ph < pk.ph_hi; ++ph) {
        Params p = pk; int G = gridDim.x, bid = blockIdx.x;
        asm volatile("" : "+s"(p.ws), "+s"(p.out), "+s"(G), "+s"(bid));
        bf16_t* XN = (bf16_t*)(p.ws + WS_XN); bf16_t* Z = (bf16_t*)(p.ws + WS_Z); bf16_t* Y0 = (bf16_t*)(p.ws + WS_Y); bf16_t* W = (bf16_t*)(p.ws + WS_W); bf16_t* H = (bf16_t*)(p.ws + WS_H);
        if (ph == NPH - 1) { phase_final(p, bid, G); }
        else {
            const int l = ph / PH_PER_LAYER, k = ph % PH_PER_LAYER;
            const float* xp = l == 0 ? p.in[0] : p.out; const float* xs = l == 0 ? p.in[1] : p.out + (size_t)MPR * DM;
            pg8::Order S; pg8::Gemm g;
            for (int rep = ((REPMASK >> k) & 1u) ? 2 : 1; rep > 0; --rep)
            switch (k) {
            case 0: phase_prep(p, l, lds, xp, xs, bid, G); break;
            case 1: { S.init(NTM, ZC / 256, G, bid, 0); g = {XN, W + W_IN, DM, DM, DM}; EpiZ E{Z, p.out, l}; pg8::gemm_phase(lds, g, S, E); } break;
            case 2: phase_mix(p, l, lds, bid, G); break;
            case 3: { S.init(NTM, 8, G, bid, 1); g = {Y0, W + W_RI, DRNN, 256, 256};
                      EpiRI E{Y0, Z + UE, Z + 5 * UE, p.in[13] + (size_t)l * DRNN, p.in[15] + (size_t)l * DRNN, (const float*)(p.ws + WS_SP)}; pg8::gemm_phase(lds, g, S, E); } break;
            case 4: phase_scan(p, l, lds, bid, G); break;
            case 5: { S.init(NTM, 12, G, bid, 0); g = {XN, W + W_IN + (size_t)ZC * DM, DM, DM, DM}; EpiG E{Z}; pg8::gemm_phase(lds, g, S, E); } break;
            case 6: { { S.init(NTM, 4, G, bid, 0); g = {Y0 + 2 * UE, W + W_PA, DPOOL, DPOOL, DPOOL}; EpiP E{Z, 0}; pg8::gemm_phase(lds, g, S, E); }
                      { S.init(NTM, 4, G, (bid + 8) % G, 0); g = {Y0, W + W_PB, DRNN, DRNN, DRNN}; EpiP E{Z, 1024}; pg8::gemm_phase(lds, g, S, E); }
                      { S.init(NTM, 4, G, (bid + 16) % G, 0); g = {Y0 + 3 * UE, W + W_PC, DCH, DCH, DCH}; EpiP E{Z, 2048}; pg8::gemm_phase(lds, g, S, E); } } break;
            case 7: phase_merge(p, bid, G); break;
            case 8: { S.init(NTM, 4, G, bid, 0); g = {XN, W + W_O, DM, DM, DM}; EpiX E{xp, xs, p.out}; pg8::gemm_phase(lds, g, S, E); } break;
            case 9: { int tid = threadIdx.x; asm volatile("" : "+v"(tid)); const int wave = tid >> 6, lane = tid & 63; rms_rows(p.out, p.out + (size_t)MPR * DM, p.in[24] + (size_t)l * DM, XN, bid * 8 + wave, G * 8, lane); } break;
            case 10: { S.init(NTM, 12, G, bid, 0); g = {XN, W + W_G, DM, DM, DM}; EpiGpre E{Z, p.out, l}; pg8::gemm_phase(lds, g, S, E); } break;
            case 11: { S.init(NTM, 12, G, bid, 0); g = {XN, W + W_U, DM, DM, DM};
                       EpiH E{Z, H, p.in[27] + (size_t)l * 3 * DFF, p.in[28] + (size_t)l * DFF, p.in[5] + (size_t)l * NS * 2 * DFF}; pg8::gemm_phase(lds, g, S, E); } break;
            default: { S.init(NTM, 4, G, bid, 0); g = {H, W + W_D, DFF, DFF, DFF}; EpiX E{p.out, p.out + (size_t)MPR * DM, p.out}; pg8::gemm_phase(lds, g, S, E); } break;
            }
        }
        if (ph + 1 < pk.ph_hi) {
            if (!posted) {
                grid.sync(); posted = true;
                if (threadIdx.x == 0) (void)xb_add(&((unsigned*)(pk.ws + WS_BAR))[XB_XCNT(xb_xcc_id())], 1u);
            } else xcd_barrier((unsigned*)(pk.ws + WS_BAR), bst, (unsigned)gridDim.x);
            for (int e = 0; e < EXTRA_SYNCS; ++e) xcd_barrier((unsigned*)(pk.ws + WS_BAR), bst, (unsigned)gridDim.x);
        }
    }
}

extern "C" void kernel_launch(void* const* d_in, const int* in_sizes, int n_in, void* d_out, int out_size, void* d_ws, size_t ws_size, hipStream_t stream) {
    static int grid = 0;
    if (grid == 0) {
        int dev = 0, cus = 0, per_cu = 0;
        hipGetDevice(&dev);
        hipDeviceGetAttribute(&cus, hipDeviceAttributeMultiprocessorCount, dev);
        if (hipFuncSetAttribute((const void*)mega, hipFuncAttributeMaxDynamicSharedMemorySize, LDS_BYTES) != hipSuccess) fprintf(stderr, "kernel_launch: hipFuncSetAttribute failed\n");
        if (hipOccupancyMaxActiveBlocksPerMultiprocessor(&per_cu, (const void*)mega, 512, LDS_BYTES) != hipSuccess || per_cu < 1) { fprintf(stderr, "kernel_launch: occupancy query says %d blocks per CU\n", per_cu); per_cu = 1; }
        (void)hipGetLastError();
        grid = cus;
        if (n_in != 31 || ws_size < WS_END) fprintf(stderr, "kernel_launch: unexpected n_in %d / ws_size %zu (need %zu)\n", n_in, ws_size, (size_t)WS_END);
    }
    Params p{};
    for (int i = 0; i < 31; ++i) p.in[i] = (const float*)d_in[i];
    p.out = (float*)d_out; p.ws = (unsigned char*)d_ws; p.ph_lo = 0; p.ph_hi = NPH;
    void* args[] = {&p};
    hipError_t e = hipLaunchCooperativeKernel((const void*)mega, dim3(grid), dim3(512), args, LDS_BYTES, stream);
    if (e != hipSuccess) fprintf(stderr, "cooperative launch failed: %s (grid %d)\n", hipGetErrorString(e), grid);
}
```

```cpp
#include <hip/hip_runtime.h>
#include <hip/hip_cooperative_groups.h>
#include <cstdio>
#include <cstdint>
namespace cg = cooperative_groups;

#define LAS __attribute__((address_space(3)))
typedef unsigned short bf16_t;
typedef short bf16x8 __attribute__((ext_vector_type(8)));
typedef float f32x4 __attribute__((ext_vector_type(4)));
typedef float f32x2 __attribute__((ext_vector_type(2)));
typedef unsigned u32x4 __attribute__((ext_vector_type(4)));
typedef unsigned u32x2 __attribute__((ext_vector_type(2)));

constexpr int DM = 1024, NB = 8, SEQ = 2048, MPR = NB * SEQ, NS = 128, MROWS = MPR + NS, MPAD = 16640, NTM = MPAD / 256;
constexpr int DPOOL = 512, DRNN = 1024, DCH = 512, DFF = 3072, INCOLS = 6656, ZC = 3584;
constexpr int NLAYER = 2, PH_PER_LAYER = 13, NPH = NLAYER * PH_PER_LAYER + 1;
constexpr size_t O_Y = 0;
constexpr size_t O_POOL_P = (size_t)MROWS * DM;
constexpr size_t O_POOL_S = O_POOL_P + (size_t)2 * NB * 15 * DPOOL;
constexpr size_t O_RC_P = O_POOL_S + (size_t)2 * NS * 15 * DPOOL;
constexpr size_t O_RC_S = O_RC_P + (size_t)2 * NB * 3 * DRNN;
constexpr size_t O_H_P = O_RC_S + (size_t)2 * NS * 3 * DRNN;
constexpr size_t O_H_S = O_H_P + (size_t)2 * NB * DRNN;
constexpr size_t O_FF_P = O_H_S + (size_t)2 * NS * DRNN;
constexpr size_t O_FF_S = O_FF_P + (size_t)2 * NB * 2 * DFF;
constexpr size_t O_CV_S = O_FF_S + (size_t)2 * NS * 2 * DFF;
constexpr size_t UE = (size_t)MPAD * 512, UB = UE * 2;
constexpr size_t WS_BAR = 16384;
constexpr size_t WS_SP = 4096;
constexpr size_t WS_XN = 1u << 20;
constexpr size_t WS_Z = WS_XN + 2 * UB;
constexpr size_t WS_Y = WS_Z + 7 * UB;
constexpr size_t WS_W = WS_Y + 4 * UB;
constexpr size_t WS_H = WS_Z + 6 * UB;
constexpr size_t W_IN = 0;
constexpr size_t W_PA = W_IN + (size_t)INCOLS * DM;
constexpr size_t W_PB = W_PA + (size_t)DM * DPOOL;
constexpr size_t W_PC = W_PB + (size_t)DM * DRNN;
constexpr size_t W_O = W_PC + (size_t)DM * DCH;
constexpr size_t W_G = W_O + (size_t)DM * DM;
constexpr size_t W_U = W_G + (size_t)DFF * DM;
constexpr size_t W_D = W_U + (size_t)DFF * DM;
constexpr size_t W_RI = W_D + (size_t)DM * DFF;
constexpr size_t W_END = W_RI + (size_t)8 * 256 * 256;
constexpr size_t WS_END = WS_W + W_END * 2;
static_assert(WS_END <= (256u << 20), "workspace");
static_assert(WS_H + 6 * UB <= WS_W + (W_G)*2, "h overlay must not reach wg/wu/wd");
constexpr int LDS_BYTES = 131072 + 2048;
#ifndef REPMASK
#define REPMASK 0u
#endif
#ifndef EXTRA_SYNCS
#define EXTRA_SYNCS 0
#endif

struct Params { const float* in[31]; float* out; unsigned char* ws; int ph_lo, ph_hi; };

__device__ __forceinline__ float bf_lo(unsigned w) { return __builtin_bit_cast(float, w << 16); }
__device__ __forceinline__ float bf_hi(unsigned w) { return __builtin_bit_cast(float, w & 0xffff0000u); }
__device__ __forceinline__ float bf2f(bf16_t b) { return __builtin_bit_cast(float, (unsigned)b << 16); }
typedef __bf16 bf16x2_t __attribute__((ext_vector_type(2)));
__device__ __forceinline__ unsigned pk2(float lo, float hi) { f32x2 v = {lo, hi}; bf16x2_t b = __builtin_convertvector(v, bf16x2_t); return __builtin_bit_cast(unsigned, b); }
__device__ __forceinline__ bf16_t f2bf(float f) { return (bf16_t)(pk2(f, 0.f) & 0xffffu); }
struct F8 { f32x4 a, b; };
__device__ __forceinline__ F8 unpack8(u32x4 w) { F8 r; r.a[0] = bf_lo(w.x); r.a[1] = bf_hi(w.x); r.a[2] = bf_lo(w.y); r.a[3] = bf_hi(w.y); r.b[0] = bf_lo(w.z); r.b[1] = bf_hi(w.z); r.b[2] = bf_lo(w.w); r.b[3] = bf_hi(w.w); return r; }
__device__ __forceinline__ u32x4 pack8(f32x4 a, f32x4 b) { u32x4 w; w.x = pk2(a[0], a[1]); w.y = pk2(a[2], a[3]); w.z = pk2(b[0], b[1]); w.w = pk2(b[2], b[3]); return w; }
__device__ __forceinline__ float gelu_t(float x) {
    const float u = 0.7978845608f * (x + 0.044715f * x * x * x);
    const float e = __builtin_amdgcn_exp2f(-2.885390082f * u);
    return x * __builtin_amdgcn_rcpf(1.f + e);
}
__device__ __forceinline__ f32x4 gelu4(f32x4 v) { f32x4 r; r[0] = gelu_t(v[0]); r[1] = gelu_t(v[1]); r[2] = gelu_t(v[2]); r[3] = gelu_t(v[3]); return r; }
__device__ __forceinline__ float sigm(float x) { return __builtin_amdgcn_rcpf(1.f + __builtin_amdgcn_exp2f(-1.442695041f * x)); }
__device__ __forceinline__ f32x4 sigm4(f32x4 v) { f32x4 r; r[0] = sigm(v[0]); r[1] = sigm(v[1]); r[2] = sigm(v[2]); r[3] = sigm(v[3]); return r; }
__device__ __forceinline__ float wave_sum(float v) {
#pragma unroll
    for (int o = 1; o < 64; o <<= 1) v += __shfl_xor(v, o);
    return v;
}

namespace pg8 {
constexpr int BM = 256, BK = 64, HALF = 128, HTB = HALF * BK * 2, STAGE_BYTES = 8 * HTB, NXCD = 8, WGM = 8;
__device__ __forceinline__ int lds_byte(int r, int c) { const int st = (r >> 4) * 2 + (c >> 5), rr = r & 15, cc = c & 31, ob = rr * 64 + cc * 2; return st * 1024 + (ob ^ (((ob >> 9) & 1) << 5)); }
__device__ __forceinline__ void stage_rc(int b, int& R, int& C) { const int st = b / 1024, sb = b % 1024, swz = sb ^ (((sb >> 9) & 1) << 5); R = (st >> 1) * 16 + swz / 64; C = (st & 1) * 32 + (swz % 64) / 2; }
__device__ __forceinline__ int perm32(int rho) { const int n = rho >> 4, i = rho & 15; return 8 * (i >> 2) + 4 * n + (i & 3); }

struct Unit { int pm, pn, ka; };
struct Gemm { const bf16_t* A; const bf16_t* Bt; int lda, ldb, K; };

struct Order {
    int nM, nN, nwg, G, c, mode;
    __device__ __forceinline__ void init(int nM_, int nN_, int G_, int c_, int mode_) { nM = nM_; nN = nN_; nwg = nM * nN; G = G_; c = c_; mode = mode_; }
    __device__ __forceinline__ bool next(int i, Unit& u) const {
        const long L = (long)i * G + c; if (L >= nwg) return false;
        int wgid = (int)L; { const int q = nwg / NXCD, r = nwg % NXCD, xcd = wgid % NXCD, off = wgid / NXCD; wgid = (xcd < r ? xcd * (q + 1) : r * (q + 1) + (xcd - r) * q) + off; }
        const int nig = WGM * nN, gid = wgid / nig, fm = gid * WGM, gsz = (nM - fm) < WGM ? (nM - fm) : WGM;
        u.pm = fm + ((wgid % nig) % gsz); u.pn = (wgid % nig) / gsz; u.ka = mode ? ((u.pn & ~1) * 128) : 0; return true;
    }
};

template <class Epi>
__device__ __forceinline__ void gemm_phase(LAS unsigned char* lds, const Gemm g, const Order& S, const Epi& E) {
    int tid = threadIdx.x; asm volatile("" : "+v"(tid));
    const int wid = __builtin_amdgcn_readfirstlane(tid >> 6), lane = tid & 63, wr = wid >> 2, wc = wid & 3, fr = lane & 15, fq = lane >> 4;
    const int K = g.K, nt = K / BK;
    unsigned voffA[2], voffB[2];
#pragma unroll
    for (int i = 0; i < 2; ++i) { int R, C; stage_rc(tid * 16 + i * 8192, R, C); const int Rb = Epi::PERM ? ((R & ~31) + perm32(R & 31)) : R;
        voffA[i] = (unsigned)(R * g.lda + C) * 2u; voffB[i] = (unsigned)(Rb * g.ldb + C) * 2u; }
    const size_t kstep = (size_t)(BK * 2);
    const size_t hstepA = (size_t)HALF * g.lda * 2, tstepA = 2 * hstepA;
    const size_t hstepB = (size_t)HALF * g.ldb * 2, tstepB = 2 * hstepB;
    const unsigned ldsw = (unsigned)wid * 1024u;
    const int aoff = lds_byte(wr * 64 + fr, fq * 8), boff = lds_byte(wc * 32 + fr, fq * 8);
#define PG8_SA(b, h) (((b) * 2 + (h)) * HTB)
#define PG8_SB(b, h) ((4 + (b) * 2 + (h)) * HTB)
#define PG8_STAGE(bufoff, gbase, voff) do { _Pragma("unroll") for (int _i = 0; _i < 2; ++_i) \
        __builtin_amdgcn_global_load_lds((const unsigned*)((const char*)(gbase) + (voff)[_i]), (LAS unsigned*)(lds + (bufoff) + ldsw + _i * 8192), 16, 0, 0); } while (0)
#define PG8_LDA(dst, b, h) do { _Pragma("unroll") for (int m = 0; m < 4; ++m) _Pragma("unroll") for (int k = 0; k < 2; ++k) dst[m][k] = *(const LAS bf16x8*)(lds + PG8_SA(b, h) + aoff + m * 2048 + k * 1024); } while (0)
#define PG8_LDB(dst, b, h) do { _Pragma("unroll") for (int n = 0; n < 2; ++n) _Pragma("unroll") for (int k = 0; k < 2; ++k) dst[n][k] = *(const LAS bf16x8*)(lds + PG8_SB(b, h) + boff + n * 2048 + k * 1024); } while (0)
#define PG8_MMA(ai, bj, At, Bt) do { __builtin_amdgcn_s_setprio(1); _Pragma("unroll") for (int m = 0; m < 4; ++m) _Pragma("unroll") for (int n = 0; n < 2; ++n) _Pragma("unroll") for (int k = 0; k < 2; ++k) \
        acc[ai][bj][m][n] = __builtin_amdgcn_mfma_f32_16x16x32_bf16(Bt[n][k], At[m][k], acc[ai][bj][m][n], 0, 0, 0); __builtin_amdgcn_s_setprio(0); } while (0)
#define PG8_WAIT_V(n) asm volatile("s_waitcnt vmcnt(" #n ")" ::: "memory")
#define PG8_WAIT_L(n) asm volatile("s_waitcnt lgkmcnt(" #n ")" ::: "memory")
#define PG8_BAR __builtin_amdgcn_s_barrier()
#define PG8_SCHED __builtin_amdgcn_sched_barrier(0)
    Unit cur, nxt; int ui = 0;
    if (!S.next(0, cur)) return;
    f32x4 acc[2][2][4][2];
#pragma unroll
    for (int a = 0; a < 2; ++a)
#pragma unroll
        for (int b = 0; b < 2; ++b)
#pragma unroll
            for (int m = 0; m < 4; ++m)
#pragma unroll
                for (int n = 0; n < 2; ++n) acc[a][b][m][n] = (f32x4){0.f, 0.f, 0.f, 0.f};
    bf16x8 At[4][2], B0[2][2], B1[2][2];
    const char* cA = (const char*)g.A + (size_t)cur.pm * tstepA + (size_t)cur.ka * 2; const char* cB = (const char*)g.Bt + (size_t)cur.pn * tstepB;
    PG8_STAGE(PG8_SB(0, 0), cB, voffB); PG8_STAGE(PG8_SB(0, 1), cB + hstepB, voffB); PG8_STAGE(PG8_SA(0, 0), cA, voffA); PG8_STAGE(PG8_SA(0, 1), cA + hstepA, voffA);
    if (wr == 1) PG8_BAR;
    PG8_WAIT_V(2); PG8_BAR;
    PG8_STAGE(PG8_SB(1, 0), cB + kstep, voffB); PG8_STAGE(PG8_SA(1, 0), cA + kstep, voffA); PG8_STAGE(PG8_SB(1, 1), cB + hstepB + kstep, voffB);
    PG8_WAIT_V(6); PG8_BAR;
    for (;;) {
        const bool has_next = S.next(ui + 1, nxt);
        const char* nA = has_next ? (const char*)g.A + (size_t)nxt.pm * tstepA + (size_t)nxt.ka * 2 : cA; const char* nB = has_next ? (const char*)g.Bt + (size_t)nxt.pn * tstepB : cB;
#pragma unroll 1
        for (int t = 0; t < nt; t += 2) {
            const bool last = (t == nt - 2);
            const char* a1 = cA + (size_t)(t + 1) * kstep;
            const char* a2 = last ? nA : cA + (size_t)(t + 2) * kstep; const char* b2 = last ? nB : cB + (size_t)(t + 2) * kstep;
            const char* a3 = a2 + kstep; const char* b3 = b2 + kstep;
            PG8_LDB(B0, 0, 0); PG8_LDB(B1, 0, 1); PG8_SCHED; PG8_LDA(At, 0, 0); PG8_STAGE(PG8_SA(1, 1), a1 + hstepA, voffA);
            PG8_WAIT_V(8); PG8_WAIT_L(0); PG8_BAR; PG8_MMA(0, 0, At, B0); PG8_MMA(0, 1, At, B1); PG8_BAR; PG8_SCHED;
            PG8_LDA(At, 0, 1); PG8_STAGE(PG8_SB(0, 0), b2, voffB); PG8_STAGE(PG8_SB(0, 1), b2 + hstepB, voffB); PG8_STAGE(PG8_SA(0, 0), a2, voffA);
            PG8_WAIT_V(8); PG8_WAIT_L(0); PG8_BAR; PG8_MMA(1, 0, At, B0); PG8_MMA(1, 1, At, B1); PG8_BAR; PG8_SCHED;
            PG8_LDB(B0, 1, 0); PG8_LDB(B1, 1, 1); PG8_SCHED; PG8_LDA(At, 1, 0); PG8_STAGE(PG8_SA(0, 1), a2 + hstepA, voffA);
            PG8_WAIT_V(8); PG8_WAIT_L(0); PG8_BAR; PG8_MMA(0, 0, At, B0); PG8_MMA(0, 1, At, B1); PG8_BAR; PG8_SCHED;
            PG8_LDA(At, 1, 1); PG8_STAGE(PG8_SB(1, 0), b3, voffB); PG8_STAGE(PG8_SB(1, 1), b3 + hstepB, voffB); PG8_STAGE(PG8_SA(1, 0), a3, voffA);
            PG8_WAIT_V(8); PG8_WAIT_L(0); PG8_BAR; PG8_MMA(1, 0, At, B0); PG8_MMA(1, 1, At, B1); PG8_BAR; PG8_SCHED;
        }
        if (wr == 0) PG8_BAR;
        { int fr2 = fr, fq2 = fq; asm volatile("" : "+v"(fr2), "+v"(fq2));
          E(acc, cur, wr, wc, fr2, fq2); }
        if (!has_next) break;
#pragma unroll
        for (int a = 0; a < 2; ++a)
#pragma unroll
            for (int b = 0; b < 2; ++b)
#pragma unroll
                for (int m = 0; m < 4; ++m)
#pragma unroll
                    for (int n = 0; n < 2; ++n) acc[a][b][m][n] = (f32x4){0.f, 0.f, 0.f, 0.f};
        cur = nxt; cA = nA; cB = nB; ++ui;
        if (wr == 1) PG8_BAR;
    }
    PG8_WAIT_V(0);
    PG8_BAR;
#undef PG8_SA
#undef PG8_SB
#undef PG8_STAGE
#undef PG8_LDA
#undef PG8_LDB
#undef PG8_MMA
#undef PG8_WAIT_V
#undef PG8_WAIT_L
#undef PG8_BAR
#undef PG8_SCHED
}
}
using pg8::Unit;

#define EPI_ARGS const f32x4 (&acc)[2][2][4][2], const Unit& u, int wr, int wc, int fr, int fq
struct EpiZ {
    static constexpr bool PERM = true;
    bf16_t* Z; float* out; int l;
    __device__ __forceinline__ void operator()(EPI_ARGS) const {
        const int pn = u.pn; bf16_t* base; int ld, ct; bool act;
        if (pn < 2) { base = Z; ld = 512; ct = pn * 256; act = false; }
        else if (pn < 6) { base = Z + UE; ld = 1024; ct = (pn - 2) * 256; act = false; }
        else if (pn < 10) { base = Z + 3 * UE; ld = 1024; ct = (pn - 6) * 256; act = true; }
        else if (pn < 12) { base = Z + 5 * UE; ld = 512; ct = (pn - 10) * 256; act = true; }
        else { base = Z + 6 * UE; ld = 512; ct = (pn - 12) * 256; act = true; }
        const bool st = (pn < 6) && (((u.pm & 7) == 7) || u.pm == 64);
#pragma unroll
        for (int ai = 0; ai < 2; ++ai)
#pragma unroll
            for (int m = 0; m < 4; ++m) {
                const int row = u.pm * 256 + ai * 128 + wr * 64 + m * 16 + fr;
#pragma unroll
                for (int bj = 0; bj < 2; ++bj) {
                    f32x4 v0 = acc[ai][bj][m][0], v1 = acc[ai][bj][m][1];
                    const int c = ct + bj * 128 + wc * 32 + 8 * fq;
                    if (st) {
                        float* o = nullptr;
                        if (row < MPR) { const int t = row & 2047, b = row >> 11;
                            if (pn < 2) { if (t >= 2033) o = out + O_POOL_P + ((size_t)(l * NB + b) * 15 + (t - 2033)) * DPOOL + c; }
                            else { if (t >= 2045) o = out + O_RC_P + ((size_t)(l * NB + b) * 3 + (t - 2045)) * DRNN + c; } }
                        else if (row < MROWS) { const int s = row - MPR;
                            if (pn < 2) o = out + O_POOL_S + ((size_t)(l * NS + s) * 15 + 14) * DPOOL + c;
                            else o = out + O_RC_S + ((size_t)(l * NS + s) * 3 + 2) * DRNN + c; }
                        if (o) { *(f32x4*)o = v0; *(f32x4*)(o + 4) = v1; }
                    }
                    if (act) { v0 = gelu4(v0); v1 = gelu4(v1); }
                    *(u32x4*)(base + (size_t)row * ld + c) = pack8(v0, v1);
                    asm volatile("" ::: "memory");
                }
            }
    }
    __device__ __forceinline__ void sample(int row, int col, f32x4 v) const {
        const int s = row - MPR; bf16_t* dst;
        if (col < 512) { dst = Z + (size_t)row * 512 + col; *(f32x4*)(out + O_POOL_S + ((size_t)(l * NS + s) * 15 + 14) * DPOOL + col) = v; }
        else if (col < 1536) { dst = Z + UE + (size_t)row * 1024 + (col - 512); *(f32x4*)(out + O_RC_S + ((size_t)(l * NS + s) * 3 + 2) * DRNN + (col - 512)) = v; }
        else if (col < 2560) { dst = Z + 3 * UE + (size_t)row * 1024 + (col - 1536); v = gelu4(v); }
        else if (col < 3072) { dst = Z + 5 * UE + (size_t)row * 512 + (col - 2560); v = gelu4(v); }
        else { dst = Z + 6 * UE + (size_t)row * 512 + (col - 3072); v = gelu4(v); }
        u32x2 w; w.x = pk2(v[0], v[1]); w.y = pk2(v[2], v[3]); *(u32x2*)dst = w;
    }
};
struct EpiRI {
    static constexpr bool PERM = true;
    const bf16_t* BC; bf16_t* LA; bf16_t* BV; const float* ba; const float* bx; const float* sp;
    __device__ __forceinline__ void operator()(EPI_ARGS) const {
        const int ch = u.pn * 128 + wc * 32 + 8 * fq;
#pragma unroll
        for (int n = 0; n < 2; ++n) {
            const f32x4 ba0 = *(const f32x4*)(ba + ch + 4 * n), bx0 = *(const f32x4*)(bx + ch + 4 * n), sp0 = *(const f32x4*)(sp + ch + 4 * n);
#pragma unroll
            for (int ai = 0; ai < 2; ++ai)
#pragma unroll
                for (int m = 0; m < 4; ++m) {
                    const int row = u.pm * 256 + ai * 128 + wr * 64 + m * 16 + fr;
                    const u32x2 xw = *(const u32x2*)(BC + (size_t)row * DRNN + ch + 4 * n);
                    const f32x4 xc = (f32x4){bf_lo(xw.x), bf_hi(xw.x), bf_lo(xw.y), bf_hi(xw.y)};
                    const f32x4 r0 = sigm4(acc[ai][0][m][n] + ba0), i0 = sigm4(acc[ai][1][m][n] + bx0);
                    const f32x4 la0 = r0 * sp0; f32x4 b0;
#pragma unroll
                    for (int j = 0; j < 4; ++j) { const float x = -2.f * la0[j];
                        const float em = x < 0.03f ? x * (1.f - x * (0.5f - x * (0.16666667f - x * 0.041666668f))) : 1.f - __expf(-x);
                        b0[j] = __builtin_sqrtf(em) * i0[j] * xc[j]; }
                    u32x2 wl, wb; wl.x = pk2(la0[0], la0[1]); wl.y = pk2(la0[2], la0[3]); wb.x = pk2(b0[0], b0[1]); wb.y = pk2(b0[2], b0[3]);
                    *(u32x2*)(LA + (size_t)row * DRNN + ch + 4 * n) = wl;
                    *(u32x2*)(BV + (size_t)row * DRNN + ch + 4 * n) = wb;
                    asm volatile("" ::: "memory");
                }
        }
    }
    __device__ __forceinline__ void sample2(int row, int ch, f32x4 vr, f32x4 vi) const {
        const f32x4 ba0 = *(const f32x4*)(ba + ch), bx0 = *(const f32x4*)(bx + ch), sp0 = *(const f32x4*)(sp + ch);
        const u32x2 xw = *(const u32x2*)(BC + (size_t)row * DRNN + ch);
        const f32x4 xc = (f32x4){bf_lo(xw.x), bf_hi(xw.x), bf_lo(xw.y), bf_hi(xw.y)};
        const f32x4 r0 = sigm4(vr + ba0), i0 = sigm4(vi + bx0), la0 = r0 * sp0; f32x4 b0;
#pragma unroll
        for (int j = 0; j < 4; ++j) { const float x = -2.f * la0[j];
            const float em = x < 0.03f ? x * (1.f - x * (0.5f - x * (0.16666667f - x * 0.041666668f))) : 1.f - __expf(-x);
            b0[j] = __builtin_sqrtf(em) * i0[j] * xc[j]; }
        u32x2 wl, wb; wl.x = pk2(la0[0], la0[1]); wl.y = pk2(la0[2], la0[3]); wb.x = pk2(b0[0], b0[1]); wb.y = pk2(b0[2], b0[3]);
        *(u32x2*)(LA + (size_t)row * DRNN + ch) = wl; *(u32x2*)(BV + (size_t)row * DRNN + ch) = wb;
    }
};
struct EpiG {
    static constexpr bool PERM = true;
    bf16_t* G;
    __device__ __forceinline__ void operator()(EPI_ARGS) const {
#pragma unroll
        for (int ai = 0; ai < 2; ++ai)
#pragma unroll
            for (int m = 0; m < 4; ++m) {
                const int row = u.pm * 256 + ai * 128 + wr * 64 + m * 16 + fr;
#pragma unroll
                for (int bj = 0; bj < 2; ++bj) {
                    const int c = u.pn * 256 + bj * 128 + wc * 32 + 8 * fq;
                    *(u32x4*)(G + (size_t)row * 3072 + c) = pack8(sigm4(acc[ai][bj][m][0]), sigm4(acc[ai][bj][m][1]));
                    asm volatile("" ::: "memory");
                }
            }
    }
    __device__ __forceinline__ void sample(int row, int col, f32x4 v) const {
        v = sigm4(v); u32x2 w; w.x = pk2(v[0], v[1]); w.y = pk2(v[2], v[3]); *(u32x2*)(G + (size_t)row * 3072 + col) = w;
    }
};
struct EpiP {
    static constexpr bool PERM = true;
    bf16_t* G; int goff;
    __device__ __forceinline__ void operator()(EPI_ARGS) const {
#pragma unroll
        for (int ai = 0; ai < 2; ++ai)
#pragma unroll
            for (int m = 0; m < 4; ++m) {
                const int row = u.pm * 256 + ai * 128 + wr * 64 + m * 16 + fr;
#pragma unroll
                for (int bj = 0; bj < 2; ++bj) {
                    const int c = goff + u.pn * 256 + bj * 128 + wc * 32 + 8 * fq;
                    u32x4* p = (u32x4*)(G + (size_t)row * 3072 + c);
                    const F8 gt = unpack8(*p);
                    *p = pack8(gt.a * acc[ai][bj][m][0], gt.b * acc[ai][bj][m][1]);
                    asm volatile("" ::: "memory");
                }
            }
    }
    __device__ __forceinline__ void sample(int row, int col, f32x4 v) const {
        u32x2* p = (u32x2*)(G + (size_t)row * 3072 + goff + col); const u32x2 g = *p;
        u32x2 w; w.x = pk2(bf_lo(g.x) * v[0], bf_hi(g.x) * v[1]); w.y = pk2(bf_lo(g.y) * v[2], bf_hi(g.y) * v[3]); *p = w;
    }
};
struct EpiX {
    static constexpr bool PERM = false;
    const float* xin_p; const float* xin_s; float* xout;
    __device__ __forceinline__ void operator()(EPI_ARGS) const {
#pragma unroll
        for (int ai = 0; ai < 2; ++ai)
#pragma unroll
            for (int m = 0; m < 4; ++m) {
                const int row = u.pm * 256 + ai * 128 + wr * 64 + m * 16 + fr;
                if (row < MROWS) {
                    const float* src = row < MPR ? xin_p + (size_t)row * DM : xin_s + (size_t)(row - MPR) * DM;
                    float* dst = xout + (size_t)row * DM;
#pragma unroll
                    for (int bj = 0; bj < 2; ++bj)
#pragma unroll
                        for (int n = 0; n < 2; ++n) {
                            const int c = u.pn * 256 + bj * 128 + wc * 32 + 16 * n + 4 * fq;
                            *(f32x4*)(dst + c) = *(const f32x4*)(src + c) + acc[ai][bj][m][n];
                        }
                    asm volatile("" ::: "memory");
                }
            }
    }
    __device__ __forceinline__ void sample(int row, int col, f32x4 v) const {
        *(f32x4*)(xout + (size_t)row * DM + col) = *(const f32x4*)(xin_s + (size_t)(row - MPR) * DM + col) + v;
    }
};
struct EpiGpre {
    static constexpr bool PERM = true;
    bf16_t* GP; float* out; int l;
    __device__ __forceinline__ void operator()(EPI_ARGS) const {
        const bool st = ((u.pm & 7) == 7) || u.pm == 64;
#pragma unroll
        for (int ai = 0; ai < 2; ++ai)
#pragma unroll
            for (int m = 0; m < 4; ++m) {
                const int row = u.pm * 256 + ai * 128 + wr * 64 + m * 16 + fr;
#pragma unroll
                for (int bj = 0; bj < 2; ++bj) {
                    const f32x4 v0 = acc[ai][bj][m][0], v1 = acc[ai][bj][m][1];
                    const int c = u.pn * 256 + bj * 128 + wc * 32 + 8 * fq;
                    if (st) {
                        float* o = nullptr;
                        if (row < MPR) { const int t = row & 2047, b = row >> 11; if (t >= 2046) o = out + O_FF_P + ((size_t)(l * NB + b) * 2 + (t - 2046)) * DFF + c; }
                        else if (row < MROWS) { const int s = row - MPR; o = out + O_FF_S + ((size_t)(l * NS + s) * 2 + 1) * DFF + c; }
                        if (o) { *(f32x4*)o = v0; *(f32x4*)(o + 4) = v1; }
                    }
                    *(u32x4*)(GP + (size_t)row * 3072 + c) = pack8(v0, v1);
                    asm volatile("" ::: "memory");
                }
            }
    }
    __device__ __forceinline__ void sample(int row, int col, f32x4 v) const {
        *(f32x4*)(out + O_FF_S + ((size_t)(l * NS + (row - MPR)) * 2 + 1) * DFF + col) = v;
        u32x2 w; w.x = pk2(v[0], v[1]); w.y = pk2(v[2], v[3]); *(u32x2*)(GP + (size_t)row * 3072 + col) = w;
    }
};
struct EpiH {
    static constexpr bool PERM = true;
    const bf16_t* GP; bf16_t* H; const float* cw; const float* cb; const float* st;
    __device__ __forceinline__ void operator()(EPI_ARGS) const {
#pragma unroll
        for (int bj = 0; bj < 2; ++bj) {
            const int c = u.pn * 256 + bj * 128 + wc * 32 + 8 * fq;
            const f32x4 w00 = *(const f32x4*)(cw + c), w01 = *(const f32x4*)(cw + c + 4);
            const f32x4 w10 = *(const f32x4*)(cw + DFF + c), w11 = *(const f32x4*)(cw + DFF + c + 4);
            const f32x4 w20 = *(const f32x4*)(cw + 2 * DFF + c), w21 = *(const f32x4*)(cw + 2 * DFF + c + 4);
            const f32x4 cb0 = *(const f32x4*)(cb + c), cb1 = *(const f32x4*)(cb + c + 4);
#pragma unroll
            for (int ai = 0; ai < 2; ++ai)
#pragma unroll
                for (int m = 0; m < 4; ++m) {
                    const int row = u.pm * 256 + ai * 128 + wr * 64 + m * 16 + fr;
                    const F8 g0 = unpack8(*(const u32x4*)(GP + (size_t)row * 3072 + c));
                    f32x4 s0 = cb0 + w20 * g0.a, s1 = cb1 + w21 * g0.b;
                    if (row < MPR) { const int t = row & 2047;
                        if (t >= 1) { const F8 g1 = unpack8(*(const u32x4*)(GP + (size_t)(row - 1) * 3072 + c)); s0 += w10 * g1.a; s1 += w11 * g1.b; }
                        if (t >= 2) { const F8 g2 = unpack8(*(const u32x4*)(GP + (size_t)(row - 2) * 3072 + c)); s0 += w00 * g2.a; s1 += w01 * g2.b; } }
                    else if (row < MROWS) { const float* sp = st + (size_t)(row - MPR) * 2 * DFF + c;
                        s0 += w00 * *(const f32x4*)sp + w10 * *(const f32x4*)(sp + DFF); s1 += w01 * *(const f32x4*)(sp + 4) + w11 * *(const f32x4*)(sp + DFF + 4); }
                    *(u32x4*)(H + (size_t)row * 3072 + c) = pack8(gelu4(s0) * acc[ai][bj][m][0], gelu4(s1) * acc[ai][bj][m][1]);
                    asm volatile("" ::: "memory");
                }
        }
    }
    __device__ __forceinline__ void sample(int row, int col, f32x4 v) const {
        const u32x2 gw = *(const u32x2*)(GP + (size_t)row * 3072 + col); const f32x4 g0 = (f32x4){bf_lo(gw.x), bf_hi(gw.x), bf_lo(gw.y), bf_hi(gw.y)};
        const float* sp = st + (size_t)(row - MPR) * 2 * DFF + col;
        const f32x4 s0 = *(const f32x4*)(cb + col) + *(const f32x4*)(cw + 2 * DFF + col) * g0 + *(const f32x4*)(cw + col) * *(const f32x4*)sp + *(const f32x4*)(cw + DFF + col) * *(const f32x4*)(sp + DFF);
        const f32x4 h = gelu4(s0) * v; u32x2 w; w.x = pk2(h[0], h[1]); w.y = pk2(h[2], h[3]); *(u32x2*)(H + (size_t)row * 3072 + col) = w;
    }
};

template <bool DUAL, class Epi>
__device__ __forceinline__ void sample_gemm(LAS unsigned char* lds, const bf16_t* A, int lda, const bf16_t* Bt, int ldb, int K, int nstrips, int bid, int G, const Epi& E) {
    int tid = threadIdx.x; asm volatile("" : "+v"(tid));
    const int kw = __builtin_amdgcn_readfirstlane(tid >> 6), lane = tid & 63, fr = lane & 15, fq = lane >> 4;
    const int kslice = K >> 3, nks = kslice >> 5;
    LAS f32x4* part = (LAS f32x4*)lds;
    for (int strip = G - 1 - bid; strip < nstrips; strip += G) {
        int n0 = strip * 16, acol = 0, h = 0, cc = 0;
        if (DUAL) { h = strip >> 3; cc = (strip & 7) * 16; n0 = h * 256 + cc; acol = (h & ~1) * 128; }
        f32x4 acc[8], acc2[8];
#pragma unroll
        for (int m = 0; m < 8; ++m) { acc[m] = (f32x4){0.f, 0.f, 0.f, 0.f}; acc2[m] = acc[m]; }
        const bf16_t* bp = Bt + (size_t)(n0 + fr) * ldb + kw * kslice + 8 * fq;
        const bf16_t* ap = A + (size_t)fr * lda + acol + kw * kslice + 8 * fq;
#pragma unroll 2
        for (int ks = 0; ks < nks; ++ks) {
            const bf16x8 b = *(const bf16x8*)(bp + ks * 32);
            bf16x8 b2; if (DUAL) b2 = *(const bf16x8*)(bp + (size_t)128 * ldb + ks * 32);
#pragma unroll
            for (int m = 0; m < 8; ++m) { const bf16x8 a = *(const bf16x8*)(ap + (size_t)(16 * m) * lda + ks * 32);
                acc[m] = __builtin_amdgcn_mfma_f32_16x16x32_bf16(b, a, acc[m], 0, 0, 0);
                if (DUAL) acc2[m] = __builtin_amdgcn_mfma_f32_16x16x32_bf16(b2, a, acc2[m], 0, 0, 0); }
        }
#pragma unroll
        for (int m = 0; m < 8; ++m) part[(kw * 8 + m) * 64 + lane] = acc[m];
        __syncthreads();
        f32x4 v = part[kw * 64 + lane];
#pragma unroll
        for (int k2 = 1; k2 < 8; ++k2) v += part[(k2 * 8 + kw) * 64 + lane];
        const int row = MPR + 16 * kw + fr;
        if constexpr (DUAL) {
            __syncthreads();
#pragma unroll
            for (int m = 0; m < 8; ++m) part[(kw * 8 + m) * 64 + lane] = acc2[m];
            __syncthreads();
            f32x4 v2 = part[kw * 64 + lane];
#pragma unroll
            for (int k2 = 1; k2 < 8; ++k2) v2 += part[(k2 * 8 + kw) * 64 + lane];
            E.sample2(row, h * 128 + cc + 4 * fq, v, v2);
        } else E.sample(row, n0 + 4 * fq, v);
        __syncthreads();
    }
}


__device__ __forceinline__ void transpose_item(const float* W, int K, int N, bf16_t* WT, LAS float* scr, int item, int lane) {
    const int nblk = N / 32, kb = item / nblk, nb = item % nblk, k0 = 64 * kb, n0 = 32 * nb;
#pragma unroll 8
    for (int i = 0; i < 32; ++i) { const int kk = 2 * i + (lane >> 5); scr[kk * 33 + (lane & 31)] = W[(size_t)(k0 + kk) * N + n0 + (lane & 31)]; }
    asm volatile("s_waitcnt lgkmcnt(0)" ::: "memory");
    const int c = lane & 7;
#pragma unroll
    for (int j = 0; j < 4; ++j) { const int n = (lane >> 3) + 8 * j; const LAS float* s = scr + (8 * c) * 33 + n;
        u32x4 o; o.x = pk2(s[0 * 33], s[1 * 33]); o.y = pk2(s[2 * 33], s[3 * 33]); o.z = pk2(s[4 * 33], s[5 * 33]); o.w = pk2(s[6 * 33], s[7 * 33]);
        *(u32x4*)(WT + (size_t)(n0 + n) * K + k0 + 8 * c) = o; }
    asm volatile("s_waitcnt lgkmcnt(0)" ::: "memory");
}
__device__ __forceinline__ void rms_row_bf16(const float* xrow, const float* g, bf16_t* orow, int lane) {
    const f32x4* xr = (const f32x4*)xrow + lane; f32x4 v[4]; float s = 0.f;
#pragma unroll
    for (int j = 0; j < 4; ++j) { v[j] = xr[64 * j]; s += (v[j][0] * v[j][0] + v[j][1] * v[j][1]) + (v[j][2] * v[j][2] + v[j][3] * v[j][3]); }
    const float rstd = rsqrtf(wave_sum(s) * (1.f / DM) + 1e-6f);
    const f32x4* gr = (const f32x4*)g + lane; u32x2* o8 = (u32x2*)orow + lane;
#pragma unroll
    for (int j = 0; j < 4; ++j) { const f32x4 o = v[j] * rstd * gr[64 * j]; u32x2 w; w.x = pk2(o[0], o[1]); w.y = pk2(o[2], o[3]); o8[64 * j] = w; }
}
__device__ __forceinline__ void rms_rows(const float* xp, const float* xs, const float* g, bf16_t* XN, int gw, int ngw, int lane) {
    for (int row = gw; row < MPAD; row += ngw) {
        if (row < MROWS) rms_row_bf16(row < MPR ? xp + (size_t)row * DM : xs + (size_t)(row - MPR) * DM, g, XN + (size_t)row * DM, lane);
        else { u32x2* o8 = (u32x2*)(XN + (size_t)row * DM) + lane; u32x2 z; z.x = 0u; z.y = 0u;
#pragma unroll
            for (int j = 0; j < 4; ++j) o8[64 * j] = z; }
    }
}

__device__ __forceinline__ void phase_prep(const Params& p, int l, LAS unsigned char* lds, const float* xp, const float* xs, int bid, int G) {
    int tid = threadIdx.x; asm volatile("" : "+v"(tid));
    const int wave = tid >> 6, lane = tid & 63;
    const int gw = bid * 8 + wave, ngw = G * 8;
    bf16_t* W = (bf16_t*)(p.ws + WS_W);
    LAS float* scr = (LAS float*)(lds + wave * 8448);
    const float* w_in = p.in[7] + (size_t)l * DM * INCOLS; const float* w_pb = p.in[21] + (size_t)l * DRNN * DM; const float* w_pc = p.in[22] + (size_t)l * DCH * DM;
    const float* w_o = p.in[23] + (size_t)l * DM * DM; const float* wg = p.in[25] + (size_t)l * DM * DFF; const float* wu = p.in[26] + (size_t)l * DM * DFF; const float* wd = p.in[29] + (size_t)l * DFF * DM;
    constexpr int I_IN = (DM / 64) * (INCOLS / 32), I_PB = (DRNN / 64) * (DM / 32), I_PC = (DCH / 64) * (DM / 32), I_O = (DM / 64) * (DM / 32), I_G = (DM / 64) * (DFF / 32), I_D = (DFF / 64) * (DM / 32);
    constexpr int NITEMS = I_IN + I_PB + I_PC + I_O + 2 * I_G + I_D;
    for (int it = gw; it < NITEMS; it += ngw) {
        int r = it;
        if (r < I_IN) { transpose_item(w_in, DM, INCOLS, W + W_IN, scr, r, lane); continue; } r -= I_IN;
        if (r < I_PB) { transpose_item(w_pb, DRNN, DM, W + W_PB, scr, r, lane); continue; } r -= I_PB;
        if (r < I_PC) { transpose_item(w_pc, DCH, DM, W + W_PC, scr, r, lane); continue; } r -= I_PC;
        if (r < I_O) { transpose_item(w_o, DM, DM, W + W_O, scr, r, lane); continue; } r -= I_O;
        if (r < I_G) { transpose_item(wg, DM, DFF, W + W_G, scr, r, lane); continue; } r -= I_G;
        if (r < I_G) { transpose_item(wu, DM, DFF, W + W_U, scr, r, lane); continue; } r -= I_G;
        transpose_item(wd, DFF, DM, W + W_D, scr, r, lane);
    }
    const int gt = bid * 512 + tid, ngt = G * 512;
    { const float* pw = p.in[8] + (size_t)l * 4 * 128 * 128; const float* ps = p.in[9] + (size_t)l * DPOOL; const float* w_pa = p.in[20] + (size_t)l * DPOOL * DM;
      for (int idx = gt; idx < DPOOL * DM; idx += ngt) { const int n = idx & 1023, kp = idx >> 10, g = kp >> 7;
          const float* pr = pw + (size_t)kp * 128; const float* sr = ps + g * 128; const float* wr_ = w_pa + (size_t)g * 128 * DM + n; float s = 0.f;
#pragma unroll 8
          for (int j = 0; j < 128; ++j) s += pr[j] * sr[j] * wr_[(size_t)j * DM];
          W[W_PA + (size_t)n * DPOOL + kp] = f2bf(s); } }
    { const float* wa = p.in[12] + (size_t)l * 8 * 128 * 128; const float* wx = p.in[14] + (size_t)l * 8 * 128 * 128;
      for (int idx = gt; idx < 8 * 256 * 256; idx += ngt) { const int k = idx & 255, n = (idx >> 8) & 255, h = idx >> 16; float v = 0.f;
          if ((k >> 7) == (h & 1)) v = (n < 128 ? wa : wx)[((size_t)h * 128 + (k & 127)) * 128 + (n & 127)];
          W[W_RI + idx] = f2bf(v); } }
    if (gt < DRNN) ((float*)(p.ws + WS_SP))[gt] = -8.f * log1pf(__expf(-p.in[16][(size_t)l * DRNN + gt]));
    rms_rows(xp, xs, p.in[6] + (size_t)l * DM, (bf16_t*)(p.ws + WS_XN), gw, ngw, lane);
}

__device__ __forceinline__ void phase_mix(const Params& p, int l, LAS unsigned char* lds, int bid, int G) {
    int tid = threadIdx.x; asm volatile("" : "+v"(tid));
    const int wave = tid >> 6, lane = tid & 63;
    const bf16_t* Za = (const bf16_t*)(p.ws + WS_Z); const bf16_t* Zbx = Za + UE; const bf16_t* Zgu = Za + 5 * UE; const bf16_t* Zgv = Za + 6 * UE;
    bf16_t* Y0 = (bf16_t*)(p.ws + WS_Y); bf16_t* Yd = Y0 + 2 * UE; bf16_t* Yc = Y0 + 3 * UE;
    const float* vg = p.in[17] + (size_t)l * DCH; const float* cws = p.in[18] + (size_t)l * 4 * 128 * 128; const float* cbs = p.in[19] + (size_t)l * 4 * 128;
    if (bid < 128) {
        const int r0 = bid * 128;
        LAS float* rstd = (LAS float*)lds; LAS bf16_t* VT = (LAS bf16_t*)(lds + 1024);
        { const int j = tid >> 2, q = tid & 3; const u32x4* src = (const u32x4*)(Zgv + (size_t)(r0 + j) * DCH + q * 128); float s = 0.f;
#pragma unroll
          for (int i = 0; i < 16; ++i) { const F8 v = unpack8(src[i]); s += (v.a[0] * v.a[0] + v.a[1] * v.a[1]) + (v.a[2] * v.a[2] + v.a[3] * v.a[3]) + (v.b[0] * v.b[0] + v.b[1] * v.b[1]) + (v.b[2] * v.b[2] + v.b[3] * v.b[3]); }
          s += __shfl_xor(s, 1); s += __shfl_xor(s, 2);
          if (q == 0) rstd[j] = rsqrtf(s * (1.f / DCH) + 1e-6f); }
        __syncthreads();
        const int fr = lane & 15, fq = lane >> 4;
        for (int g = 0; g < 4; ++g) {
            { const int j = tid >> 2, q = tid & 3; const float rs = rstd[j];
              const u32x4* src = (const u32x4*)(Zgv + (size_t)(r0 + j) * DCH + g * 128 + q * 32); const float* gg = vg + g * 128 + q * 32;
#pragma unroll
              for (int i = 0; i < 4; ++i) { const F8 v = unpack8(src[i]); const f32x4 g0 = *(const f32x4*)(gg + 8 * i), g1 = *(const f32x4*)(gg + 8 * i + 4);
                  const int d = q * 32 + 8 * i;
#pragma unroll
                  for (int e = 0; e < 4; ++e) { VT[(d + e) * 136 + j] = f2bf(v.a[e] * rs * g0[e]); VT[(d + 4 + e) * 136 + j] = f2bf(v.b[e] * rs * g1[e]); } } }
            __syncthreads();
            const int i = 16 * wave + fr; bf16x8 af[4];
#pragma unroll
            for (int ks = 0; ks < 4; ++ks) { const int k0 = 32 * ks + 8 * fq; const float* wrow = cws + ((size_t)g * 128 + i) * 128 + k0;
                const f32x4 a0 = *(const f32x4*)wrow, a1 = *(const f32x4*)(wrow + 4); u32x4 w;
                w.x = pk2(k0 + 0 <= i ? a0[0] : 0.f, k0 + 1 <= i ? a0[1] : 0.f); w.y = pk2(k0 + 2 <= i ? a0[2] : 0.f, k0 + 3 <= i ? a0[3] : 0.f);
                w.z = pk2(k0 + 4 <= i ? a1[0] : 0.f, k0 + 5 <= i ? a1[1] : 0.f); w.w = pk2(k0 + 6 <= i ? a1[2] : 0.f, k0 + 7 <= i ? a1[3] : 0.f);
                af[ks] = __builtin_bit_cast(bf16x8, w); }
            const float bsv = cbs[g * 128 + i];
#pragma unroll
            for (int dt = 0; dt < 8; ++dt) {
                f32x4 c4 = (f32x4){0.f, 0.f, 0.f, 0.f};
#pragma unroll
                for (int ks = 0; ks < 4; ++ks) { const bf16x8 vf = *(const LAS bf16x8*)(VT + (16 * dt + fr) * 136 + 32 * ks + 8 * fq);
                    c4 = __builtin_amdgcn_mfma_f32_16x16x32_bf16(vf, af[ks], c4, 0, 0, 0); }
                const size_t off = (size_t)(r0 + i) * DCH + g * 128 + 16 * dt + 4 * fq;
                const u32x2 uu = *(const u32x2*)(Zgu + off); u32x2 o;
                o.x = pk2(bf_lo(uu.x) * (c4[0] + bsv), bf_hi(uu.x) * (c4[1] + bsv)); o.y = pk2(bf_lo(uu.y) * (c4[2] + bsv), bf_hi(uu.y) * (c4[3] + bsv));
                *(u32x2*)(Yc + off) = o;
            }
            __syncthreads();
        }
    } else if (bid < 144) {
        const int s = (bid - 128) * 8 + wave, row = MPR + s, c = lane * 8, g = lane >> 4;
        const F8 v = unpack8(*(const u32x4*)(Zgv + (size_t)row * DCH + c));
        float ss = (v.a[0] * v.a[0] + v.a[1] * v.a[1]) + (v.a[2] * v.a[2] + v.a[3] * v.a[3]) + (v.b[0] * v.b[0] + v.b[1] * v.b[1]) + (v.b[2] * v.b[2] + v.b[3] * v.b[3]);
        const float rs = rsqrtf(wave_sum(ss) * (1.f / DCH) + 1e-6f);
        const f32x4 vn0 = v.a * rs * *(const f32x4*)(vg + c), vn1 = v.b * rs * *(const f32x4*)(vg + c + 4);
        float* ov = p.out + O_CV_S + ((size_t)l * NS + s) * DCH + c; *(f32x4*)ov = vn0; *(f32x4*)(ov + 4) = vn1;
        const float w00 = cws[(size_t)g * 128 * 128], b0 = cbs[g * 128];
        const F8 uu = unpack8(*(const u32x4*)(Zgu + (size_t)row * DCH + c));
        *(u32x4*)(Yc + (size_t)row * DCH + c) = pack8(uu.a * (vn0 * w00 + b0), uu.b * (vn1 * w00 + b0));
    }
    if (bid >= 128) {
    const int et = (bid - 128) * 512 + tid, net = (G - 128) * 512;
    { const float* cw = p.in[10] + (size_t)l * 4 * DRNN; const float* cb = p.in[11] + (size_t)l * DRNN; const float* st = p.in[3] + (size_t)l * NS * 3 * DRNN;
      for (int idx = et; idx < (MPR / 8) * 128; idx += net) { const int r0 = (idx >> 7) * 8, c = (idx & 127) * 8, t0 = r0 & 2047;
          const f32x4 w00 = *(const f32x4*)(cw + c), w01 = *(const f32x4*)(cw + c + 4), w10 = *(const f32x4*)(cw + DRNN + c), w11 = *(const f32x4*)(cw + DRNN + c + 4);
          const f32x4 w20 = *(const f32x4*)(cw + 2 * DRNN + c), w21 = *(const f32x4*)(cw + 2 * DRNN + c + 4), w30 = *(const f32x4*)(cw + 3 * DRNN + c), w31 = *(const f32x4*)(cw + 3 * DRNN + c + 4);
          const f32x4 b0 = *(const f32x4*)(cb + c), b1 = *(const f32x4*)(cb + c + 4);
          F8 x1, x2, x3; const u32x4 zz = (u32x4){0u, 0u, 0u, 0u};
          x3 = unpack8(t0 >= 3 ? *(const u32x4*)(Zbx + (size_t)(r0 - 3) * DRNN + c) : zz); x2 = unpack8(t0 >= 2 ? *(const u32x4*)(Zbx + (size_t)(r0 - 2) * DRNN + c) : zz); x1 = unpack8(t0 >= 1 ? *(const u32x4*)(Zbx + (size_t)(r0 - 1) * DRNN + c) : zz);
#pragma unroll
          for (int i = 0; i < 8; ++i) { const F8 x0 = unpack8(*(const u32x4*)(Zbx + (size_t)(r0 + i) * DRNN + c));
              *(u32x4*)(Y0 + (size_t)(r0 + i) * DRNN + c) = pack8(b0 + w30 * x0.a + w20 * x1.a + w10 * x2.a + w00 * x3.a, b1 + w31 * x0.b + w21 * x1.b + w11 * x2.b + w01 * x3.b);
              x3 = x2; x2 = x1; x1 = x0; } }
      for (int idx = et; idx < NS * 128; idx += net) { const int row = MPR + (idx >> 7), c = (idx & 127) * 8;
          f32x4 s0 = *(const f32x4*)(cb + c), s1 = *(const f32x4*)(cb + c + 4);
          { const F8 x = unpack8(*(const u32x4*)(Zbx + (size_t)row * DRNN + c)); s0 += *(const f32x4*)(cw + 3 * DRNN + c) * x.a; s1 += *(const f32x4*)(cw + 3 * DRNN + c + 4) * x.b; }
          const float* sp = st + (size_t)(row - MPR) * 3 * DRNN + c;
#pragma unroll
          for (int k = 0; k < 3; ++k) { s0 += *(const f32x4*)(cw + k * DRNN + c) * *(const f32x4*)(sp + k * DRNN); s1 += *(const f32x4*)(cw + k * DRNN + c + 4) * *(const f32x4*)(sp + k * DRNN + 4); }
          *(u32x4*)(Y0 + (size_t)row * DRNN + c) = pack8(s0, s1); } }
    { const float* st = p.in[2] + (size_t)l * NS * 15 * DPOOL;
      for (int idx = et; idx < (MPR / 8) * 64; idx += net) { const int g = (idx >> 6) & 3, rb = ((idx >> 8) << 2) + ((idx >> 4) & 3), c = g * 128 + (idx & 15) * 8, w = 2 << g, r0 = rb * 8, t0 = r0 & 2047;
          f32x4 s0 = (f32x4){0.f, 0.f, 0.f, 0.f}, s1 = s0;
#pragma unroll
          for (int j = 1; j < 16; ++j) if (j < w && t0 >= j) { const F8 x = unpack8(*(const u32x4*)(Za + (size_t)(r0 - j) * DPOOL + c)); s0 += x.a; s1 += x.b; }
#pragma unroll
          for (int i = 0; i < 8; ++i) { const F8 cur = unpack8(*(const u32x4*)(Za + (size_t)(r0 + i) * DPOOL + c)); s0 += cur.a; s1 += cur.b;
              const int t = t0 + i; const float ic = 1.f / (float)(t + 1 < w ? t + 1 : w);
              *(u32x4*)(Yd + (size_t)(r0 + i) * DPOOL + c) = pack8(s0 * ic - cur.a, s1 * ic - cur.b);
              if (t >= w - 1) { const F8 old = unpack8(*(const u32x4*)(Za + (size_t)(r0 + i - (w - 1)) * DPOOL + c)); s0 -= old.a; s1 -= old.b; } } }
      for (int idx = et; idx < NS * 64; idx += net) { const int row = MPR + (idx >> 6), c = (idx & 63) * 8, w = 2 << (c >> 7);
          const F8 cur = unpack8(*(const u32x4*)(Za + (size_t)row * DPOOL + c)); f32x4 s0 = cur.a, s1 = cur.b;
          const float* sp = st + (size_t)(row - MPR) * 15 * DPOOL + c;
          for (int j = 1; j < w; ++j) { s0 += *(const f32x4*)(sp + (15 - j) * DPOOL); s1 += *(const f32x4*)(sp + (15 - j) * DPOOL + 4); }
          const float ic = 1.f / (float)w;
          *(u32x4*)(Yd + (size_t)row * DPOOL + c) = pack8(s0 * ic - cur.a, s1 * ic - cur.b); } }
    }
    const int gt = bid * 512 + tid, ngt = G * 512;
    { const float* sp = p.in[2] + (size_t)l * NS * 15 * DPOOL; float* o = p.out + O_POOL_S + (size_t)l * NS * 15 * DPOOL;
      for (int idx = gt; idx < NS * 14 * (DPOOL / 4); idx += ngt) { const int c = (idx & 127) * 4, r = (idx >> 7) % 14, s = (idx >> 7) / 14;
          *(f32x4*)(o + ((size_t)s * 15 + r) * DPOOL + c) = *(const f32x4*)(sp + ((size_t)s * 15 + r + 1) * DPOOL + c); } }
    { const float* sp = p.in[3] + (size_t)l * NS * 3 * DRNN; float* o = p.out + O_RC_S + (size_t)l * NS * 3 * DRNN;
      for (int idx = gt; idx < NS * 2 * (DRNN / 4); idx += ngt) { const int c = (idx & 255) * 4, r = (idx >> 8) & 1, s = idx >> 9;
          *(f32x4*)(o + ((size_t)s * 3 + r) * DRNN + c) = *(const f32x4*)(sp + ((size_t)s * 3 + r + 1) * DRNN + c); } }
    { const float* sp = p.in[5] + (size_t)l * NS * 2 * DFF; float* o = p.out + O_FF_S + (size_t)l * NS * 2 * DFF;
      for (int idx = gt; idx < NS * (DFF / 4); idx += ngt) { const int c = (idx % 768) * 4, s = idx / 768;
          *(f32x4*)(o + ((size_t)s * 2) * DFF + c) = *(const f32x4*)(sp + ((size_t)s * 2 + 1) * DFF + c); } }
}

__device__ __forceinline__ void phase_scan(const Params& p, int l, LAS unsigned char* lds, int bid, int G) {
    int tid = threadIdx.x; asm volatile("" : "+v"(tid));
    const bf16_t* LA = (const bf16_t*)(p.ws + WS_Z) + UE; const bf16_t* BV = (const bf16_t*)(p.ws + WS_Z) + 5 * UE; const bf16_t* GB = (const bf16_t*)(p.ws + WS_Z) + 3 * UE;
    bf16_t* Y0 = (bf16_t*)(p.ws + WS_Y);
    LAS float* sP = (LAS float*)lds; LAS float* sH = sP + 4096; LAS float* sC = sH + 4096; LAS float* sPg = sC + 4096; LAS float* sHg = sPg + 512;
    for (int item = bid; item < 256; item += G) {
        const int b = item >> 5, c0 = (item & 31) * 32, seg = tid >> 2, lg = tid & 3;
        const size_t base = ((size_t)b * SEQ + seg * 16) * DRNN + c0 + lg * 8;
        f32x4 P0 = (f32x4){1.f, 1.f, 1.f, 1.f}, P1 = P0, h0 = (f32x4){0.f, 0.f, 0.f, 0.f}, h1 = h0;
#pragma unroll
        for (int t = 0; t < 16; ++t) { const F8 la = unpack8(*(const u32x4*)(LA + base + (size_t)t * DRNN)), bv = unpack8(*(const u32x4*)(BV + base + (size_t)t * DRNN));
            f32x4 a0, a1;
#pragma unroll
            for (int e = 0; e < 4; ++e) { a0[e] = __builtin_amdgcn_exp2f(1.442695041f * la.a[e]); a1[e] = __builtin_amdgcn_exp2f(1.442695041f * la.b[e]); }
            h0 = a0 * h0 + bv.a; h1 = a1 * h1 + bv.b; P0 *= a0; P1 *= a1; }
        { const int o = seg * 32 + lg * 8; *(LAS f32x4*)(sP + o) = P0; *(LAS f32x4*)(sP + o + 4) = P1; *(LAS f32x4*)(sH + o) = h0; *(LAS f32x4*)(sH + o + 4) = h1; }
        __syncthreads();
        const int ch = tid & 31, sg = tid >> 5;
        { float Pg = 1.f, hg = 0.f;
#pragma unroll
          for (int k = 0; k < 8; ++k) { const float pp = sP[(sg * 8 + k) * 32 + ch], hh = sH[(sg * 8 + k) * 32 + ch]; hg = pp * hg + hh; Pg *= pp; }
          sPg[sg * 32 + ch] = Pg; sHg[sg * 32 + ch] = hg; }
        __syncthreads();
        { float carry = 0.f;
          for (int k = 0; k < sg; ++k) carry = sPg[k * 32 + ch] * carry + sHg[k * 32 + ch];
#pragma unroll
          for (int k = 0; k < 8; ++k) { const int o = (sg * 8 + k) * 32 + ch; sC[o] = carry; carry = sP[o] * carry + sH[o]; }
          if (sg == 15) p.out[O_H_P + ((size_t)l * NB + b) * DRNN + c0 + ch] = carry; }
        __syncthreads();
        { const int o = seg * 32 + lg * 8; h0 = *(LAS f32x4*)(sC + o); h1 = *(LAS f32x4*)(sC + o + 4); }
#pragma unroll
        for (int t = 0; t < 16; ++t) { const F8 la = unpack8(*(const u32x4*)(LA + base + (size_t)t * DRNN)), bv = unpack8(*(const u32x4*)(BV + base + (size_t)t * DRNN)), gt = unpack8(*(const u32x4*)(GB + base + (size_t)t * DRNN));
            f32x4 a0, a1;
#pragma unroll
            for (int e = 0; e < 4; ++e) { a0[e] = __builtin_amdgcn_exp2f(1.442695041f * la.a[e]); a1[e] = __builtin_amdgcn_exp2f(1.442695041f * la.b[e]); }
            h0 = a0 * h0 + bv.a; h1 = a1 * h1 + bv.b;
            *(u32x4*)(Y0 + base + (size_t)t * DRNN) = pack8(gt.a * h0, gt.b * h1); }
        __syncthreads();
    }
    { const float* hin = p.in[4] + (size_t)l * NS * DRNN; float* oh = p.out + O_H_S + (size_t)l * NS * DRNN;
      for (int idx = bid * 512 + tid; idx < NS * DRNN; idx += G * 512) { const size_t off = (size_t)MPR * DRNN + idx;
          const float a = __expf(bf2f(LA[off])), h = a * hin[idx] + bf2f(BV[off]); oh[idx] = h; Y0[off] = f2bf(bf2f(GB[off]) * h); } }
}

__device__ __forceinline__ void phase_merge(const Params& p, int bid, int NG) {
    const bf16_t* G = (const bf16_t*)(p.ws + WS_Z); bf16_t* XN = (bf16_t*)(p.ws + WS_XN);
    int tid = threadIdx.x; asm volatile("" : "+v"(tid));
    for (int idx = bid * 512 + tid; idx < MPAD * 128; idx += NG * 512) { const int row = idx >> 7, c = (idx & 127) * 8;
        const bf16_t* gr = G + (size_t)row * 3072 + c; const F8 a = unpack8(*(const u32x4*)gr), b = unpack8(*(const u32x4*)(gr + 1024)), d = unpack8(*(const u32x4*)(gr + 2048));
        *(u32x4*)(XN + (size_t)row * DM + c) = pack8(a.a + b.a + d.a, a.b + b.b + d.b); }
}

__device__ __forceinline__ void phase_final(const Params& p, int bid, int G) {
    int tid = threadIdx.x; asm volatile("" : "+v"(tid));
    const int wave = tid >> 6, lane = tid & 63; const float* g = p.in[30];
    for (int row = bid * 8 + wave; row < MROWS; row += G * 8) {
        f32x4* xr = (f32x4*)(p.out + (size_t)row * DM) + lane; f32x4 v[4]; float s = 0.f;
#pragma unroll
        for (int j = 0; j < 4; ++j) { v[j] = xr[64 * j]; s += (v[j][0] * v[j][0] + v[j][1] * v[j][1]) + (v[j][2] * v[j][2] + v[j][3] * v[j][3]); }
        const float rstd = rsqrtf(wave_sum(s) * (1.f / DM) + 1e-6f); const f32x4* gr = (const f32x4*)g + lane;
#pragma unroll
        for (int j = 0; j < 4; ++j) xr[64 * j] = v[j] * rstd * gr[64 * j];
    }
}


#define XB_TMO      128
#define XB_XCNT(j)  (256  + 64 * (j))
#define XB_XSUB(j)  (1280 + 64 * (j))
#define XB_XGEN(j)  (2304 + 64 * (j))
#define XB_TOP      3328
#define XB_TOPGEN   3392
#define XCD_BAR_WORDS 3456
#define XB_SPIN_CAP (1u << 18)
__device__ __forceinline__ unsigned xb_ld(unsigned* p)              { return __hip_atomic_load(p, __ATOMIC_RELAXED, __HIP_MEMORY_SCOPE_AGENT); }
__device__ __forceinline__ unsigned xb_add(unsigned* p, unsigned v) { return __hip_atomic_fetch_add(p, v, __ATOMIC_RELAXED, __HIP_MEMORY_SCOPE_AGENT); }
__device__ __forceinline__ unsigned xb_xcc_id() { return (unsigned)__builtin_amdgcn_s_getreg((3 << 11) | 20) & 0xFu; }
#define XB_SPIN(cond, bar) do { unsigned _sp = 0; while (cond) { __builtin_amdgcn_s_sleep(1); \
    if ((++_sp & 255u) == 0u) { if (xb_ld(&(bar)[XB_TMO])) break; if (_sp > XB_SPIN_CAP) { atomicAdd(&(bar)[XB_TMO], 1u); break; } } } } while (0)
__device__ __forceinline__ void xcd_barrier_complete(unsigned* bar, unsigned x, unsigned G, unsigned& nloc, unsigned& nx) {
    unsigned sum, cnt, mine, sp = 0u;
    for (;;) {
        sum = 0u; cnt = 0u; mine = 0u;
#pragma unroll
        for (unsigned j = 0; j < 16; ++j) { const unsigned c = xb_ld(&bar[XB_XCNT(j)]); sum += c; cnt += (c > 0u) ? 1u : 0u; mine = (j == x) ? c : mine; }
        if (sum == G) break;
        __builtin_amdgcn_s_sleep(1);
        if ((++sp & 255u) == 0u) { if (xb_ld(&bar[XB_TMO])) break; if (sp > XB_SPIN_CAP) { atomicAdd(&bar[XB_TMO], 1u); break; } }
    }
    nloc = mine > 0u ? mine : 1u; nx = cnt > 0u ? cnt : 1u;
}
__device__ __forceinline__ void xcd_barrier(unsigned* bar, volatile LAS unsigned* st, unsigned G) {
    asm volatile("s_waitcnt vmcnt(0)" ::: "memory");
    __syncthreads();
    if (threadIdx.x == 0) {
        const unsigned x = xb_xcc_id();
        __builtin_amdgcn_s_waitcnt(0);
        unsigned nloc = st[0], nx = st[1];
        if (nloc == 0u) { xcd_barrier_complete(bar, x, G, nloc, nx); st[0] = nloc; st[1] = nx; }
        const unsigned old = xb_add(&bar[XB_XSUB(x)], 1u);
        const unsigned gen = old / nloc;
        if (old + 1u == (gen + 1u) * nloc) {
            __builtin_amdgcn_fence(__ATOMIC_RELEASE, "agent");
            asm volatile("s_waitcnt vmcnt(0)" ::: "memory");
            const unsigned og = xb_add(&bar[XB_TOP], 1u);
            const unsigned tg = og / nx;
            if (og + 1u == (tg + 1u) * nx) xb_add(&bar[XB_TOPGEN], 1u);
            else XB_SPIN(xb_ld(&bar[XB_TOPGEN]) == tg, bar);
            __builtin_amdgcn_fence(__ATOMIC_ACQUIRE, "agent");
            xb_add(&bar[XB_XGEN(x)], 1u);
            asm volatile("s_waitcnt vmcnt(0)" ::: "memory");
        } else {
            XB_SPIN(xb_ld(&bar[XB_XGEN(x)]) == gen, bar);
            __builtin_amdgcn_fence(__ATOMIC_ACQUIRE, "agent");
            asm volatile("s_waitcnt vmcnt(0)" ::: "memory");
        }
    }
    __syncthreads();
}

__global__ void __launch_bounds__(512, 2) mega(Params pk) {
    extern __shared__ __attribute__((aligned(16))) unsigned char shm[];
    LAS unsigned char* lds = (LAS unsigned char*)shm;
    cg::grid_group grid = cg::this_grid();
    volatile LAS unsigned* bst = (volatile LAS unsigned*)(lds + 131072 + 1024);
    if (threadIdx.x < 2) bst[threadIdx.x] = 0u;
    if (blockIdx.x == 0) for (int i = threadIdx.x; i < XCD_BAR_WORDS; i += 512) ((unsigned*)(pk.ws + WS_BAR))[i] = 0u;
    __syncthreads();
    bool posted = false;
    for (int ph = pk.ph_lo; ph < pk.ph_hi; ++ph) {
        Params p = pk; int G = gridDim.x, bid = blockIdx.x;
        asm volatile("" : "+s"(p.ws), "+s"(p.out), "+s"(G), "+s"(bid));
        bf16_t* XN = (bf16_t*)(p.ws + WS_XN); bf16_t* Z = (bf16_t*)(p.ws + WS_Z); bf16_t* Y0 = (bf16_t*)(p.ws + WS_Y); bf16_t* W = (bf16_t*)(p.ws + WS_W); bf16_t* H = (bf16_t*)(p.ws + WS_H);
        if (ph == NPH - 1) { phase_final(p, bid, G); }
        else {
            const int l = ph / PH_PER_LAYER, k = ph % PH_PER_LAYER;
            const float* xp = l == 0 ? p.in[0] : p.out; const float* xs = l == 0 ? p.in[1] : p.out + (size_t)MPR * DM;
            pg8::Order S; pg8::Gemm g;
            for (int rep = ((REPMASK >> k) & 1u) ? 2 : 1; rep > 0; --rep)
            switch (k) {
            case 0: phase_prep(p, l, lds, xp, xs, bid, G); break;
            case 1: { S.init(64, ZC / 256, G, bid, 0); g = {XN, W + W_IN, DM, DM, DM}; EpiZ E{Z, p.out, l}; pg8::gemm_phase(lds, g, S, E);
                      sample_gemm<false>(lds, XN + (size_t)MPR * DM, DM, W + W_IN, DM, DM, ZC / 16, bid, G, E); } break;
            case 2: phase_mix(p, l, lds, bid, G); break;
            case 3: { S.init(64, 8, G, bid, 1); g = {Y0, W + W_RI, DRNN, 256, 256};
                      EpiRI E{Y0, Z + UE, Z + 5 * UE, p.in[13] + (size_t)l * DRNN, p.in[15] + (size_t)l * DRNN, (const float*)(p.ws + WS_SP)}; pg8::gemm_phase(lds, g, S, E);
                      sample_gemm<true>(lds, Y0 + (size_t)MPR * DRNN, DRNN, W + W_RI, 256, 256, 64, bid, G, E); } break;
            case 4: phase_scan(p, l, lds, bid, G); break;
            case 5: { S.init(64, 12, G, bid, 0); g = {XN, W + W_IN + (size_t)ZC * DM, DM, DM, DM}; EpiG E{Z}; pg8::gemm_phase(lds, g, S, E);
                      sample_gemm<false>(lds, XN + (size_t)MPR * DM, DM, W + W_IN + (size_t)ZC * DM, DM, DM, 3072 / 16, bid, G, E); } break;
            case 6: { { S.init(64, 4, G, bid, 0); g = {Y0 + 2 * UE, W + W_PA, DPOOL, DPOOL, DPOOL}; EpiP E{Z, 0}; pg8::gemm_phase(lds, g, S, E);
                        sample_gemm<false>(lds, Y0 + 2 * UE + (size_t)MPR * DPOOL, DPOOL, W + W_PA, DPOOL, DPOOL, 64, bid, G, E); }
                      { S.init(64, 4, G, bid, 0); g = {Y0, W + W_PB, DRNN, DRNN, DRNN}; EpiP E{Z, 1024}; pg8::gemm_phase(lds, g, S, E);
                        sample_gemm<false>(lds, Y0 + (size_t)MPR * DRNN, DRNN, W + W_PB, DRNN, DRNN, 64, (bid + 64) % G, G, E); }
                      { S.init(64, 4, G, bid, 0); g = {Y0 + 3 * UE, W + W_PC, DCH, DCH, DCH}; EpiP E{Z, 2048}; pg8::gemm_phase(lds, g, S, E);
                        sample_gemm<false>(lds, Y0 + 3 * UE + (size_t)MPR * DCH, DCH, W + W_PC, DCH, DCH, 64, (bid + 128) % G, G, E); } } break;
            case 7: phase_merge(p, bid, G); break;
            case 8: { S.init(64, 4, G, bid, 0); g = {XN, W + W_O, DM, DM, DM}; EpiX E{xp, xs, p.out}; pg8::gemm_phase(lds, g, S, E);
                      sample_gemm<false>(lds, XN + (size_t)MPR * DM, DM, W + W_O, DM, DM, 64, bid, G, E); } break;
            case 9: { int tid = threadIdx.x; asm volatile("" : "+v"(tid)); const int wave = tid >> 6, lane = tid & 63; rms_rows(p.out, p.out + (size_t)MPR * DM, p.in[24] + (size_t)l * DM, XN, bid * 8 + wave, G * 8, lane); } break;
            case 10: { S.init(64, 12, G, bid, 0); g = {XN, W + W_G, DM, DM, DM}; EpiGpre E{Z, p.out, l}; pg8::gemm_phase(lds, g, S, E);
                       sample_gemm<false>(lds, XN + (size_t)MPR * DM, DM, W + W_G, DM, DM, 192, bid, G, E); } break;
            case 11: { S.init(64, 12, G, bid, 0); g = {XN, W + W_U, DM, DM, DM};
                       EpiH E{Z, H, p.in[27] + (size_t)l * 3 * DFF, p.in[28] + (size_t)l * DFF, p.in[5] + (size_t)l * NS * 2 * DFF}; pg8::gemm_phase(lds, g, S, E);
                       sample_gemm<false>(lds, XN + (size_t)MPR * DM, DM, W + W_U, DM, DM, 192, bid, G, E); } break;
            default: { S.init(64, 4, G, bid, 0); g = {H, W + W_D, DFF, DFF, DFF}; EpiX E{p.out, p.out + (size_t)MPR * DM, p.out}; pg8::gemm_phase(lds, g, S, E);
                       sample_gemm<false>(lds, H + (size_t)MPR * DFF, DFF, W + W_D, DFF, DFF, 64, bid, G, E); } break;
            }
        }
        if (ph + 1 < pk.ph_hi) {
            if (!posted) {
                grid.sync(); posted = true;
                if (threadIdx.x == 0) (void)xb_add(&((unsigned*)(pk.ws + WS_BAR))[XB_XCNT(xb_xcc_id())], 1u);
            } else xcd_barrier((unsigned*)(pk.ws + WS_BAR), bst, (unsigned)gridDim.x);
            for (int e = 0; e < EXTRA_SYNCS; ++e) xcd_barrier((unsigned*)(pk.ws + WS_BAR), bst, (unsigned)gridDim.x);
        }
    }
}

extern "C" void kernel_launch(void* const* d_in, const int* in_sizes, int n_in, void* d_out, int out_size, void* d_ws, size_t ws_size, hipStream_t stream) {
    static int grid = 0;
    if (grid == 0) {
        int dev = 0, cus = 0, per_cu = 0;
        hipGetDevice(&dev);
        hipDeviceGetAttribute(&cus, hipDeviceAttributeMultiprocessorCount, dev);
        if (hipFuncSetAttribute((const void*)mega, hipFuncAttributeMaxDynamicSharedMemorySize, LDS_BYTES) != hipSuccess) fprintf(stderr, "kernel_launch: hipFuncSetAttribute failed\n");
        if (hipOccupancyMaxActiveBlocksPerMultiprocessor(&per_cu, (const void*)mega, 512, LDS_BYTES) != hipSuccess || per_cu < 1) { fprintf(stderr, "kernel_launch: occupancy query says %d blocks per CU\n", per_cu); per_cu = 1; }
        (void)hipGetLastError();
        grid = cus;
        if (n_in != 31 || ws_size < WS_END) fprintf(stderr, "kernel_launch: unexpected n_in %d / ws_size %zu (need %zu)\n", n_in, ws_size, (size_t)WS_END);
    }
    Params p{};
    for (int i = 0; i < 31; ++i) p.in[i] = (const float*)d_in[i];
    p.out = (float*)d_out; p.ws = (unsigned char*)d_ws; p.ph_lo = 0; p.ph_hi = NPH;
    void* args[] = {&p};
    hipError_t e = hipLaunchCooperativeKernel((const void*)mega, dim3(grid), dim3(512), args, LDS_BYTES, stream);
    if (e != hipSuccess) fprintf(stderr, "cooperative launch failed: %s (grid %d)\n", hipGetErrorString(e), grid);
}
```

```cpp
#include <hip/hip_runtime.h>
#include <hip/hip_cooperative_groups.h>
#include <cstdio>
#include <cstdint>
namespace cg = cooperative_groups;

#define LAS __attribute__((address_space(3)))
typedef unsigned short bf16_t;
typedef short bf16x8 __attribute__((ext_vector_type(8)));
typedef float f32x4 __attribute__((ext_vector_type(4)));
typedef float f32x2 __attribute__((ext_vector_type(2)));
typedef unsigned u32x4 __attribute__((ext_vector_type(4)));
typedef unsigned u32x2 __attribute__((ext_vector_type(2)));

constexpr int DM = 1024, NB = 8, SEQ = 2048, MPR = NB * SEQ, NS = 128, MROWS = MPR + NS, MPAD = 16640, NTM = MPAD / 256;
constexpr int DPOOL = 512, DRNN = 1024, DCH = 512, DFF = 3072, INCOLS = 6656, ZC = 3584;
constexpr int NLAYER = 2, PH_PER_LAYER = 13, NPH = NLAYER * PH_PER_LAYER + 1;
constexpr size_t O_Y = 0;
constexpr size_t O_POOL_P = (size_t)MROWS * DM;
constexpr size_t O_POOL_S = O_POOL_P + (size_t)2 * NB * 15 * DPOOL;
constexpr size_t O_RC_P = O_POOL_S + (size_t)2 * NS * 15 * DPOOL;
constexpr size_t O_RC_S = O_RC_P + (size_t)2 * NB * 3 * DRNN;
constexpr size_t O_H_P = O_RC_S + (size_t)2 * NS * 3 * DRNN;
constexpr size_t O_H_S = O_H_P + (size_t)2 * NB * DRNN;
constexpr size_t O_FF_P = O_H_S + (size_t)2 * NS * DRNN;
constexpr size_t O_FF_S = O_FF_P + (size_t)2 * NB * 2 * DFF;
constexpr size_t O_CV_S = O_FF_S + (size_t)2 * NS * 2 * DFF;
constexpr size_t UE = (size_t)MPAD * 512, UB = UE * 2;
constexpr size_t WS_BAR = 16384;
constexpr size_t WS_SP = 4096;
constexpr size_t WS_XN = 1u << 20;
constexpr size_t WS_Z = WS_XN + 2 * UB;
constexpr size_t WS_Y = WS_Z + 7 * UB;
constexpr size_t WS_W = WS_Y + 4 * UB;
constexpr size_t WS_H = WS_Z + 6 * UB;
constexpr size_t W_IN = 0;
constexpr size_t W_PA = W_IN + (size_t)INCOLS * DM;
constexpr size_t W_PB = W_PA + (size_t)DM * DPOOL;
constexpr size_t W_PC = W_PB + (size_t)DM * DRNN;
constexpr size_t W_O = W_PC + (size_t)DM * DCH;
constexpr size_t W_G = W_O + (size_t)DM * DM;
constexpr size_t W_U = W_G + (size_t)DFF * DM;
constexpr size_t W_D = W_U + (size_t)DFF * DM;
constexpr size_t W_RI = W_D + (size_t)DM * DFF;
constexpr size_t W_END = W_RI + (size_t)8 * 256 * 256;
constexpr size_t WS_END = WS_W + W_END * 2;
static_assert(WS_END <= (256u << 20), "workspace");
static_assert(WS_H + 6 * UB <= WS_W + (W_G)*2, "h overlay must not reach wg/wu/wd");
constexpr int LDS_BYTES = 131072 + 2048;
#ifndef REPMASK
#define REPMASK 0u
#endif
#ifndef EXTRA_SYNCS
#define EXTRA_SYNCS 0
#endif

struct Params { const float* in[31]; float* out; unsigned char* ws; int ph_lo, ph_hi; };

__device__ __forceinline__ float bf_lo(unsigned w) { return __builtin_bit_cast(float, w << 16); }
__device__ __forceinline__ float bf_hi(unsigned w) { return __builtin_bit_cast(float, w & 0xffff0000u); }
__device__ __forceinline__ float bf2f(bf16_t b) { return __builtin_bit_cast(float, (unsigned)b << 16); }
typedef __bf16 bf16x2_t __attribute__((ext_vector_type(2)));
__device__ __forceinline__ unsigned pk2(float lo, float hi) { f32x2 v = {lo, hi}; bf16x2_t b = __builtin_convertvector(v, bf16x2_t); return __builtin_bit_cast(unsigned, b); }
__device__ __forceinline__ bf16_t f2bf(float f) { return (bf16_t)(pk2(f, 0.f) & 0xffffu); }
struct F8 { f32x4 a, b; };
__device__ __forceinline__ F8 unpack8(u32x4 w) { F8 r; r.a[0] = bf_lo(w.x); r.a[1] = bf_hi(w.x); r.a[2] = bf_lo(w.y); r.a[3] = bf_hi(w.y); r.b[0] = bf_lo(w.z); r.b[1] = bf_hi(w.z); r.b[2] = bf_lo(w.w); r.b[3] = bf_hi(w.w); return r; }
__device__ __forceinline__ u32x4 pack8(f32x4 a, f32x4 b) { u32x4 w; w.x = pk2(a[0], a[1]); w.y = pk2(a[2], a[3]); w.z = pk2(b[0], b[1]); w.w = pk2(b[2], b[3]); return w; }
__device__ __forceinline__ float gelu_t(float x) {
    const float u = 0.7978845608f * (x + 0.044715f * x * x * x);
    const float e = __builtin_amdgcn_exp2f(-2.885390082f * u);
    return x * __builtin_amdgcn_rcpf(1.f + e);
}
__device__ __forceinline__ f32x4 gelu4(f32x4 v) { f32x4 r; r[0] = gelu_t(v[0]); r[1] = gelu_t(v[1]); r[2] = gelu_t(v[2]); r[3] = gelu_t(v[3]); return r; }
__device__ __forceinline__ float sigm(float x) { return __builtin_amdgcn_rcpf(1.f + __builtin_amdgcn_exp2f(-1.442695041f * x)); }
__device__ __forceinline__ f32x4 sigm4(f32x4 v) { f32x4 r; r[0] = sigm(v[0]); r[1] = sigm(v[1]); r[2] = sigm(v[2]); r[3] = sigm(v[3]); return r; }
__device__ __forceinline__ float wave_sum(float v) {
#pragma unroll
    for (int o = 1; o < 64; o <<= 1) v += __shfl_xor(v, o);
    return v;
}

namespace pg8 {
constexpr int BM = 256, BK = 64, HALF = 128, HTB = HALF * BK * 2, STAGE_BYTES = 8 * HTB, NXCD = 8, WGM = 8;
__device__ __forceinline__ int lds_byte(int r, int c) { const int st = (r >> 4) * 2 + (c >> 5), rr = r & 15, cc = c & 31, ob = rr * 64 + cc * 2; return st * 1024 + (ob ^ (((ob >> 9) & 1) << 5)); }
__device__ __forceinline__ void stage_rc(int b, int& R, int& C) { const int st = b / 1024, sb = b % 1024, swz = sb ^ (((sb >> 9) & 1) << 5); R = (st >> 1) * 16 + swz / 64; C = (st & 1) * 32 + (swz % 64) / 2; }
__device__ __forceinline__ int perm32(int rho) { const int n = rho >> 4, i = rho & 15; return 8 * (i >> 2) + 4 * n + (i & 3); }

struct Unit { int pm, pn, ka; };
struct Gemm { const bf16_t* A; const bf16_t* Bt; int lda, ldb, K; };

struct Order {
    int nM, nN, nwg, G, c, mode;
    __device__ __forceinline__ void init(int nM_, int nN_, int G_, int c_, int mode_) { nM = nM_; nN = nN_; nwg = nM * nN; G = G_; c = c_; mode = mode_; }
    __device__ __forceinline__ bool next(int i, Unit& u) const {
        const long L = (long)i * G + c; if (L >= nwg) return false;
        int wgid = (int)L; { const int q = nwg / NXCD, r = nwg % NXCD, xcd = wgid % NXCD, off = wgid / NXCD; wgid = (xcd < r ? xcd * (q + 1) : r * (q + 1) + (xcd - r) * q) + off; }
        const int nig = WGM * nN, gid = wgid / nig, fm = gid * WGM, gsz = (nM - fm) < WGM ? (nM - fm) : WGM;
        u.pm = fm + ((wgid % nig) % gsz); u.pn = (wgid % nig) / gsz; u.ka = mode ? ((u.pn & ~1) * 128) : 0; return true;
    }
};

template <class Epi>
__device__ __forceinline__ void gemm_phase(LAS unsigned char* lds, const Gemm g, const Order& S, const Epi& E) {
    int tid = threadIdx.x; asm volatile("" : "+v"(tid));
    const int wid = __builtin_amdgcn_readfirstlane(tid >> 6), lane = tid & 63, wr = wid >> 2, wc = wid & 3, fr = lane & 15, fq = lane >> 4;
    const int K = g.K, nt = K / BK;
    unsigned voffA[2], voffB[2];
#pragma unroll
    for (int i = 0; i < 2; ++i) { int R, C; stage_rc(tid * 16 + i * 8192, R, C); const int Rb = Epi::PERM ? ((R & ~31) + perm32(R & 31)) : R;
        voffA[i] = (unsigned)(R * g.lda + C) * 2u; voffB[i] = (unsigned)(Rb * g.ldb + C) * 2u; }
    const size_t kstep = (size_t)(BK * 2);
    const size_t hstepA = (size_t)HALF * g.lda * 2, tstepA = 2 * hstepA;
    const size_t hstepB = (size_t)HALF * g.ldb * 2, tstepB = 2 * hstepB;
    const unsigned ldsw = (unsigned)wid * 1024u;
    const int aoff = lds_byte(wr * 64 + fr, fq * 8), boff = lds_byte(wc * 32 + fr, fq * 8);
#define PG8_SA(b, h) (((b) * 2 + (h)) * HTB)
#define PG8_SB(b, h) ((4 + (b) * 2 + (h)) * HTB)
#define PG8_STAGE(bufoff, gbase, voff) do { _Pragma("unroll") for (int _i = 0; _i < 2; ++_i) \
        __builtin_amdgcn_global_load_lds((const unsigned*)((const char*)(gbase) + (voff)[_i]), (LAS unsigned*)(lds + (bufoff) + ldsw + _i * 8192), 16, 0, 0); } while (0)
#define PG8_LDA(dst, b, h) do { _Pragma("unroll") for (int m = 0; m < 4; ++m) _Pragma("unroll") for (int k = 0; k < 2; ++k) dst[m][k] = *(const LAS bf16x8*)(lds + PG8_SA(b, h) + aoff + m * 2048 + k * 1024); } while (0)
#define PG8_LDB(dst, b, h) do { _Pragma("unroll") for (int n = 0; n < 2; ++n) _Pragma("unroll") for (int k = 0; k < 2; ++k) dst[n][k] = *(const LAS bf16x8*)(lds + PG8_SB(b, h) + boff + n * 2048 + k * 1024); } while (0)
#define PG8_MMA(ai, bj, At, Bt) do { __builtin_amdgcn_s_setprio(1); _Pragma("unroll") for (int m = 0; m < 4; ++m) _Pragma("unroll") for (int n = 0; n < 2; ++n) _Pragma("unroll") for (int k = 0; k < 2; ++k) \
        acc[ai][bj][m][n] = __builtin_amdgcn_mfma_f32_16x16x32_bf16(Bt[n][k], At[m][k], acc[ai][bj][m][n], 0, 0, 0); __builtin_amdgcn_s_setprio(0); } while (0)
#define PG8_WAIT_V(n) asm volatile("s_waitcnt vmcnt(" #n ")" ::: "memory")
#define PG8_WAIT_L(n) asm volatile("s_waitcnt lgkmcnt(" #n ")" ::: "memory")
#define PG8_BAR __builtin_amdgcn_s_barrier()
#define PG8_SCHED __builtin_amdgcn_sched_barrier(0)
    Unit cur, nxt; int ui = 0;
    if (!S.next(0, cur)) return;
    f32x4 acc[2][2][4][2];
#pragma unroll
    for (int a = 0; a < 2; ++a)
#pragma unroll
        for (int b = 0; b < 2; ++b)
#pragma unroll
            for (int m = 0; m < 4; ++m)
#pragma unroll
                for (int n = 0; n < 2; ++n) acc[a][b][m][n] = (f32x4){0.f, 0.f, 0.f, 0.f};
    bf16x8 At[4][2], B0[2][2], B1[2][2];
    const char* cA = (const char*)g.A + (size_t)cur.pm * tstepA + (size_t)cur.ka * 2; const char* cB = (const char*)g.Bt + (size_t)cur.pn * tstepB;
    PG8_STAGE(PG8_SB(0, 0), cB, voffB); PG8_STAGE(PG8_SB(0, 1), cB + hstepB, voffB); PG8_STAGE(PG8_SA(0, 0), cA, voffA); PG8_STAGE(PG8_SA(0, 1), cA + hstepA, voffA);
    if (wr == 1) PG8_BAR;
    PG8_WAIT_V(2); PG8_BAR;
    PG8_STAGE(PG8_SB(1, 0), cB + kstep, voffB); PG8_STAGE(PG8_SA(1, 0), cA + kstep, voffA); PG8_STAGE(PG8_SB(1, 1), cB + hstepB + kstep, voffB);
    PG8_WAIT_V(6); PG8_BAR;
    for (;;) {
        const bool has_next = S.next(ui + 1, nxt);
        const char* nA = has_next ? (const char*)g.A + (size_t)nxt.pm * tstepA + (size_t)nxt.ka * 2 : cA; const char* nB = has_next ? (const char*)g.Bt + (size_t)nxt.pn * tstepB : cB;
#pragma unroll 1
        for (int t = 0; t < nt; t += 2) {
            const bool last = (t == nt - 2);
            const char* a1 = cA + (size_t)(t + 1) * kstep;
            const char* a2 = last ? nA : cA + (size_t)(t + 2) * kstep; const char* b2 = last ? nB : cB + (size_t)(t + 2) * kstep;
            const char* a3 = a2 + kstep; const char* b3 = b2 + kstep;
            PG8_LDB(B0, 0, 0); PG8_LDB(B1, 0, 1); PG8_SCHED; PG8_LDA(At, 0, 0); PG8_STAGE(PG8_SA(1, 1), a1 + hstepA, voffA);
            PG8_WAIT_V(8); PG8_WAIT_L(0); PG8_BAR; PG8_MMA(0, 0, At, B0); PG8_MMA(0, 1, At, B1); PG8_BAR; PG8_SCHED;
            PG8_LDA(At, 0, 1); PG8_STAGE(PG8_SB(0, 0), b2, voffB); PG8_STAGE(PG8_SB(0, 1), b2 + hstepB, voffB); PG8_STAGE(PG8_SA(0, 0), a2, voffA);
            PG8_WAIT_V(8); PG8_WAIT_L(0); PG8_BAR; PG8_MMA(1, 0, At, B0); PG8_MMA(1, 1, At, B1); PG8_BAR; PG8_SCHED;
            PG8_LDB(B0, 1, 0); PG8_LDB(B1, 1, 1); PG8_SCHED; PG8_LDA(At, 1, 0); PG8_STAGE(PG8_SA(0, 1), a2 + hstepA, voffA);
            PG8_WAIT_V(8); PG8_WAIT_L(0); PG8_BAR; PG8_MMA(0, 0, At, B0); PG8_MMA(0, 1, At, B1); PG8_BAR; PG8_SCHED;
            PG8_LDA(At, 1, 1); PG8_STAGE(PG8_SB(1, 0), b3, voffB); PG8_STAGE(PG8_SB(1, 1), b3 + hstepB, voffB); PG8_STAGE(PG8_SA(1, 0), a3, voffA);
            PG8_WAIT_V(8); PG8_WAIT_L(0); PG8_BAR; PG8_MMA(1, 0, At, B0); PG8_MMA(1, 1, At, B1); PG8_BAR; PG8_SCHED;
        }
        if (wr == 0) PG8_BAR;
        { int fr2 = fr, fq2 = fq; asm volatile("" : "+v"(fr2), "+v"(fq2));
          E(acc, cur, wr, wc, fr2, fq2); }
        if (!has_next) break;
#pragma unroll
        for (int a = 0; a < 2; ++a)
#pragma unroll
            for (int b = 0; b < 2; ++b)
#pragma unroll
                for (int m = 0; m < 4; ++m)
#pragma unroll
                    for (int n = 0; n < 2; ++n) acc[a][b][m][n] = (f32x4){0.f, 0.f, 0.f, 0.f};
        cur = nxt; cA = nA; cB = nB; ++ui;
        if (wr == 1) PG8_BAR;
    }
    PG8_WAIT_V(0);
    PG8_BAR;
#undef PG8_SA
#undef PG8_SB
#undef PG8_STAGE
#undef PG8_LDA
#undef PG8_LDB
#undef PG8_MMA
#undef PG8_WAIT_V
#undef PG8_WAIT_L
#undef PG8_BAR
#undef PG8_SCHED
}
}
using pg8::Unit;

#define EPI_ARGS const f32x4 (&acc)[2][2][4][2], const Unit& u, int wr, int wc, int fr, int fq
struct EpiZ {
    static constexpr bool PERM = true;
    bf16_t* Z; float* out; int l;
    __device__ __forceinline__ void operator()(EPI_ARGS) const {
        const int pn = u.pn; bf16_t* base; int ld, ct; bool act;
        if (pn < 2) { base = Z; ld = 512; ct = pn * 256; act = false; }
        else if (pn < 6) { base = Z + UE; ld = 1024; ct = (pn - 2) * 256; act = false; }
        else if (pn < 10) { base = Z + 3 * UE; ld = 1024; ct = (pn - 6) * 256; act = true; }
        else if (pn < 12) { base = Z + 5 * UE; ld = 512; ct = (pn - 10) * 256; act = true; }
        else { base = Z + 6 * UE; ld = 512; ct = (pn - 12) * 256; act = true; }
        const bool st = (pn < 6) && (((u.pm & 7) == 7) || u.pm == 64);
#pragma unroll
        for (int ai = 0; ai < 2; ++ai)
#pragma unroll
            for (int m = 0; m < 4; ++m) {
                const int row = u.pm * 256 + ai * 128 + wr * 64 + m * 16 + fr;
#pragma unroll
                for (int bj = 0; bj < 2; ++bj) {
                    f32x4 v0 = acc[ai][bj][m][0], v1 = acc[ai][bj][m][1];
                    const int c = ct + bj * 128 + wc * 32 + 8 * fq;
                    if (st) {
                        float* o = nullptr;
                        if (row < MPR) { const int t = row & 2047, b = row >> 11;
                            if (pn < 2) { if (t >= 2033) o = out + O_POOL_P + ((size_t)(l * NB + b) * 15 + (t - 2033)) * DPOOL + c; }
                            else { if (t >= 2045) o = out + O_RC_P + ((size_t)(l * NB + b) * 3 + (t - 2045)) * DRNN + c; } }
                        else if (row < MROWS) { const int s = row - MPR;
                            if (pn < 2) o = out + O_POOL_S + ((size_t)(l * NS + s) * 15 + 14) * DPOOL + c;
                            else o = out + O_RC_S + ((size_t)(l * NS + s) * 3 + 2) * DRNN + c; }
                        if (o) { *(f32x4*)o = v0; *(f32x4*)(o + 4) = v1; }
                    }
                    if (act) { v0 = gelu4(v0); v1 = gelu4(v1); }
                    *(u32x4*)(base + (size_t)row * ld + c) = pack8(v0, v1);
                    asm volatile("" ::: "memory");
                }
            }
    }
    __device__ __forceinline__ void sample(int row, int col, f32x4 v) const {
        const int s = row - MPR; bf16_t* dst;
        if (col < 512) { dst = Z + (size_t)row * 512 + col; *(f32x4*)(out + O_POOL_S + ((size_t)(l * NS + s) * 15 + 14) * DPOOL + col) = v; }
        else if (col < 1536) { dst = Z + UE + (size_t)row * 1024 + (col - 512); *(f32x4*)(out + O_RC_S + ((size_t)(l * NS + s) * 3 + 2) * DRNN + (col - 512)) = v; }
        else if (col < 2560) { dst = Z + 3 * UE + (size_t)row * 1024 + (col - 1536); v = gelu4(v); }
        else if (col < 3072) { dst = Z + 5 * UE + (size_t)row * 512 + (col - 2560); v = gelu4(v); }
        else { dst = Z + 6 * UE + (size_t)row * 512 + (col - 3072); v = gelu4(v); }
        u32x2 w; w.x = pk2(v[0], v[1]); w.y = pk2(v[2], v[3]); *(u32x2*)dst = w;
    }
};
struct EpiRI {
    static constexpr bool PERM = true;
    const bf16_t* BC; bf16_t* LA; bf16_t* BV; const float* ba; const float* bx; const float* sp;
    __device__ __forceinline__ void operator()(EPI_ARGS) const {
        const int ch = u.pn * 128 + wc * 32 + 8 * fq;
#pragma unroll
        for (int n = 0; n < 2; ++n) {
            const f32x4 ba0 = *(const f32x4*)(ba + ch + 4 * n), bx0 = *(const f32x4*)(bx + ch + 4 * n), sp0 = *(const f32x4*)(sp + ch + 4 * n);
#pragma unroll
            for (int ai = 0; ai < 2; ++ai) {
                u32x2 xw[4];
#pragma unroll
                for (int m = 0; m < 4; ++m) xw[m] = *(const u32x2*)(BC + (size_t)(u.pm * 256 + ai * 128 + wr * 64 + m * 16 + fr) * DRNN + ch + 4 * n);
#pragma unroll
                for (int m = 0; m < 4; ++m) {
                    const int row = u.pm * 256 + ai * 128 + wr * 64 + m * 16 + fr;
                    const f32x4 xc = (f32x4){bf_lo(xw[m].x), bf_hi(xw[m].x), bf_lo(xw[m].y), bf_hi(xw[m].y)};
                    const f32x4 r0 = sigm4(acc[ai][0][m][n] + ba0), i0 = sigm4(acc[ai][1][m][n] + bx0);
                    const f32x4 la0 = r0 * sp0; f32x4 b0;
#pragma unroll
                    for (int j = 0; j < 4; ++j) { const float x = -2.f * la0[j];
                        const float em = x < 0.03f ? x * (1.f - x * (0.5f - x * (0.16666667f - x * 0.041666668f))) : 1.f - __expf(-x);
                        b0[j] = __builtin_sqrtf(em) * i0[j] * xc[j]; }
                    u32x2 wl, wb; wl.x = pk2(la0[0], la0[1]); wl.y = pk2(la0[2], la0[3]); wb.x = pk2(b0[0], b0[1]); wb.y = pk2(b0[2], b0[3]);
                    *(u32x2*)(LA + (size_t)row * DRNN + ch + 4 * n) = wl;
                    *(u32x2*)(BV + (size_t)row * DRNN + ch + 4 * n) = wb;
                }
                asm volatile("" ::: "memory");
            }
        }
    }
    __device__ __forceinline__ void sample2(int row, int ch, f32x4 vr, f32x4 vi) const {
        const f32x4 ba0 = *(const f32x4*)(ba + ch), bx0 = *(const f32x4*)(bx + ch), sp0 = *(const f32x4*)(sp + ch);
        const u32x2 xw = *(const u32x2*)(BC + (size_t)row * DRNN + ch);
        const f32x4 xc = (f32x4){bf_lo(xw.x), bf_hi(xw.x), bf_lo(xw.y), bf_hi(xw.y)};
        const f32x4 r0 = sigm4(vr + ba0), i0 = sigm4(vi + bx0), la0 = r0 * sp0; f32x4 b0;
#pragma unroll
        for (int j = 0; j < 4; ++j) { const float x = -2.f * la0[j];
            const float em = x < 0.03f ? x * (1.f - x * (0.5f - x * (0.16666667f - x * 0.041666668f))) : 1.f - __expf(-x);
            b0[j] = __builtin_sqrtf(em) * i0[j] * xc[j]; }
        u32x2 wl, wb; wl.x = pk2(la0[0], la0[1]); wl.y = pk2(la0[2], la0[3]); wb.x = pk2(b0[0], b0[1]); wb.y = pk2(b0[2], b0[3]);
        *(u32x2*)(LA + (size_t)row * DRNN + ch) = wl; *(u32x2*)(BV + (size_t)row * DRNN + ch) = wb;
    }
};
struct EpiG {
    static constexpr bool PERM = true;
    bf16_t* G;
    __device__ __forceinline__ void operator()(EPI_ARGS) const {
#pragma unroll
        for (int ai = 0; ai < 2; ++ai)
#pragma unroll
            for (int m = 0; m < 4; ++m) {
                const int row = u.pm * 256 + ai * 128 + wr * 64 + m * 16 + fr;
#pragma unroll
                for (int bj = 0; bj < 2; ++bj) {
                    const int c = u.pn * 256 + bj * 128 + wc * 32 + 8 * fq;
                    *(u32x4*)(G + (size_t)row * 3072 + c) = pack8(sigm4(acc[ai][bj][m][0]), sigm4(acc[ai][bj][m][1]));
                    asm volatile("" ::: "memory");
                }
            }
    }
    __device__ __forceinline__ void sample(int row, int col, f32x4 v) const {
        v = sigm4(v); u32x2 w; w.x = pk2(v[0], v[1]); w.y = pk2(v[2], v[3]); *(u32x2*)(G + (size_t)row * 3072 + col) = w;
    }
};
struct EpiP {
    static constexpr bool PERM = true;
    const bf16_t* G; bf16_t* M; int goff; int first;
    __device__ __forceinline__ void operator()(EPI_ARGS) const {
#pragma unroll
        for (int ai = 0; ai < 2; ++ai)
#pragma unroll
            for (int bj = 0; bj < 2; ++bj) {
                const int c = u.pn * 256 + bj * 128 + wc * 32 + 8 * fq;
                u32x4 gw[4], ow[4];
#pragma unroll
                for (int m = 0; m < 4; ++m) { const int row = u.pm * 256 + ai * 128 + wr * 64 + m * 16 + fr;
                    gw[m] = *(const u32x4*)(G + (size_t)row * 3072 + goff + c);
                    if (!first) ow[m] = *(const u32x4*)(M + (size_t)row * DM + c); }
#pragma unroll
                for (int m = 0; m < 4; ++m) { const int row = u.pm * 256 + ai * 128 + wr * 64 + m * 16 + fr;
                    const F8 gt = unpack8(gw[m]);
                    f32x4 o0 = gt.a * acc[ai][bj][m][0], o1 = gt.b * acc[ai][bj][m][1];
                    if (!first) { const F8 old = unpack8(ow[m]); o0 += old.a; o1 += old.b; }
                    *(u32x4*)(M + (size_t)row * DM + c) = pack8(o0, o1); }
                asm volatile("" ::: "memory");
            }
    }
    __device__ __forceinline__ void sample(int row, int col, f32x4 v) const {
        const u32x2 g = *(const u32x2*)(G + (size_t)row * 3072 + goff + col); u32x2* mp = (u32x2*)(M + (size_t)row * DM + col);
        f32x4 o = (f32x4){bf_lo(g.x) * v[0], bf_hi(g.x) * v[1], bf_lo(g.y) * v[2], bf_hi(g.y) * v[3]};
        if (!first) { const u32x2 old = *mp; o += (f32x4){bf_lo(old.x), bf_hi(old.x), bf_lo(old.y), bf_hi(old.y)}; }
        u32x2 w; w.x = pk2(o[0], o[1]); w.y = pk2(o[2], o[3]); *mp = w;
    }
};
struct EpiX {
    static constexpr bool PERM = false;
    const float* xin_p; const float* xin_s; float* xout;
    __device__ __forceinline__ void operator()(EPI_ARGS) const {
#pragma unroll
        for (int ai = 0; ai < 2; ++ai)
#pragma unroll
            for (int mp = 0; mp < 2; ++mp) {
                f32x4 xv[2][2][2];
#pragma unroll
                for (int mm = 0; mm < 2; ++mm) { const int row = u.pm * 256 + ai * 128 + wr * 64 + (2 * mp + mm) * 16 + fr; const float* src = xin_p + (size_t)row * DM;
#pragma unroll
                    for (int bj = 0; bj < 2; ++bj)
#pragma unroll
                        for (int n = 0; n < 2; ++n) xv[mm][bj][n] = *(const f32x4*)(src + u.pn * 256 + bj * 128 + wc * 32 + 16 * n + 4 * fq); }
#pragma unroll
                for (int mm = 0; mm < 2; ++mm) { const int row = u.pm * 256 + ai * 128 + wr * 64 + (2 * mp + mm) * 16 + fr; float* dst = xout + (size_t)row * DM;
#pragma unroll
                    for (int bj = 0; bj < 2; ++bj)
#pragma unroll
                        for (int n = 0; n < 2; ++n) *(f32x4*)(dst + u.pn * 256 + bj * 128 + wc * 32 + 16 * n + 4 * fq) = xv[mm][bj][n] + acc[ai][bj][2 * mp + mm][n]; }
                asm volatile("" ::: "memory");
            }
    }
    __device__ __forceinline__ void sample(int row, int col, f32x4 v) const {
        *(f32x4*)(xout + (size_t)row * DM + col) = *(const f32x4*)(xin_s + (size_t)(row - MPR) * DM + col) + v;
    }
};
struct EpiGpre {
    static constexpr bool PERM = true;
    bf16_t* GP; float* out; int l;
    __device__ __forceinline__ void operator()(EPI_ARGS) const {
        const bool st = ((u.pm & 7) == 7) || u.pm == 64;
#pragma unroll
        for (int ai = 0; ai < 2; ++ai)
#pragma unroll
            for (int m = 0; m < 4; ++m) {
                const int row = u.pm * 256 + ai * 128 + wr * 64 + m * 16 + fr;
#pragma unroll
                for (int bj = 0; bj < 2; ++bj) {
                    const f32x4 v0 = acc[ai][bj][m][0], v1 = acc[ai][bj][m][1];
                    const int c = u.pn * 256 + bj * 128 + wc * 32 + 8 * fq;
                    if (st) {
                        float* o = nullptr;
                        if (row < MPR) { const int t = row & 2047, b = row >> 11; if (t >= 2046) o = out + O_FF_P + ((size_t)(l * NB + b) * 2 + (t - 2046)) * DFF + c; }
                        else if (row < MROWS) { const int s = row - MPR; o = out + O_FF_S + ((size_t)(l * NS + s) * 2 + 1) * DFF + c; }
                        if (o) { *(f32x4*)o = v0; *(f32x4*)(o + 4) = v1; }
                    }
                    *(u32x4*)(GP + (size_t)row * 3072 + c) = pack8(v0, v1);
                    asm volatile("" ::: "memory");
                }
            }
    }
    __device__ __forceinline__ void sample(int row, int col, f32x4 v) const {
        *(f32x4*)(out + O_FF_S + ((size_t)(l * NS + (row - MPR)) * 2 + 1) * DFF + col) = v;
        u32x2 w; w.x = pk2(v[0], v[1]); w.y = pk2(v[2], v[3]); *(u32x2*)(GP + (size_t)row * 3072 + col) = w;
    }
};
struct EpiH {
    static constexpr bool PERM = true;
    const bf16_t* GP; bf16_t* H; const float* cw; const float* cb; const float* st;
    __device__ __forceinline__ void operator()(EPI_ARGS) const {
#pragma unroll
        for (int bj = 0; bj < 2; ++bj) {
            const int c = u.pn * 256 + bj * 128 + wc * 32 + 8 * fq;
            const f32x4 w00 = *(const f32x4*)(cw + c), w01 = *(const f32x4*)(cw + c + 4);
            const f32x4 w10 = *(const f32x4*)(cw + DFF + c), w11 = *(const f32x4*)(cw + DFF + c + 4);
            const f32x4 w20 = *(const f32x4*)(cw + 2 * DFF + c), w21 = *(const f32x4*)(cw + 2 * DFF + c + 4);
            const f32x4 cb0 = *(const f32x4*)(cb + c), cb1 = *(const f32x4*)(cb + c + 4);
#pragma unroll
            for (int am = 0; am < 4; ++am) {
                u32x4 q0[2], q1[2], q2[2];
#pragma unroll
                for (int mm = 0; mm < 2; ++mm) { const int row = u.pm * 256 + (am >> 1) * 128 + wr * 64 + ((am & 1) * 2 + mm) * 16 + fr, t = row & 2047;
                    q0[mm] = *(const u32x4*)(GP + (size_t)row * 3072 + c);
                    q1[mm] = *(const u32x4*)(GP + (size_t)(t >= 1 ? row - 1 : row) * 3072 + c);
                    q2[mm] = *(const u32x4*)(GP + (size_t)(t >= 2 ? row - 2 : row) * 3072 + c); }
#pragma unroll
                for (int mm = 0; mm < 2; ++mm) { const int ai = am >> 1, m = (am & 1) * 2 + mm; const int row = u.pm * 256 + ai * 128 + wr * 64 + m * 16 + fr, t = row & 2047;
                    const F8 g0 = unpack8(q0[mm]), g1 = unpack8(q1[mm]), g2 = unpack8(q2[mm]);
                    const float k1 = t >= 1 ? 1.f : 0.f, k2 = t >= 2 ? 1.f : 0.f;
                    const f32x4 s0 = cb0 + w20 * g0.a + (w10 * g1.a) * k1 + (w00 * g2.a) * k2, s1 = cb1 + w21 * g0.b + (w11 * g1.b) * k1 + (w01 * g2.b) * k2;
                    *(u32x4*)(H + (size_t)row * 3072 + c) = pack8(gelu4(s0) * acc[ai][bj][m][0], gelu4(s1) * acc[ai][bj][m][1]); }
                asm volatile("" ::: "memory");
            }
        }
    }
    __device__ __forceinline__ void sample(int row, int col, f32x4 v) const {
        const u32x2 gw = *(const u32x2*)(GP + (size_t)row * 3072 + col); const f32x4 g0 = (f32x4){bf_lo(gw.x), bf_hi(gw.x), bf_lo(gw.y), bf_hi(gw.y)};
        const float* sp = st + (size_t)(row - MPR) * 2 * DFF + col;
        const f32x4 s0 = *(const f32x4*)(cb + col) + *(const f32x4*)(cw + 2 * DFF + col) * g0 + *(const f32x4*)(cw + col) * *(const f32x4*)sp + *(const f32x4*)(cw + DFF + col) * *(const f32x4*)(sp + DFF);
        const f32x4 h = gelu4(s0) * v; u32x2 w; w.x = pk2(h[0], h[1]); w.y = pk2(h[2], h[3]); *(u32x2*)(H + (size_t)row * 3072 + col) = w;
    }
};

template <bool DUAL, class Epi>
__device__ __forceinline__ void sample_gemm(LAS unsigned char* lds, const bf16_t* A, int lda, const bf16_t* Bt, int ldb, int K, int nstrips, int bid, int G, const Epi& E) {
    int tid = threadIdx.x; asm volatile("" : "+v"(tid));
    const int kw = __builtin_amdgcn_readfirstlane(tid >> 6), lane = tid & 63, fr = lane & 15, fq = lane >> 4;
    const int kslice = K >> 3, nks = kslice >> 5;
    LAS f32x4* part = (LAS f32x4*)lds;
    for (int strip = G - 1 - bid; strip < nstrips; strip += G) {
        int n0 = strip * 16, acol = 0, h = 0, cc = 0;
        if (DUAL) { h = strip >> 3; cc = (strip & 7) * 16; n0 = h * 256 + cc; acol = (h & ~1) * 128; }
        f32x4 acc[8], acc2[8];
#pragma unroll
        for (int m = 0; m < 8; ++m) { acc[m] = (f32x4){0.f, 0.f, 0.f, 0.f}; acc2[m] = acc[m]; }
        typedef const __attribute__((address_space(1))) bf16x8* gfrag;
        const bf16_t* bp = Bt + (size_t)(n0 + fr) * ldb + kw * kslice + 8 * fq;
        const bf16_t* ap = A + (size_t)fr * lda + acol + kw * kslice + 8 * fq;
#pragma unroll 1
        for (int ks0 = 0; ks0 < nks; ks0 += 2) {
            bf16x8 bb[2], bb2[2], aa[2][8];
#pragma unroll
            for (int u = 0; u < 2; ++u) if (ks0 + u < nks) {
                bb[u] = *(gfrag)(bp + (ks0 + u) * 32);
                if (DUAL) bb2[u] = *(gfrag)(bp + (size_t)128 * ldb + (ks0 + u) * 32);
#pragma unroll
                for (int m = 0; m < 8; ++m) aa[u][m] = *(gfrag)(ap + (size_t)(16 * m) * lda + (ks0 + u) * 32);
            }
            __builtin_amdgcn_sched_barrier(0);
#pragma unroll
            for (int u = 0; u < 2; ++u) if (ks0 + u < nks) {
#pragma unroll
                for (int m = 0; m < 8; ++m) { acc[m] = __builtin_amdgcn_mfma_f32_16x16x32_bf16(bb[u], aa[u][m], acc[m], 0, 0, 0);
                    if (DUAL) acc2[m] = __builtin_amdgcn_mfma_f32_16x16x32_bf16(bb2[u], aa[u][m], acc2[m], 0, 0, 0); }
            }
            __builtin_amdgcn_sched_barrier(0);
        }
#pragma unroll
        for (int m = 0; m < 8; ++m) part[(kw * 8 + m) * 64 + lane] = acc[m];
        __syncthreads();
        f32x4 v = part[kw * 64 + lane];
#pragma unroll
        for (int k2 = 1; k2 < 8; ++k2) v += part[(k2 * 8 + kw) * 64 + lane];
        const int row = MPR + 16 * kw + fr;
        if constexpr (DUAL) {
            __syncthreads();
#pragma unroll
            for (int m = 0; m < 8; ++m) part[(kw * 8 + m) * 64 + lane] = acc2[m];
            __syncthreads();
            f32x4 v2 = part[kw * 64 + lane];
#pragma unroll
            for (int k2 = 1; k2 < 8; ++k2) v2 += part[(k2 * 8 + kw) * 64 + lane];
            E.sample2(row, h * 128 + cc + 4 * fq, v, v2);
        } else E.sample(row, n0 + 4 * fq, v);
        __syncthreads();
    }
}


__device__ __forceinline__ void transpose_item(const float* W, int K, int N, bf16_t* WT, LAS float* scr, int item, int lane) {
    const int nblk = N / 32, kb = item / nblk, nb = item % nblk, k0 = 64 * kb, n0 = 32 * nb;
#pragma unroll 8
    for (int i = 0; i < 32; ++i) { const int kk = 2 * i + (lane >> 5); scr[kk * 33 + (lane & 31)] = W[(size_t)(k0 + kk) * N + n0 + (lane & 31)]; }
    asm volatile("s_waitcnt lgkmcnt(0)" ::: "memory");
    const int c = lane & 7;
#pragma unroll
    for (int j = 0; j < 4; ++j) { const int n = (lane >> 3) + 8 * j; const LAS float* s = scr + (8 * c) * 33 + n;
        u32x4 o; o.x = pk2(s[0 * 33], s[1 * 33]); o.y = pk2(s[2 * 33], s[3 * 33]); o.z = pk2(s[4 * 33], s[5 * 33]); o.w = pk2(s[6 * 33], s[7 * 33]);
        *(u32x4*)(WT + (size_t)(n0 + n) * K + k0 + 8 * c) = o; }
    asm volatile("s_waitcnt lgkmcnt(0)" ::: "memory");
}
__device__ __forceinline__ void rms_row_bf16(const float* xrow, const float* g, bf16_t* orow, int lane) {
    const f32x4* xr = (const f32x4*)xrow + lane; f32x4 v[4]; float s = 0.f;
#pragma unroll
    for (int j = 0; j < 4; ++j) { v[j] = xr[64 * j]; s += (v[j][0] * v[j][0] + v[j][1] * v[j][1]) + (v[j][2] * v[j][2] + v[j][3] * v[j][3]); }
    const float rstd = rsqrtf(wave_sum(s) * (1.f / DM) + 1e-6f);
    const f32x4* gr = (const f32x4*)g + lane; u32x2* o8 = (u32x2*)orow + lane;
#pragma unroll
    for (int j = 0; j < 4; ++j) { const f32x4 o = v[j] * rstd * gr[64 * j]; u32x2 w; w.x = pk2(o[0], o[1]); w.y = pk2(o[2], o[3]); o8[64 * j] = w; }
}
__device__ __forceinline__ void rms_rows(const float* xp, const float* xs, const float* g, bf16_t* XN, int gw, int ngw, int lane) {
    for (int row = gw; row < MPAD; row += ngw) {
        if (row < MROWS) rms_row_bf16(row < MPR ? xp + (size_t)row * DM : xs + (size_t)(row - MPR) * DM, g, XN + (size_t)row * DM, lane);
        else { u32x2* o8 = (u32x2*)(XN + (size_t)row * DM) + lane; u32x2 z; z.x = 0u; z.y = 0u;
#pragma unroll
            for (int j = 0; j < 4; ++j) o8[64 * j] = z; }
    }
}

__device__ __forceinline__ void phase_prep(const Params& p, int l, LAS unsigned char* lds, const float* xp, const float* xs, int bid, int G) {
    int tid = threadIdx.x; asm volatile("" : "+v"(tid));
    const int wave = tid >> 6, lane = tid & 63;
    const int gw = bid * 8 + wave, ngw = G * 8;
    bf16_t* W = (bf16_t*)(p.ws + WS_W);
    LAS float* scr = (LAS float*)(lds + wave * 8448);
    const float* w_in = p.in[7] + (size_t)l * DM * INCOLS; const float* w_pb = p.in[21] + (size_t)l * DRNN * DM; const float* w_pc = p.in[22] + (size_t)l * DCH * DM;
    const float* w_o = p.in[23] + (size_t)l * DM * DM; const float* wg = p.in[25] + (size_t)l * DM * DFF; const float* wu = p.in[26] + (size_t)l * DM * DFF; const float* wd = p.in[29] + (size_t)l * DFF * DM;
    constexpr int I_IN = (DM / 64) * (INCOLS / 32), I_PB = (DRNN / 64) * (DM / 32), I_PC = (DCH / 64) * (DM / 32), I_O = (DM / 64) * (DM / 32), I_G = (DM / 64) * (DFF / 32), I_D = (DFF / 64) * (DM / 32);
    constexpr int NITEMS = I_IN + I_PB + I_PC + I_O + 2 * I_G + I_D;
    for (int it = gw; it < NITEMS; it += ngw) {
        int r = it;
        if (r < I_IN) { transpose_item(w_in, DM, INCOLS, W + W_IN, scr, r, lane); continue; } r -= I_IN;
        if (r < I_PB) { transpose_item(w_pb, DRNN, DM, W + W_PB, scr, r, lane); continue; } r -= I_PB;
        if (r < I_PC) { transpose_item(w_pc, DCH, DM, W + W_PC, scr, r, lane); continue; } r -= I_PC;
        if (r < I_O) { transpose_item(w_o, DM, DM, W + W_O, scr, r, lane); continue; } r -= I_O;
        if (r < I_G) { transpose_item(wg, DM, DFF, W + W_G, scr, r, lane); continue; } r -= I_G;
        if (r < I_G) { transpose_item(wu, DM, DFF, W + W_U, scr, r, lane); continue; } r -= I_G;
        transpose_item(wd, DFF, DM, W + W_D, scr, r, lane);
    }
    const int gt = bid * 512 + tid, ngt = G * 512;
    { const float* pw = p.in[8] + (size_t)l * 4 * 128 * 128; const float* ps = p.in[9] + (size_t)l * DPOOL; const float* w_pa = p.in[20] + (size_t)l * DPOOL * DM;
      for (int idx = gt; idx < DPOOL * DM; idx += ngt) { const int n = idx & 1023, kp = idx >> 10, g = kp >> 7;
          const float* pr = pw + (size_t)kp * 128; const float* sr = ps + g * 128; const float* wr_ = w_pa + (size_t)g * 128 * DM + n; float s = 0.f;
#pragma unroll 8
          for (int j = 0; j < 128; ++j) s += pr[j] * sr[j] * wr_[(size_t)j * DM];
          W[W_PA + (size_t)n * DPOOL + kp] = f2bf(s); } }
    { const float* wa = p.in[12] + (size_t)l * 8 * 128 * 128; const float* wx = p.in[14] + (size_t)l * 8 * 128 * 128;
      for (int idx = gt; idx < 8 * 256 * 256; idx += ngt) { const int k = idx & 255, n = (idx >> 8) & 255, h = idx >> 16; float v = 0.f;
          if ((k >> 7) == (h & 1)) v = (n < 128 ? wa : wx)[((size_t)h * 128 + (k & 127)) * 128 + (n & 127)];
          W[W_RI + idx] = f2bf(v); } }
    if (gt < DRNN) { const float y = __expf(-p.in[16][(size_t)l * DRNN + gt]);
        const float lp = y < 0.05f ? y * (1.f - y * (0.5f - y * (0.33333334f - y * (0.25f - y * 0.2f)))) : __logf(1.f + y);
        ((float*)(p.ws + WS_SP))[gt] = -8.f * lp; }
    rms_rows(xp, xs, p.in[6] + (size_t)l * DM, (bf16_t*)(p.ws + WS_XN), gw, ngw, lane);
}

__device__ __forceinline__ void phase_mix(const Params& p, int l, LAS unsigned char* lds, int bid, int G) {
    int tid = threadIdx.x; asm volatile("" : "+v"(tid));
    const int wave = tid >> 6, lane = tid & 63;
    const bf16_t* Za = (const bf16_t*)(p.ws + WS_Z); const bf16_t* Zbx = Za + UE; const bf16_t* Zgu = Za + 5 * UE; const bf16_t* Zgv = Za + 6 * UE;
    bf16_t* Y0 = (bf16_t*)(p.ws + WS_Y); bf16_t* Yd = Y0 + 2 * UE; bf16_t* Yc = Y0 + 3 * UE;
    const float* vg = p.in[17] + (size_t)l * DCH; const float* cws = p.in[18] + (size_t)l * 4 * 128 * 128; const float* cbs = p.in[19] + (size_t)l * 4 * 128;
    if (bid < 128) {
        const int r0 = bid * 128;
        LAS float* rstd = (LAS float*)lds; LAS bf16_t* VT = (LAS bf16_t*)(lds + 1024);
        { const int j = tid >> 2, q = tid & 3; const u32x4* src = (const u32x4*)(Zgv + (size_t)(r0 + j) * DCH + q * 128); float s = 0.f;
#pragma unroll
          for (int i = 0; i < 16; ++i) { const F8 v = unpack8(src[i]); s += (v.a[0] * v.a[0] + v.a[1] * v.a[1]) + (v.a[2] * v.a[2] + v.a[3] * v.a[3]) + (v.b[0] * v.b[0] + v.b[1] * v.b[1]) + (v.b[2] * v.b[2] + v.b[3] * v.b[3]); }
          s += __shfl_xor(s, 1); s += __shfl_xor(s, 2);
          if (q == 0) rstd[j] = rsqrtf(s * (1.f / DCH) + 1e-6f); }
        __syncthreads();
        const int fr = lane & 15, fq = lane >> 4;
        for (int g = 0; g < 4; ++g) {
            { const int j = tid >> 2, q = tid & 3; const float rs = rstd[j];
              const u32x4* src = (const u32x4*)(Zgv + (size_t)(r0 + j) * DCH + g * 128 + q * 32); const float* gg = vg + g * 128 + q * 32;
#pragma unroll
              for (int i = 0; i < 4; ++i) { const F8 v = unpack8(src[i]); const f32x4 g0 = *(const f32x4*)(gg + 8 * i), g1 = *(const f32x4*)(gg + 8 * i + 4);
                  const int d = q * 32 + 8 * i;
#pragma unroll
                  for (int e = 0; e < 4; ++e) { VT[(d + e) * 136 + j] = f2bf(v.a[e] * rs * g0[e]); VT[(d + 4 + e) * 136 + j] = f2bf(v.b[e] * rs * g1[e]); } } }
            __syncthreads();
            const int i = 16 * wave + fr; bf16x8 af[4];
#pragma unroll
            for (int ks = 0; ks < 4; ++ks) { const int k0 = 32 * ks + 8 * fq; const float* wrow = cws + ((size_t)g * 128 + i) * 128 + k0;
                const f32x4 a0 = *(const f32x4*)wrow, a1 = *(const f32x4*)(wrow + 4); u32x4 w;
                w.x = pk2(k0 + 0 <= i ? a0[0] : 0.f, k0 + 1 <= i ? a0[1] : 0.f); w.y = pk2(k0 + 2 <= i ? a0[2] : 0.f, k0 + 3 <= i ? a0[3] : 0.f);
                w.z = pk2(k0 + 4 <= i ? a1[0] : 0.f, k0 + 5 <= i ? a1[1] : 0.f); w.w = pk2(k0 + 6 <= i ? a1[2] : 0.f, k0 + 7 <= i ? a1[3] : 0.f);
                af[ks] = __builtin_bit_cast(bf16x8, w); }
            const float bsv = cbs[g * 128 + i];
#pragma unroll
            for (int dt = 0; dt < 8; ++dt) {
                f32x4 c4 = (f32x4){0.f, 0.f, 0.f, 0.f};
#pragma unroll
                for (int ks = 0; ks < 4; ++ks) { const bf16x8 vf = *(const LAS bf16x8*)(VT + (16 * dt + fr) * 136 + 32 * ks + 8 * fq);
                    c4 = __builtin_amdgcn_mfma_f32_16x16x32_bf16(vf, af[ks], c4, 0, 0, 0); }
                const size_t off = (size_t)(r0 + i) * DCH + g * 128 + 16 * dt + 4 * fq;
                const u32x2 uu = *(const u32x2*)(Zgu + off); u32x2 o;
                o.x = pk2(bf_lo(uu.x) * (c4[0] + bsv), bf_hi(uu.x) * (c4[1] + bsv)); o.y = pk2(bf_lo(uu.y) * (c4[2] + bsv), bf_hi(uu.y) * (c4[3] + bsv));
                *(u32x2*)(Yc + off) = o;
            }
            __syncthreads();
        }
    } else if (bid < 144) {
        const int s = (bid - 128) * 8 + wave, row = MPR + s, c = lane * 8, g = lane >> 4;
        const F8 v = unpack8(*(const u32x4*)(Zgv + (size_t)row * DCH + c));
        float ss = (v.a[0] * v.a[0] + v.a[1] * v.a[1]) + (v.a[2] * v.a[2] + v.a[3] * v.a[3]) + (v.b[0] * v.b[0] + v.b[1] * v.b[1]) + (v.b[2] * v.b[2] + v.b[3] * v.b[3]);
        const float rs = rsqrtf(wave_sum(ss) * (1.f / DCH) + 1e-6f);
        const f32x4 vn0 = v.a * rs * *(const f32x4*)(vg + c), vn1 = v.b * rs * *(const f32x4*)(vg + c + 4);
        float* ov = p.out + O_CV_S + ((size_t)l * NS + s) * DCH + c; *(f32x4*)ov = vn0; *(f32x4*)(ov + 4) = vn1;
        const float w00 = cws[(size_t)g * 128 * 128], b0 = cbs[g * 128];
        const F8 uu = unpack8(*(const u32x4*)(Zgu + (size_t)row * DCH + c));
        *(u32x4*)(Yc + (size_t)row * DCH + c) = pack8(uu.a * (vn0 * w00 + b0), uu.b * (vn1 * w00 + b0));
    }
    if (bid >= 128) {
    const int et = (bid - 128) * 512 + tid, net = (G - 128) * 512;
    { const float* cw = p.in[10] + (size_t)l * 4 * DRNN; const float* cb = p.in[11] + (size_t)l * DRNN; const float* st = p.in[3] + (size_t)l * NS * 3 * DRNN;
      for (int idx = et; idx < (MPR / 8) * 128; idx += net) { const int r0 = (idx >> 7) * 8, c = (idx & 127) * 8, t0 = r0 & 2047;
          const f32x4 w00 = *(const f32x4*)(cw + c), w01 = *(const f32x4*)(cw + c + 4), w10 = *(const f32x4*)(cw + DRNN + c), w11 = *(const f32x4*)(cw + DRNN + c + 4);
          const f32x4 w20 = *(const f32x4*)(cw + 2 * DRNN + c), w21 = *(const f32x4*)(cw + 2 * DRNN + c + 4), w30 = *(const f32x4*)(cw + 3 * DRNN + c), w31 = *(const f32x4*)(cw + 3 * DRNN + c + 4);
          const f32x4 b0 = *(const f32x4*)(cb + c), b1 = *(const f32x4*)(cb + c + 4);
          F8 x1, x2, x3; const u32x4 zz = (u32x4){0u, 0u, 0u, 0u};
          x3 = unpack8(t0 >= 3 ? *(const u32x4*)(Zbx + (size_t)(r0 - 3) * DRNN + c) : zz); x2 = unpack8(t0 >= 2 ? *(const u32x4*)(Zbx + (size_t)(r0 - 2) * DRNN + c) : zz); x1 = unpack8(t0 >= 1 ? *(const u32x4*)(Zbx + (size_t)(r0 - 1) * DRNN + c) : zz);
#pragma unroll
          for (int i = 0; i < 8; ++i) { const F8 x0 = unpack8(*(const u32x4*)(Zbx + (size_t)(r0 + i) * DRNN + c));
              *(u32x4*)(Y0 + (size_t)(r0 + i) * DRNN + c) = pack8(b0 + w30 * x0.a + w20 * x1.a + w10 * x2.a + w00 * x3.a, b1 + w31 * x0.b + w21 * x1.b + w11 * x2.b + w01 * x3.b);
              x3 = x2; x2 = x1; x1 = x0; } }
      for (int idx = et; idx < NS * 128; idx += net) { const int row = MPR + (idx >> 7), c = (idx & 127) * 8;
          f32x4 s0 = *(const f32x4*)(cb + c), s1 = *(const f32x4*)(cb + c + 4);
          { const F8 x = unpack8(*(const u32x4*)(Zbx + (size_t)row * DRNN + c)); s0 += *(const f32x4*)(cw + 3 * DRNN + c) * x.a; s1 += *(const f32x4*)(cw + 3 * DRNN + c + 4) * x.b; }
          const float* sp = st + (size_t)(row - MPR) * 3 * DRNN + c;
#pragma unroll
          for (int k = 0; k < 3; ++k) { s0 += *(const f32x4*)(cw + k * DRNN + c) * *(const f32x4*)(sp + k * DRNN); s1 += *(const f32x4*)(cw + k * DRNN + c + 4) * *(const f32x4*)(sp + k * DRNN + 4); }
          *(u32x4*)(Y0 + (size_t)row * DRNN + c) = pack8(s0, s1); } }
    { const float* st = p.in[2] + (size_t)l * NS * 15 * DPOOL;
      for (int idx = et; idx < (MPR / 8) * 64; idx += net) { const int g = (idx >> 6) & 3, rb = ((idx >> 8) << 2) + ((idx >> 4) & 3), c = g * 128 + (idx & 15) * 8, w = 2 << g, r0 = rb * 8, t0 = r0 & 2047;
          f32x4 s0 = (f32x4){0.f, 0.f, 0.f, 0.f}, s1 = s0;
#pragma unroll
          for (int j = 1; j < 16; ++j) if (j < w && t0 >= j) { const F8 x = unpack8(*(const u32x4*)(Za + (size_t)(r0 - j) * DPOOL + c)); s0 += x.a; s1 += x.b; }
#pragma unroll
          for (int i = 0; i < 8; ++i) { const F8 cur = unpack8(*(const u32x4*)(Za + (size_t)(r0 + i) * DPOOL + c)); s0 += cur.a; s1 += cur.b;
              const int t = t0 + i; const float ic = 1.f / (float)(t + 1 < w ? t + 1 : w);
              *(u32x4*)(Yd + (size_t)(r0 + i) * DPOOL + c) = pack8(s0 * ic - cur.a, s1 * ic - cur.b);
              if (t >= w - 1) { const F8 old = unpack8(*(const u32x4*)(Za + (size_t)(r0 + i - (w - 1)) * DPOOL + c)); s0 -= old.a; s1 -= old.b; } } }
      for (int idx = et; idx < NS * 64; idx += net) { const int row = MPR + (idx >> 6), c = (idx & 63) * 8, w = 2 << (c >> 7);
          const F8 cur = unpack8(*(const u32x4*)(Za + (size_t)row * DPOOL + c)); f32x4 s0 = cur.a, s1 = cur.b;
          const float* sp = st + (size_t)(row - MPR) * 15 * DPOOL + c;
          for (int j = 1; j < w; ++j) { s0 += *(const f32x4*)(sp + (15 - j) * DPOOL); s1 += *(const f32x4*)(sp + (15 - j) * DPOOL + 4); }
          const float ic = 1.f / (float)w;
          *(u32x4*)(Yd + (size_t)row * DPOOL + c) = pack8(s0 * ic - cur.a, s1 * ic - cur.b); } }
    }
    const int gt = bid * 512 + tid, ngt = G * 512;
    { const float* sp = p.in[2] + (size_t)l * NS * 15 * DPOOL; float* o = p.out + O_POOL_S + (size_t)l * NS * 15 * DPOOL;
      for (int idx = gt; idx < NS * 14 * (DPOOL / 4); idx += ngt) { const int c = (idx & 127) * 4, r = (idx >> 7) % 14, s = (idx >> 7) / 14;
          *(f32x4*)(o + ((size_t)s * 15 + r) * DPOOL + c) = *(const f32x4*)(sp + ((size_t)s * 15 + r + 1) * DPOOL + c); } }
    { const float* sp = p.in[3] + (size_t)l * NS * 3 * DRNN; float* o = p.out + O_RC_S + (size_t)l * NS * 3 * DRNN;
      for (int idx = gt; idx < NS * 2 * (DRNN / 4); idx += ngt) { const int c = (idx & 255) * 4, r = (idx >> 8) & 1, s = idx >> 9;
          *(f32x4*)(o + ((size_t)s * 3 + r) * DRNN + c) = *(const f32x4*)(sp + ((size_t)s * 3 + r + 1) * DRNN + c); } }
    { const float* sp = p.in[5] + (size_t)l * NS * 2 * DFF; float* o = p.out + O_FF_S + (size_t)l * NS * 2 * DFF;
      for (int idx = gt; idx < NS * (DFF / 4); idx += ngt) { const int c = (idx % 768) * 4, s = idx / 768;
          *(f32x4*)(o + ((size_t)s * 2) * DFF + c) = *(const f32x4*)(sp + ((size_t)s * 2 + 1) * DFF + c); } }
}

__device__ __forceinline__ void phase_scan(const Params& p, int l, LAS unsigned char* lds, int bid, int G) {
    int tid = threadIdx.x; asm volatile("" : "+v"(tid));
    const bf16_t* LA = (const bf16_t*)(p.ws + WS_Z) + UE; const bf16_t* BV = (const bf16_t*)(p.ws + WS_Z) + 5 * UE; const bf16_t* GB = (const bf16_t*)(p.ws + WS_Z) + 3 * UE;
    bf16_t* Y0 = (bf16_t*)(p.ws + WS_Y);
    LAS float* sP = (LAS float*)lds; LAS float* sH = sP + 4096; LAS float* sC = sH + 4096; LAS float* sPg = sC + 4096; LAS float* sHg = sPg + 512;
    for (int item = bid; item < 256; item += G) {
        const int b = item >> 5, c0 = (item & 31) * 32, seg = tid >> 2, lg = tid & 3;
        const size_t base = ((size_t)b * SEQ + seg * 16) * DRNN + c0 + lg * 8;
        f32x4 P0 = (f32x4){1.f, 1.f, 1.f, 1.f}, P1 = P0, h0 = (f32x4){0.f, 0.f, 0.f, 0.f}, h1 = h0;
#pragma unroll
        for (int t = 0; t < 16; ++t) { const F8 la = unpack8(*(const u32x4*)(LA + base + (size_t)t * DRNN)), bv = unpack8(*(const u32x4*)(BV + base + (size_t)t * DRNN));
            f32x4 a0, a1;
#pragma unroll
            for (int e = 0; e < 4; ++e) { a0[e] = __builtin_amdgcn_exp2f(1.442695041f * la.a[e]); a1[e] = __builtin_amdgcn_exp2f(1.442695041f * la.b[e]); }
            h0 = a0 * h0 + bv.a; h1 = a1 * h1 + bv.b; P0 *= a0; P1 *= a1; }
        { const int o = seg * 32 + lg * 8; *(LAS f32x4*)(sP + o) = P0; *(LAS f32x4*)(sP + o + 4) = P1; *(LAS f32x4*)(sH + o) = h0; *(LAS f32x4*)(sH + o + 4) = h1; }
        __syncthreads();
        const int ch = tid & 31, sg = tid >> 5;
        { float Pg = 1.f, hg = 0.f;
#pragma unroll
          for (int k = 0; k < 8; ++k) { const float pp = sP[(sg * 8 + k) * 32 + ch], hh = sH[(sg * 8 + k) * 32 + ch]; hg = pp * hg + hh; Pg *= pp; }
          sPg[sg * 32 + ch] = Pg; sHg[sg * 32 + ch] = hg; }
        __syncthreads();
        { float carry = 0.f;
          for (int k = 0; k < sg; ++k) carry = sPg[k * 32 + ch] * carry + sHg[k * 32 + ch];
#pragma unroll
          for (int k = 0; k < 8; ++k) { const int o = (sg * 8 + k) * 32 + ch; sC[o] = carry; carry = sP[o] * carry + sH[o]; }
          if (sg == 15) p.out[O_H_P + ((size_t)l * NB + b) * DRNN + c0 + ch] = carry; }
        __syncthreads();
        { const int o = seg * 32 + lg * 8; h0 = *(LAS f32x4*)(sC + o); h1 = *(LAS f32x4*)(sC + o + 4); }
#pragma unroll
        for (int t = 0; t < 16; ++t) { const F8 la = unpack8(*(const u32x4*)(LA + base + (size_t)t * DRNN)), bv = unpack8(*(const u32x4*)(BV + base + (size_t)t * DRNN)), gt = unpack8(*(const u32x4*)(GB + base + (size_t)t * DRNN));
            f32x4 a0, a1;
#pragma unroll
            for (int e = 0; e < 4; ++e) { a0[e] = __builtin_amdgcn_exp2f(1.442695041f * la.a[e]); a1[e] = __builtin_amdgcn_exp2f(1.442695041f * la.b[e]); }
            h0 = a0 * h0 + bv.a; h1 = a1 * h1 + bv.b;
            *(u32x4*)(Y0 + base + (size_t)t * DRNN) = pack8(gt.a * h0, gt.b * h1); }
        __syncthreads();
    }
    { const float* hin = p.in[4] + (size_t)l * NS * DRNN; float* oh = p.out + O_H_S + (size_t)l * NS * DRNN;
      for (int idx = bid * 512 + tid; idx < NS * DRNN; idx += G * 512) { const size_t off = (size_t)MPR * DRNN + idx;
          const float a = __expf(bf2f(LA[off])), h = a * hin[idx] + bf2f(BV[off]); oh[idx] = h; Y0[off] = f2bf(bf2f(GB[off]) * h); } }
}

__device__ __forceinline__ void phase_merge(const Params& p, int bid, int NG) {
    const bf16_t* G = (const bf16_t*)(p.ws + WS_Z); bf16_t* XN = (bf16_t*)(p.ws + WS_XN);
    int tid = threadIdx.x; asm volatile("" : "+v"(tid));
    for (int idx = bid * 512 + tid; idx < MPAD * 128; idx += NG * 512) { const int row = idx >> 7, c = (idx & 127) * 8;
        const bf16_t* gr = G + (size_t)row * 3072 + c; const F8 a = unpack8(*(const u32x4*)gr), b = unpack8(*(const u32x4*)(gr + 1024)), d = unpack8(*(const u32x4*)(gr + 2048));
        *(u32x4*)(XN + (size_t)row * DM + c) = pack8(a.a + b.a + d.a, a.b + b.b + d.b); }
}

__device__ __forceinline__ void phase_final(const Params& p, int bid, int G) {
    int tid = threadIdx.x; asm volatile("" : "+v"(tid));
    const int wave = tid >> 6, lane = tid & 63; const float* g = p.in[30];
    for (int row = bid * 8 + wave; row < MROWS; row += G * 8) {
        f32x4* xr = (f32x4*)(p.out + (size_t)row * DM) + lane; f32x4 v[4]; float s = 0.f;
#pragma unroll
        for (int j = 0; j < 4; ++j) { v[j] = xr[64 * j]; s += (v[j][0] * v[j][0] + v[j][1] * v[j][1]) + (v[j][2] * v[j][2] + v[j][3] * v[j][3]); }
        const float rstd = rsqrtf(wave_sum(s) * (1.f / DM) + 1e-6f); const f32x4* gr = (const f32x4*)g + lane;
#pragma unroll
        for (int j = 0; j < 4; ++j) xr[64 * j] = v[j] * rstd * gr[64 * j];
    }
}


#define XB_TMO      128
#define XB_XCNT(j)  (256  + 64 * (j))
#define XB_XSUB(j)  (1280 + 64 * (j))
#define XB_XGEN(j)  (2304 + 64 * (j))
#define XB_TOP      3328
#define XB_TOPGEN   3392
#define XCD_BAR_WORDS 3456
#define XB_SPIN_CAP (1u << 18)
__device__ __forceinline__ unsigned xb_ld(unsigned* p)              { return __hip_atomic_load(p, __ATOMIC_RELAXED, __HIP_MEMORY_SCOPE_AGENT); }
__device__ __forceinline__ unsigned xb_add(unsigned* p, unsigned v) { return __hip_atomic_fetch_add(p, v, __ATOMIC_RELAXED, __HIP_MEMORY_SCOPE_AGENT); }
__device__ __forceinline__ unsigned xb_xcc_id() { return (unsigned)__builtin_amdgcn_s_getreg((3 << 11) | 20) & 0xFu; }
#define XB_SPIN(cond, bar) do { unsigned _sp = 0; while (cond) { __builtin_amdgcn_s_sleep(1); \
    if ((++_sp & 255u) == 0u) { if (xb_ld(&(bar)[XB_TMO])) break; if (_sp > XB_SPIN_CAP) { atomicAdd(&(bar)[XB_TMO], 1u); break; } } } } while (0)
__device__ __forceinline__ void xcd_barrier_complete(unsigned* bar, unsigned x, unsigned G, unsigned& nloc, unsigned& nx) {
    unsigned sum, cnt, mine, sp = 0u;
    for (;;) {
        sum = 0u; cnt = 0u; mine = 0u;
#pragma unroll
        for (unsigned j = 0; j < 16; ++j) { const unsigned c = xb_ld(&bar[XB_XCNT(j)]); sum += c; cnt += (c > 0u) ? 1u : 0u; mine = (j == x) ? c : mine; }
        if (sum == G) break;
        __builtin_amdgcn_s_sleep(1);
        if ((++sp & 255u) == 0u) { if (xb_ld(&bar[XB_TMO])) break; if (sp > XB_SPIN_CAP) { atomicAdd(&bar[XB_TMO], 1u); break; } }
    }
    nloc = mine > 0u ? mine : 1u; nx = cnt > 0u ? cnt : 1u;
}
__device__ __forceinline__ void xcd_barrier(unsigned* bar, volatile LAS unsigned* st, unsigned G) {
    asm volatile("s_waitcnt vmcnt(0)" ::: "memory");
    __syncthreads();
    if (threadIdx.x == 0) {
        const unsigned x = xb_xcc_id();
        __builtin_amdgcn_s_waitcnt(0);
        unsigned nloc = st[0], nx = st[1];
        if (nloc == 0u) { xcd_barrier_complete(bar, x, G, nloc, nx); st[0] = nloc; st[1] = nx; }
        const unsigned old = xb_add(&bar[XB_XSUB(x)], 1u);
        const unsigned gen = old / nloc;
        if (old + 1u == (gen + 1u) * nloc) {
            __builtin_amdgcn_fence(__ATOMIC_RELEASE, "agent");
            asm volatile("s_waitcnt vmcnt(0)" ::: "memory");
            const unsigned og = xb_add(&bar[XB_TOP], 1u);
            const unsigned tg = og / nx;
            if (og + 1u == (tg + 1u) * nx) xb_add(&bar[XB_TOPGEN], 1u);
            else XB_SPIN(xb_ld(&bar[XB_TOPGEN]) == tg, bar);
            __builtin_amdgcn_fence(__ATOMIC_ACQUIRE, "agent");
            xb_add(&bar[XB_XGEN(x)], 1u);
            asm volatile("s_waitcnt vmcnt(0)" ::: "memory");
        } else {
            XB_SPIN(xb_ld(&bar[XB_XGEN(x)]) == gen, bar);
            __builtin_amdgcn_fence(__ATOMIC_ACQUIRE, "agent");
            asm volatile("s_waitcnt vmcnt(0)" ::: "memory");
        }
    }
    __syncthreads();
}

__global__ void __launch_bounds__(512, 2) mega(Params pk) {
    extern __shared__ __attribute__((aligned(16))) unsigned char shm[];
    LAS unsigned char* lds = (LAS unsigned char*)shm;
    cg::grid_group grid = cg::this_grid();
    volatile LAS unsigned* bst = (volatile LAS unsigned*)(lds + 131072 + 1024);
    if (threadIdx.x < 2) bst[threadIdx.x] = 0u;
    if (blockIdx.x == 0) for (int i = threadIdx.x; i < XCD_BAR_WORDS; i += 512) ((unsigned*)(pk.ws + WS_BAR))[i] = 0u;
    __syncthreads();
    bool posted = false;
    for (int ph = pk.ph_lo; ph < pk.ph_hi; ++ph) {
        Params p = pk; int G = gridDim.x, bid = blockIdx.x;
        asm volatile("" : "+s"(p.ws), "+s"(p.out), "+s"(G), "+s"(bid));
        bf16_t* XN = (bf16_t*)(p.ws + WS_XN); bf16_t* Z = (bf16_t*)(p.ws + WS_Z); bf16_t* Y0 = (bf16_t*)(p.ws + WS_Y); bf16_t* W = (bf16_t*)(p.ws + WS_W); bf16_t* H = (bf16_t*)(p.ws + WS_H);
        if (ph == NPH - 1) { phase_final(p, bid, G); }
        else {
            const int l = ph / PH_PER_LAYER, k = ph % PH_PER_LAYER;
            const float* xp = l == 0 ? p.in[0] : p.out; const float* xs = l == 0 ? p.in[1] : p.out + (size_t)MPR * DM;
            pg8::Order S; pg8::Gemm g;
            for (int rep = ((REPMASK >> k) & 1u) ? 2 : 1; rep > 0; --rep)
            switch (k) {
            case 0: phase_prep(p, l, lds, xp, xs, bid, G); break;
            case 1: { S.init(64, ZC / 256, G, bid, 0); g = {XN, W + W_IN, DM, DM, DM}; EpiZ E{Z, p.out, l}; pg8::gemm_phase(lds, g, S, E);
                      sample_gemm<false>(lds, XN + (size_t)MPR * DM, DM, W + W_IN, DM, DM, ZC / 16, bid, G, E); } break;
            case 2: phase_mix(p, l, lds, bid, G); break;
            case 3: { S.init(64, 8, G, bid, 1); g = {Y0, W + W_RI, DRNN, 256, 256};
                      EpiRI E{Y0, Z + UE, Z + 5 * UE, p.in[13] + (size_t)l * DRNN, p.in[15] + (size_t)l * DRNN, (const float*)(p.ws + WS_SP)}; pg8::gemm_phase(lds, g, S, E);
                      sample_gemm<true>(lds, Y0 + (size_t)MPR * DRNN, DRNN, W + W_RI, 256, 256, 64, bid, G, E); } break;
            case 4: phase_scan(p, l, lds, bid, G); break;
            case 5: { S.init(64, 12, G, bid, 0); g = {XN, W + W_IN + (size_t)ZC * DM, DM, DM, DM}; EpiG E{Z}; pg8::gemm_phase(lds, g, S, E);
                      sample_gemm<false>(lds, XN + (size_t)MPR * DM, DM, W + W_IN + (size_t)ZC * DM, DM, DM, 3072 / 16, bid, G, E); } break;
            case 6: { { S.init(64, 4, G, bid, 0); g = {Y0 + 2 * UE, W + W_PA, DPOOL, DPOOL, DPOOL}; EpiP E{Z, XN, 0, 1}; pg8::gemm_phase(lds, g, S, E);
                        sample_gemm<false>(lds, Y0 + 2 * UE + (size_t)MPR * DPOOL, DPOOL, W + W_PA, DPOOL, DPOOL, 64, bid, G, E); }
                      { S.init(64, 4, G, bid, 0); g = {Y0, W + W_PB, DRNN, DRNN, DRNN}; EpiP E{Z, XN, 1024, 0}; pg8::gemm_phase(lds, g, S, E);
                        sample_gemm<false>(lds, Y0 + (size_t)MPR * DRNN, DRNN, W + W_PB, DRNN, DRNN, 64, bid, G, E); }
                      { S.init(64, 4, G, bid, 0); g = {Y0 + 3 * UE, W + W_PC, DCH, DCH, DCH}; EpiP E{Z, XN, 2048, 0}; pg8::gemm_phase(lds, g, S, E);
                        sample_gemm<false>(lds, Y0 + 3 * UE + (size_t)MPR * DCH, DCH, W + W_PC, DCH, DCH, 64, bid, G, E); } } break;
            case 7: break;
            case 8: { S.init(64, 4, G, bid, 0); g = {XN, W + W_O, DM, DM, DM}; EpiX E{xp, xs, p.out}; pg8::gemm_phase(lds, g, S, E);
                      sample_gemm<false>(lds, XN + (size_t)MPR * DM, DM, W + W_O, DM, DM, 64, bid, G, E); } break;
            case 9: { int tid = threadIdx.x; asm volatile("" : "+v"(tid)); const int wave = tid >> 6, lane = tid & 63; rms_rows(p.out, p.out + (size_t)MPR * DM, p.in[24] + (size_t)l * DM, XN, bid * 8 + wave, G * 8, lane); } break;
            case 10: { S.init(64, 12, G, bid, 0); g = {XN, W + W_G, DM, DM, DM}; EpiGpre E{Z, p.out, l}; pg8::gemm_phase(lds, g, S, E);
                       sample_gemm<false>(lds, XN + (size_t)MPR * DM, DM, W + W_G, DM, DM, 192, bid, G, E); } break;
            case 11: { S.init(64, 12, G, bid, 0); g = {XN, W + W_U, DM, DM, DM};
                       EpiH E{Z, H, p.in[27] + (size_t)l * 3 * DFF, p.in[28] + (size_t)l * DFF, p.in[5] + (size_t)l * NS * 2 * DFF}; pg8::gemm_phase(lds, g, S, E);
                       sample_gemm<false>(lds, XN + (size_t)MPR * DM, DM, W + W_U, DM, DM, 192, bid, G, E); } break;
            default: { S.init(64, 4, G, bid, 0); g = {H, W + W_D, DFF, DFF, DFF}; EpiX E{p.out, p.out + (size_t)MPR * DM, p.out}; pg8::gemm_phase(lds, g, S, E);
                       sample_gemm<false>(lds, H + (size_t)MPR * DFF, DFF, W + W_D, DFF, DFF, 64, bid, G, E); } break;
            }
        }
        if (ph + 1 < pk.ph_hi && (ph % PH_PER_LAYER) != 7) {
            if (!posted) {
                grid.sync(); posted = true;
                if (threadIdx.x == 0) (void)xb_add(&((unsigned*)(pk.ws + WS_BAR))[XB_XCNT(xb_xcc_id())], 1u);
            } else xcd_barrier((unsigned*)(pk.ws + WS_BAR), bst, (unsigned)gridDim.x);
            for (int e = 0; e < EXTRA_SYNCS; ++e) xcd_barrier((unsigned*)(pk.ws + WS_BAR), bst, (unsigned)gridDim.x);
        }
    }
}

extern "C" void kernel_launch(void* const* d_in, const int* in_sizes, int n_in, void* d_out, int out_size, void* d_ws, size_t ws_size, hipStream_t stream) {
    static int grid = 0;
    if (grid == 0) {
        int dev = 0, cus = 0, per_cu = 0;
        hipGetDevice(&dev);
        hipDeviceGetAttribute(&cus, hipDeviceAttributeMultiprocessorCount, dev);
        if (hipFuncSetAttribute((const void*)mega, hipFuncAttributeMaxDynamicSharedMemorySize, LDS_BYTES) != hipSuccess) fprintf(stderr, "kernel_launch: hipFuncSetAttribute failed\n");
        if (hipOccupancyMaxActiveBlocksPerMultiprocessor(&per_cu, (const void*)mega, 512, LDS_BYTES) != hipSuccess || per_cu < 1) { fprintf(stderr, "kernel_launch: occupancy query says %d blocks per CU\n", per_cu); per_cu = 1; }
        (void)hipGetLastError();
        grid = cus;
        if (n_in != 31 || ws_size < WS_END) fprintf(stderr, "kernel_launch: unexpected n_in %d / ws_size %zu (need %zu)\n", n_in, ws_size, (size_t)WS_END);
    }
    Params p{};
    for (int i = 0; i < 31; ++i) p.in[i] = (const float*)d_in[i];
    p.out = (float*)d_out; p.ws = (unsigned char*)d_ws; p.ph_lo = 0; p.ph_hi = NPH;
    void* args[] = {&p};
    hipError_t e = hipLaunchCooperativeKernel((const void*)mega, dim3(grid), dim3(512), args, LDS_BYTES, stream);
    if (e != hipSuccess) fprintf(stderr, "cooperative launch failed: %s (grid %d)\n", hipGetErrorString(e), grid);
}
```

```cpp
#include <hip/hip_runtime.h>
#include <hip/hip_cooperative_groups.h>
#include <cstdio>
#include <cstdint>
namespace cg = cooperative_groups;

#define LAS __attribute__((address_space(3)))
typedef unsigned short bf16_t;
typedef short bf16x8 __attribute__((ext_vector_type(8)));
typedef float f32x4 __attribute__((ext_vector_type(4)));
typedef float f32x2 __attribute__((ext_vector_type(2)));
typedef unsigned u32x4 __attribute__((ext_vector_type(4)));
typedef unsigned u32x2 __attribute__((ext_vector_type(2)));

constexpr int DM = 1024, NB = 8, SEQ = 2048, MPR = NB * SEQ, NS = 128, MROWS = MPR + NS, MPAD = 16640, NTM = MPAD / 256;
constexpr int DPOOL = 512, DRNN = 1024, DCH = 512, DFF = 3072, INCOLS = 6656, ZC = 3584;
constexpr int NLAYER = 2, PH_PER_LAYER = 13, NPH = NLAYER * PH_PER_LAYER + 1;
constexpr size_t O_Y = 0;
constexpr size_t O_POOL_P = (size_t)MROWS * DM;
constexpr size_t O_POOL_S = O_POOL_P + (size_t)2 * NB * 15 * DPOOL;
constexpr size_t O_RC_P = O_POOL_S + (size_t)2 * NS * 15 * DPOOL;
constexpr size_t O_RC_S = O_RC_P + (size_t)2 * NB * 3 * DRNN;
constexpr size_t O_H_P = O_RC_S + (size_t)2 * NS * 3 * DRNN;
constexpr size_t O_H_S = O_H_P + (size_t)2 * NB * DRNN;
constexpr size_t O_FF_P = O_H_S + (size_t)2 * NS * DRNN;
constexpr size_t O_FF_S = O_FF_P + (size_t)2 * NB * 2 * DFF;
constexpr size_t O_CV_S = O_FF_S + (size_t)2 * NS * 2 * DFF;
constexpr size_t UE = (size_t)MPAD * 512, UB = UE * 2;
constexpr size_t WS_BAR = 16384;
constexpr size_t WS_SP = 4096;
constexpr size_t WS_XN = 1u << 20;
constexpr size_t WS_Z = WS_XN + 2 * UB;
constexpr size_t WS_Y = WS_Z + 7 * UB;
constexpr size_t WS_W = WS_Y + 4 * UB;
constexpr size_t WS_H = WS_Z + 6 * UB;
constexpr size_t W_IN = 0;
constexpr size_t W_PA = W_IN + (size_t)INCOLS * DM;
constexpr size_t W_PB = W_PA + (size_t)DM * DPOOL;
constexpr size_t W_PC = W_PB + (size_t)DM * DRNN;
constexpr size_t W_O = W_PC + (size_t)DM * DCH;
constexpr size_t W_G = W_O + (size_t)DM * DM;
constexpr size_t W_U = W_G + (size_t)DFF * DM;
constexpr size_t W_D = W_U + (size_t)DFF * DM;
constexpr size_t W_RI = W_D + (size_t)DM * DFF;
constexpr size_t W_END = W_RI + (size_t)8 * 256 * 256;
constexpr size_t WS_END = WS_W + W_END * 2;
static_assert(WS_END <= (256u << 20), "workspace");
static_assert(WS_H + 6 * UB <= WS_W + (W_G)*2, "h overlay must not reach wg/wu/wd");
constexpr int LDS_BYTES = 131072 + 2048;
#ifndef REPMASK
#define REPMASK 0u
#endif
#ifndef EXTRA_SYNCS
#define EXTRA_SYNCS 0
#endif

struct Params { const float* in[31]; float* out; unsigned char* ws; int ph_lo, ph_hi; };

__device__ __forceinline__ float bf_lo(unsigned w) { return __builtin_bit_cast(float, w << 16); }
__device__ __forceinline__ float bf_hi(unsigned w) { return __builtin_bit_cast(float, w & 0xffff0000u); }
__device__ __forceinline__ float bf2f(bf16_t b) { return __builtin_bit_cast(float, (unsigned)b << 16); }
typedef __bf16 bf16x2_t __attribute__((ext_vector_type(2)));
__device__ __forceinline__ unsigned pk2(float lo, float hi) { f32x2 v = {lo, hi}; bf16x2_t b = __builtin_convertvector(v, bf16x2_t); return __builtin_bit_cast(unsigned, b); }
__device__ __forceinline__ bf16_t f2bf(float f) { return (bf16_t)(pk2(f, 0.f) & 0xffffu); }
struct F8 { f32x4 a, b; };
__device__ __forceinline__ F8 unpack8(u32x4 w) { F8 r; r.a[0] = bf_lo(w.x); r.a[1] = bf_hi(w.x); r.a[2] = bf_lo(w.y); r.a[3] = bf_hi(w.y); r.b[0] = bf_lo(w.z); r.b[1] = bf_hi(w.z); r.b[2] = bf_lo(w.w); r.b[3] = bf_hi(w.w); return r; }
__device__ __forceinline__ u32x4 pack8(f32x4 a, f32x4 b) { u32x4 w; w.x = pk2(a[0], a[1]); w.y = pk2(a[2], a[3]); w.z = pk2(b[0], b[1]); w.w = pk2(b[2], b[3]); return w; }
__device__ __forceinline__ float gelu_t(float x) {
    const float u = 0.7978845608f * (x + 0.044715f * x * x * x);
    const float e = __builtin_amdgcn_exp2f(-2.885390082f * u);
    return x * __builtin_amdgcn_rcpf(1.f + e);
}
__device__ __forceinline__ f32x4 gelu4(f32x4 v) { f32x4 r; r[0] = gelu_t(v[0]); r[1] = gelu_t(v[1]); r[2] = gelu_t(v[2]); r[3] = gelu_t(v[3]); return r; }
__device__ __forceinline__ float sigm(float x) { return __builtin_amdgcn_rcpf(1.f + __builtin_amdgcn_exp2f(-1.442695041f * x)); }
__device__ __forceinline__ f32x4 sigm4(f32x4 v) { f32x4 r; r[0] = sigm(v[0]); r[1] = sigm(v[1]); r[2] = sigm(v[2]); r[3] = sigm(v[3]); return r; }
__device__ __forceinline__ float wave_sum(float v) {
#pragma unroll
    for (int o = 1; o < 64; o <<= 1) v += __shfl_xor(v, o);
    return v;
}

namespace pg8 {
constexpr int BM = 256, BK = 64, HALF = 128, HTB = HALF * BK * 2, STAGE_BYTES = 8 * HTB, NXCD = 8, WGM = 8;
__device__ __forceinline__ int lds_byte(int r, int c) { const int st = (r >> 4) * 2 + (c >> 5), rr = r & 15, cc = c & 31, ob = rr * 64 + cc * 2; return st * 1024 + (ob ^ (((ob >> 9) & 1) << 5)); }
__device__ __forceinline__ void stage_rc(int b, int& R, int& C) { const int st = b / 1024, sb = b % 1024, swz = sb ^ (((sb >> 9) & 1) << 5); R = (st >> 1) * 16 + swz / 64; C = (st & 1) * 32 + (swz % 64) / 2; }
__device__ __forceinline__ int perm32(int rho) { const int n = rho >> 4, i = rho & 15; return 8 * (i >> 2) + 4 * n + (i & 3); }

struct Unit { int pm, pn, ka; };
struct Gemm { const bf16_t* A; const bf16_t* Bt; int lda, ldb, K; };

struct Order {
    int nM, nN, nwg, G, c, mode;
    __device__ __forceinline__ void init(int nM_, int nN_, int G_, int c_, int mode_) { nM = nM_; nN = nN_; nwg = nM * nN; G = G_; c = c_; mode = mode_; }
    __device__ __forceinline__ bool next(int i, Unit& u) const {
        const long L = (long)i * G + c; if (L >= nwg) return false;
        int wgid = (int)L; { const int q = nwg / NXCD, r = nwg % NXCD, xcd = wgid % NXCD, off = wgid / NXCD; wgid = (xcd < r ? xcd * (q + 1) : r * (q + 1) + (xcd - r) * q) + off; }
        const int nig = WGM * nN, gid = wgid / nig, fm = gid * WGM, gsz = (nM - fm) < WGM ? (nM - fm) : WGM;
        u.pm = fm + ((wgid % nig) % gsz); u.pn = (wgid % nig) / gsz; u.ka = mode ? ((u.pn & ~1) * 128) : 0; return true;
    }
};

template <class Epi>
__device__ __forceinline__ void gemm_phase(LAS unsigned char* lds, const Gemm g, const Order& S, const Epi& E) {
    int tid = threadIdx.x; asm volatile("" : "+v"(tid));
    const int wid = __builtin_amdgcn_readfirstlane(tid >> 6), lane = tid & 63, wr = wid >> 2, wc = wid & 3, fr = lane & 15, fq = lane >> 4;
    const int K = g.K, nt = K / BK;
    unsigned voffA[2], voffB[2];
#pragma unroll
    for (int i = 0; i < 2; ++i) { int R, C; stage_rc(tid * 16 + i * 8192, R, C); const int Rb = Epi::PERM ? ((R & ~31) + perm32(R & 31)) : R;
        voffA[i] = (unsigned)(R * g.lda + C) * 2u; voffB[i] = (unsigned)(Rb * g.ldb + C) * 2u; }
    const size_t kstep = (size_t)(BK * 2);
    const size_t hstepA = (size_t)HALF * g.lda * 2, tstepA = 2 * hstepA;
    const size_t hstepB = (size_t)HALF * g.ldb * 2, tstepB = 2 * hstepB;
    const unsigned ldsw = (unsigned)wid * 1024u;
    const int aoff = lds_byte(wr * 64 + fr, fq * 8), boff = lds_byte(wc * 32 + fr, fq * 8);
#define PG8_SA(b, h) (((b) * 2 + (h)) * HTB)
#define PG8_SB(b, h) ((4 + (b) * 2 + (h)) * HTB)
#define PG8_STAGE(bufoff, gbase, voff) do { _Pragma("unroll") for (int _i = 0; _i < 2; ++_i) \
        __builtin_amdgcn_global_load_lds((const unsigned*)((const char*)(gbase) + (voff)[_i]), (LAS unsigned*)(lds + (bufoff) + ldsw + _i * 8192), 16, 0, 0); } while (0)
#define PG8_LDA(dst, b, h) do { _Pragma("unroll") for (int m = 0; m < 4; ++m) _Pragma("unroll") for (int k = 0; k < 2; ++k) dst[m][k] = *(const LAS bf16x8*)(lds + PG8_SA(b, h) + aoff + m * 2048 + k * 1024); } while (0)
#define PG8_LDB(dst, b, h) do { _Pragma("unroll") for (int n = 0; n < 2; ++n) _Pragma("unroll") for (int k = 0; k < 2; ++k) dst[n][k] = *(const LAS bf16x8*)(lds + PG8_SB(b, h) + boff + n * 2048 + k * 1024); } while (0)
#define PG8_MMA(ai, bj, At, Bt) do { __builtin_amdgcn_s_setprio(1); _Pragma("unroll") for (int m = 0; m < 4; ++m) _Pragma("unroll") for (int n = 0; n < 2; ++n) _Pragma("unroll") for (int k = 0; k < 2; ++k) \
        acc[ai][bj][m][n] = __builtin_amdgcn_mfma_f32_16x16x32_bf16(Bt[n][k], At[m][k], acc[ai][bj][m][n], 0, 0, 0); __builtin_amdgcn_s_setprio(0); } while (0)
#define PG8_WAIT_V(n) asm volatile("s_waitcnt vmcnt(" #n ")" ::: "memory")
#define PG8_WAIT_L(n) asm volatile("s_waitcnt lgkmcnt(" #n ")" ::: "memory")
#define PG8_BAR __builtin_amdgcn_s_barrier()
#define PG8_SCHED __builtin_amdgcn_sched_barrier(0)
    Unit cur, nxt; int ui = 0;
    if (!S.next(0, cur)) return;
    f32x4 acc[2][2][4][2];
#pragma unroll
    for (int a = 0; a < 2; ++a)
#pragma unroll
        for (int b = 0; b < 2; ++b)
#pragma unroll
            for (int m = 0; m < 4; ++m)
#pragma unroll
                for (int n = 0; n < 2; ++n) acc[a][b][m][n] = (f32x4){0.f, 0.f, 0.f, 0.f};
    bf16x8 At[4][2], B0[2][2], B1[2][2];
    const char* cA = (const char*)g.A + (size_t)cur.pm * tstepA + (size_t)cur.ka * 2; const char* cB = (const char*)g.Bt + (size_t)cur.pn * tstepB;
    PG8_STAGE(PG8_SB(0, 0), cB, voffB); PG8_STAGE(PG8_SB(0, 1), cB + hstepB, voffB); PG8_STAGE(PG8_SA(0, 0), cA, voffA); PG8_STAGE(PG8_SA(0, 1), cA + hstepA, voffA);
    if (wr == 1) PG8_BAR;
    PG8_WAIT_V(2); PG8_BAR;
    PG8_STAGE(PG8_SB(1, 0), cB + kstep, voffB); PG8_STAGE(PG8_SA(1, 0), cA + kstep, voffA); PG8_STAGE(PG8_SB(1, 1), cB + hstepB + kstep, voffB);
    PG8_WAIT_V(6); PG8_BAR;
    for (;;) {
        const bool has_next = S.next(ui + 1, nxt);
        const char* nA = has_next ? (const char*)g.A + (size_t)nxt.pm * tstepA + (size_t)nxt.ka * 2 : cA; const char* nB = has_next ? (const char*)g.Bt + (size_t)nxt.pn * tstepB : cB;
#pragma unroll 1
        for (int t = 0; t < nt; t += 2) {
            const bool last = (t == nt - 2);
            const char* a1 = cA + (size_t)(t + 1) * kstep;
            const char* a2 = last ? nA : cA + (size_t)(t + 2) * kstep; const char* b2 = last ? nB : cB + (size_t)(t + 2) * kstep;
            const char* a3 = a2 + kstep; const char* b3 = b2 + kstep;
            PG8_LDB(B0, 0, 0); PG8_LDB(B1, 0, 1); PG8_SCHED; PG8_LDA(At, 0, 0); PG8_STAGE(PG8_SA(1, 1), a1 + hstepA, voffA);
            PG8_WAIT_V(8); PG8_WAIT_L(0); PG8_BAR; PG8_MMA(0, 0, At, B0); PG8_MMA(0, 1, At, B1); PG8_BAR; PG8_SCHED;
            PG8_LDA(At, 0, 1); PG8_STAGE(PG8_SB(0, 0), b2, voffB); PG8_STAGE(PG8_SB(0, 1), b2 + hstepB, voffB); PG8_STAGE(PG8_SA(0, 0), a2, voffA);
            PG8_WAIT_V(8); PG8_WAIT_L(0); PG8_BAR; PG8_MMA(1, 0, At, B0); PG8_MMA(1, 1, At, B1); PG8_BAR; PG8_SCHED;
            PG8_LDB(B0, 1, 0); PG8_LDB(B1, 1, 1); PG8_SCHED; PG8_LDA(At, 1, 0); PG8_STAGE(PG8_SA(0, 1), a2 + hstepA, voffA);
            PG8_WAIT_V(8); PG8_WAIT_L(0); PG8_BAR; PG8_MMA(0, 0, At, B0); PG8_MMA(0, 1, At, B1); PG8_BAR; PG8_SCHED;
            PG8_LDA(At, 1, 1); PG8_STAGE(PG8_SB(1, 0), b3, voffB); PG8_STAGE(PG8_SB(1, 1), b3 + hstepB, voffB); PG8_STAGE(PG8_SA(1, 0), a3, voffA);
            PG8_WAIT_V(8); PG8_WAIT_L(0); PG8_BAR; PG8_MMA(1, 0, At, B0); PG8_MMA(1, 1, At, B1); PG8_BAR; PG8_SCHED;
        }
        if (wr == 0) PG8_BAR;
        { int fr2 = fr, fq2 = fq; asm volatile("" : "+v"(fr2), "+v"(fq2));
          E(acc, cur, wr, wc, fr2, fq2); }
        if (!has_next) break;
#pragma unroll
        for (int a = 0; a < 2; ++a)
#pragma unroll
            for (int b = 0; b < 2; ++b)
#pragma unroll
                for (int m = 0; m < 4; ++m)
#pragma unroll
                    for (int n = 0; n < 2; ++n) acc[a][b][m][n] = (f32x4){0.f, 0.f, 0.f, 0.f};
        cur = nxt; cA = nA; cB = nB; ++ui;
        if (wr == 1) PG8_BAR;
    }
    PG8_WAIT_V(0);
    PG8_BAR;
#undef PG8_SA
#undef PG8_SB
#undef PG8_STAGE
#undef PG8_LDA
#undef PG8_LDB
#undef PG8_MMA
#undef PG8_WAIT_V
#undef PG8_WAIT_L
#undef PG8_BAR
#undef PG8_SCHED
}
}
using pg8::Unit;

#define EPI_ARGS const f32x4 (&acc)[2][2][4][2], const Unit& u, int wr, int wc, int fr, int fq
struct EpiZ {
    static constexpr bool PERM = true;
    bf16_t* Z; float* out; int l;
    __device__ __forceinline__ void operator()(EPI_ARGS) const {
        const int pn = u.pn; bf16_t* base; int ld, ct; bool act;
        if (pn < 2) { base = Z; ld = 512; ct = pn * 256; act = false; }
        else if (pn < 6) { base = Z + UE; ld = 1024; ct = (pn - 2) * 256; act = false; }
        else if (pn < 10) { base = Z + 3 * UE; ld = 1024; ct = (pn - 6) * 256; act = true; }
        else if (pn < 12) { base = Z + 5 * UE; ld = 512; ct = (pn - 10) * 256; act = true; }
        else { base = Z + 6 * UE; ld = 512; ct = (pn - 12) * 256; act = true; }
        const bool st = (pn < 6) && (((u.pm & 7) == 7) || u.pm == 64);
#pragma unroll
        for (int ai = 0; ai < 2; ++ai)
#pragma unroll
            for (int m = 0; m < 4; ++m) {
                const int row = u.pm * 256 + ai * 128 + wr * 64 + m * 16 + fr;
#pragma unroll
                for (int bj = 0; bj < 2; ++bj) {
                    f32x4 v0 = acc[ai][bj][m][0], v1 = acc[ai][bj][m][1];
                    const int c = ct + bj * 128 + wc * 32 + 8 * fq;
                    if (st) {
                        float* o = nullptr;
                        if (row < MPR) { const int t = row & 2047, b = row >> 11;
                            if (pn < 2) { if (t >= 2033) o = out + O_POOL_P + ((size_t)(l * NB + b) * 15 + (t - 2033)) * DPOOL + c; }
                            else { if (t >= 2045) o = out + O_RC_P + ((size_t)(l * NB + b) * 3 + (t - 2045)) * DRNN + c; } }
                        else if (row < MROWS) { const int s = row - MPR;
                            if (pn < 2) o = out + O_POOL_S + ((size_t)(l * NS + s) * 15 + 14) * DPOOL + c;
                            else o = out + O_RC_S + ((size_t)(l * NS + s) * 3 + 2) * DRNN + c; }
                        if (o) { *(f32x4*)o = v0; *(f32x4*)(o + 4) = v1; }
                    }
                    if (act) { v0 = gelu4(v0); v1 = gelu4(v1); }
                    *(u32x4*)(base + (size_t)row * ld + c) = pack8(v0, v1);
                    asm volatile("" ::: "memory");
                }
            }
    }
    __device__ __forceinline__ void sample(int row, int col, f32x4 v) const {
        const int s = row - MPR; bf16_t* dst;
        if (col < 512) { dst = Z + (size_t)row * 512 + col; *(f32x4*)(out + O_POOL_S + ((size_t)(l * NS + s) * 15 + 14) * DPOOL + col) = v; }
        else if (col < 1536) { dst = Z + UE + (size_t)row * 1024 + (col - 512); *(f32x4*)(out + O_RC_S + ((size_t)(l * NS + s) * 3 + 2) * DRNN + (col - 512)) = v; }
        else if (col < 2560) { dst = Z + 3 * UE + (size_t)row * 1024 + (col - 1536); v = gelu4(v); }
        else if (col < 3072) { dst = Z + 5 * UE + (size_t)row * 512 + (col - 2560); v = gelu4(v); }
        else { dst = Z + 6 * UE + (size_t)row * 512 + (col - 3072); v = gelu4(v); }
        u32x2 w; w.x = pk2(v[0], v[1]); w.y = pk2(v[2], v[3]); *(u32x2*)dst = w;
    }
};
struct EpiRI {
    static constexpr bool PERM = true;
    const bf16_t* BC; bf16_t* LA; bf16_t* BV; const float* ba; const float* bx; const float* sp;
    __device__ __forceinline__ void operator()(EPI_ARGS) const {
        const int ch = u.pn * 128 + wc * 32 + 8 * fq;
        f32x4 bav[2], bxv[2], spv[2];
#pragma unroll
        for (int n = 0; n < 2; ++n) { bav[n] = *(const f32x4*)(ba + ch + 4 * n); bxv[n] = *(const f32x4*)(bx + ch + 4 * n); spv[n] = *(const f32x4*)(sp + ch + 4 * n); }
#pragma unroll
        for (int ai = 0; ai < 2; ++ai) {
            u32x4 xw[4];
#pragma unroll
            for (int m = 0; m < 4; ++m) xw[m] = *(const u32x4*)(BC + (size_t)(u.pm * 256 + ai * 128 + wr * 64 + m * 16 + fr) * DRNN + ch);
#pragma unroll
            for (int m = 0; m < 4; ++m) {
                const int row = u.pm * 256 + ai * 128 + wr * 64 + m * 16 + fr;
                const F8 xc8 = unpack8(xw[m]); f32x4 lav[2], bv[2];
#pragma unroll
                for (int n = 0; n < 2; ++n) {
                    const f32x4 xc = n ? xc8.b : xc8.a;
                    const f32x4 r0 = sigm4(acc[ai][0][m][n] + bav[n]), i0 = sigm4(acc[ai][1][m][n] + bxv[n]);
                    lav[n] = r0 * spv[n];
#pragma unroll
                    for (int j = 0; j < 4; ++j) { const float x = -2.f * lav[n][j];
                        const float em = x < 0.03f ? x * (1.f - x * (0.5f - x * (0.16666667f - x * 0.041666668f))) : 1.f - __expf(-x);
                        bv[n][j] = __builtin_sqrtf(em) * i0[j] * xc[j]; }
                }
                *(u32x4*)(LA + (size_t)row * DRNN + ch) = pack8(lav[0], lav[1]);
                *(u32x4*)(BV + (size_t)row * DRNN + ch) = pack8(bv[0], bv[1]);
            }
            asm volatile("" ::: "memory");
        }
    }
    __device__ __forceinline__ void sample2(int row, int ch, f32x4 vr, f32x4 vi) const {
        const f32x4 ba0 = *(const f32x4*)(ba + ch), bx0 = *(const f32x4*)(bx + ch), sp0 = *(const f32x4*)(sp + ch);
        const u32x2 xw = *(const u32x2*)(BC + (size_t)row * DRNN + ch);
        const f32x4 xc = (f32x4){bf_lo(xw.x), bf_hi(xw.x), bf_lo(xw.y), bf_hi(xw.y)};
        const f32x4 r0 = sigm4(vr + ba0), i0 = sigm4(vi + bx0), la0 = r0 * sp0; f32x4 b0;
#pragma unroll
        for (int j = 0; j < 4; ++j) { const float x = -2.f * la0[j];
            const float em = x < 0.03f ? x * (1.f - x * (0.5f - x * (0.16666667f - x * 0.041666668f))) : 1.f - __expf(-x);
            b0[j] = __builtin_sqrtf(em) * i0[j] * xc[j]; }
        u32x2 wl, wb; wl.x = pk2(la0[0], la0[1]); wl.y = pk2(la0[2], la0[3]); wb.x = pk2(b0[0], b0[1]); wb.y = pk2(b0[2], b0[3]);
        *(u32x2*)(LA + (size_t)row * DRNN + ch) = wl; *(u32x2*)(BV + (size_t)row * DRNN + ch) = wb;
    }
};
struct EpiG {
    static constexpr bool PERM = true;
    bf16_t* G;
    __device__ __forceinline__ void operator()(EPI_ARGS) const {
#pragma unroll
        for (int ai = 0; ai < 2; ++ai)
#pragma unroll
            for (int m = 0; m < 4; ++m) {
                const int row = u.pm * 256 + ai * 128 + wr * 64 + m * 16 + fr;
#pragma unroll
                for (int bj = 0; bj < 2; ++bj) {
                    const int c = u.pn * 256 + bj * 128 + wc * 32 + 8 * fq;
                    *(u32x4*)(G + (size_t)row * 3072 + c) = pack8(sigm4(acc[ai][bj][m][0]), sigm4(acc[ai][bj][m][1]));
                    asm volatile("" ::: "memory");
                }
            }
    }
    __device__ __forceinline__ void sample(int row, int col, f32x4 v) const {
        v = sigm4(v); u32x2 w; w.x = pk2(v[0], v[1]); w.y = pk2(v[2], v[3]); *(u32x2*)(G + (size_t)row * 3072 + col) = w;
    }
};
struct EpiP {
    static constexpr bool PERM = true;
    const bf16_t* G; bf16_t* M; int goff; int first;
    __device__ __forceinline__ void operator()(EPI_ARGS) const {
#pragma unroll
        for (int ai = 0; ai < 2; ++ai)
#pragma unroll
            for (int bj = 0; bj < 2; ++bj) {
                const int c = u.pn * 256 + bj * 128 + wc * 32 + 8 * fq;
                u32x4 gw[4], ow[4];
#pragma unroll
                for (int m = 0; m < 4; ++m) { const int row = u.pm * 256 + ai * 128 + wr * 64 + m * 16 + fr;
                    gw[m] = *(const u32x4*)(G + (size_t)row * 3072 + goff + c);
                    if (!first) ow[m] = *(const u32x4*)(M + (size_t)row * DM + c); }
#pragma unroll
                for (int m = 0; m < 4; ++m) { const int row = u.pm * 256 + ai * 128 + wr * 64 + m * 16 + fr;
                    const F8 gt = unpack8(gw[m]);
                    f32x4 o0 = gt.a * acc[ai][bj][m][0], o1 = gt.b * acc[ai][bj][m][1];
                    if (!first) { const F8 old = unpack8(ow[m]); o0 += old.a; o1 += old.b; }
                    *(u32x4*)(M + (size_t)row * DM + c) = pack8(o0, o1); }
                asm volatile("" ::: "memory");
            }
    }
    __device__ __forceinline__ void sample(int row, int col, f32x4 v) const {
        const u32x2 g = *(const u32x2*)(G + (size_t)row * 3072 + goff + col); u32x2* mp = (u32x2*)(M + (size_t)row * DM + col);
        f32x4 o = (f32x4){bf_lo(g.x) * v[0], bf_hi(g.x) * v[1], bf_lo(g.y) * v[2], bf_hi(g.y) * v[3]};
        if (!first) { const u32x2 old = *mp; o += (f32x4){bf_lo(old.x), bf_hi(old.x), bf_lo(old.y), bf_hi(old.y)}; }
        u32x2 w; w.x = pk2(o[0], o[1]); w.y = pk2(o[2], o[3]); *mp = w;
    }
};
struct EpiX {
    static constexpr bool PERM = false;
    const float* xin_p; const float* xin_s; float* xout;
    __device__ __forceinline__ void operator()(EPI_ARGS) const {
#pragma unroll
        for (int ai = 0; ai < 2; ++ai)
#pragma unroll
            for (int mp = 0; mp < 2; ++mp) {
                f32x4 xv[2][2][2];
#pragma unroll
                for (int mm = 0; mm < 2; ++mm) { const int row = u.pm * 256 + ai * 128 + wr * 64 + (2 * mp + mm) * 16 + fr; const float* src = xin_p + (size_t)row * DM;
#pragma unroll
                    for (int bj = 0; bj < 2; ++bj)
#pragma unroll
                        for (int n = 0; n < 2; ++n) xv[mm][bj][n] = *(const f32x4*)(src + u.pn * 256 + bj * 128 + wc * 32 + 16 * n + 4 * fq); }
#pragma unroll
                for (int mm = 0; mm < 2; ++mm) { const int row = u.pm * 256 + ai * 128 + wr * 64 + (2 * mp + mm) * 16 + fr; float* dst = xout + (size_t)row * DM;
#pragma unroll
                    for (int bj = 0; bj < 2; ++bj)
#pragma unroll
                        for (int n = 0; n < 2; ++n) *(f32x4*)(dst + u.pn * 256 + bj * 128 + wc * 32 + 16 * n + 4 * fq) = xv[mm][bj][n] + acc[ai][bj][2 * mp + mm][n]; }
                asm volatile("" ::: "memory");
            }
    }
    __device__ __forceinline__ void sample(int row, int col, f32x4 v) const {
        *(f32x4*)(xout + (size_t)row * DM + col) = *(const f32x4*)(xin_s + (size_t)(row - MPR) * DM + col) + v;
    }
};
struct EpiGpre {
    static constexpr bool PERM = true;
    bf16_t* GP; float* out; int l;
    __device__ __forceinline__ void operator()(EPI_ARGS) const {
        const bool st = ((u.pm & 7) == 7) || u.pm == 64;
#pragma unroll
        for (int ai = 0; ai < 2; ++ai)
#pragma unroll
            for (int m = 0; m < 4; ++m) {
                const int row = u.pm * 256 + ai * 128 + wr * 64 + m * 16 + fr;
#pragma unroll
                for (int bj = 0; bj < 2; ++bj) {
                    const f32x4 v0 = acc[ai][bj][m][0], v1 = acc[ai][bj][m][1];
                    const int c = u.pn * 256 + bj * 128 + wc * 32 + 8 * fq;
                    if (st) {
                        float* o = nullptr;
                        if (row < MPR) { const int t = row & 2047, b = row >> 11; if (t >= 2046) o = out + O_FF_P + ((size_t)(l * NB + b) * 2 + (t - 2046)) * DFF + c; }
                        else if (row < MROWS) { const int s = row - MPR; o = out + O_FF_S + ((size_t)(l * NS + s) * 2 + 1) * DFF + c; }
                        if (o) { *(f32x4*)o = v0; *(f32x4*)(o + 4) = v1; }
                    }
                    *(u32x4*)(GP + (size_t)row * 3072 + c) = pack8(v0, v1);
                    asm volatile("" ::: "memory");
                }
            }
    }
    __device__ __forceinline__ void sample(int row, int col, f32x4 v) const {
        *(f32x4*)(out + O_FF_S + ((size_t)(l * NS + (row - MPR)) * 2 + 1) * DFF + col) = v;
        u32x2 w; w.x = pk2(v[0], v[1]); w.y = pk2(v[2], v[3]); *(u32x2*)(GP + (size_t)row * 3072 + col) = w;
    }
};
struct EpiH {
    static constexpr bool PERM = true;
    const bf16_t* GP; bf16_t* H; const float* cw; const float* cb; const float* st;
    __device__ __forceinline__ void operator()(EPI_ARGS) const {
#pragma unroll
        for (int bj = 0; bj < 2; ++bj) {
            const int c = u.pn * 256 + bj * 128 + wc * 32 + 8 * fq;
            const f32x4 w00 = *(const f32x4*)(cw + c), w01 = *(const f32x4*)(cw + c + 4);
            const f32x4 w10 = *(const f32x4*)(cw + DFF + c), w11 = *(const f32x4*)(cw + DFF + c + 4);
            const f32x4 w20 = *(const f32x4*)(cw + 2 * DFF + c), w21 = *(const f32x4*)(cw + 2 * DFF + c + 4);
            const f32x4 cb0 = *(const f32x4*)(cb + c), cb1 = *(const f32x4*)(cb + c + 4);
#pragma unroll
            for (int am = 0; am < 4; ++am) {
                u32x4 q0[2], q1[2], q2[2];
#pragma unroll
                for (int mm = 0; mm < 2; ++mm) { const int row = u.pm * 256 + (am >> 1) * 128 + wr * 64 + ((am & 1) * 2 + mm) * 16 + fr, t = row & 2047;
                    q0[mm] = *(const u32x4*)(GP + (size_t)row * 3072 + c);
                    q1[mm] = *(const u32x4*)(GP + (size_t)(t >= 1 ? row - 1 : row) * 3072 + c);
                    q2[mm] = *(const u32x4*)(GP + (size_t)(t >= 2 ? row - 2 : row) * 3072 + c); }
#pragma unroll
                for (int mm = 0; mm < 2; ++mm) { const int ai = am >> 1, m = (am & 1) * 2 + mm; const int row = u.pm * 256 + ai * 128 + wr * 64 + m * 16 + fr, t = row & 2047;
                    const F8 g0 = unpack8(q0[mm]), g1 = unpack8(q1[mm]), g2 = unpack8(q2[mm]);
                    const float k1 = t >= 1 ? 1.f : 0.f, k2 = t >= 2 ? 1.f : 0.f;
                    const f32x4 s0 = cb0 + w20 * g0.a + (w10 * g1.a) * k1 + (w00 * g2.a) * k2, s1 = cb1 + w21 * g0.b + (w11 * g1.b) * k1 + (w01 * g2.b) * k2;
                    *(u32x4*)(H + (size_t)row * 3072 + c) = pack8(gelu4(s0) * acc[ai][bj][m][0], gelu4(s1) * acc[ai][bj][m][1]); }
                asm volatile("" ::: "memory");
            }
        }
    }
    __device__ __forceinline__ void sample(int row, int col, f32x4 v) const {
        const u32x2 gw = *(const u32x2*)(GP + (size_t)row * 3072 + col); const f32x4 g0 = (f32x4){bf_lo(gw.x), bf_hi(gw.x), bf_lo(gw.y), bf_hi(gw.y)};
        const float* sp = st + (size_t)(row - MPR) * 2 * DFF + col;
        const f32x4 s0 = *(const f32x4*)(cb + col) + *(const f32x4*)(cw + 2 * DFF + col) * g0 + *(const f32x4*)(cw + col) * *(const f32x4*)sp + *(const f32x4*)(cw + DFF + col) * *(const f32x4*)(sp + DFF);
        const f32x4 h = gelu4(s0) * v; u32x2 w; w.x = pk2(h[0], h[1]); w.y = pk2(h[2], h[3]); *(u32x2*)(H + (size_t)row * 3072 + col) = w;
    }
};

template <bool DUAL, class Epi>
__device__ __forceinline__ void sample_gemm(LAS unsigned char* lds, const bf16_t* A, int lda, const bf16_t* Bt, int ldb, int K, int nstrips, int bid, int G, const Epi& E) {
    int tid = threadIdx.x; asm volatile("" : "+v"(tid));
    const int kw = __builtin_amdgcn_readfirstlane(tid >> 6), lane = tid & 63, fr = lane & 15, fq = lane >> 4;
    const int kslice = K >> 3, nks = kslice >> 5;
    LAS f32x4* part = (LAS f32x4*)lds;
    for (int strip = G - 1 - bid; strip < nstrips; strip += G) {
        int n0 = strip * 16, acol = 0, h = 0, cc = 0;
        if (DUAL) { h = strip >> 3; cc = (strip & 7) * 16; n0 = h * 256 + cc; acol = (h & ~1) * 128; }
        f32x4 acc[8], acc2[8];
#pragma unroll
        for (int m = 0; m < 8; ++m) { acc[m] = (f32x4){0.f, 0.f, 0.f, 0.f}; acc2[m] = acc[m]; }
        typedef const __attribute__((address_space(1))) bf16x8* gfrag;
        const bf16_t* bp = Bt + (size_t)(n0 + fr) * ldb + kw * kslice + 8 * fq;
        const bf16_t* ap = A + (size_t)fr * lda + acol + kw * kslice + 8 * fq;
#pragma unroll 1
        for (int ks0 = 0; ks0 < nks; ks0 += 2) {
            bf16x8 bb[2], bb2[2], aa[2][8];
#pragma unroll
            for (int u = 0; u < 2; ++u) if (ks0 + u < nks) {
                bb[u] = *(gfrag)(bp + (ks0 + u) * 32);
                if (DUAL) bb2[u] = *(gfrag)(bp + (size_t)128 * ldb + (ks0 + u) * 32);
#pragma unroll
                for (int m = 0; m < 8; ++m) aa[u][m] = *(gfrag)(ap + (size_t)(16 * m) * lda + (ks0 + u) * 32);
            }
            __builtin_amdgcn_sched_barrier(0);
#pragma unroll
            for (int u = 0; u < 2; ++u) if (ks0 + u < nks) {
#pragma unroll
                for (int m = 0; m < 8; ++m) { acc[m] = __builtin_amdgcn_mfma_f32_16x16x32_bf16(bb[u], aa[u][m], acc[m], 0, 0, 0);
                    if (DUAL) acc2[m] = __builtin_amdgcn_mfma_f32_16x16x32_bf16(bb2[u], aa[u][m], acc2[m], 0, 0, 0); }
            }
            __builtin_amdgcn_sched_barrier(0);
        }
#pragma unroll
        for (int m = 0; m < 8; ++m) part[(kw * 8 + m) * 64 + lane] = acc[m];
        __syncthreads();
        f32x4 v = part[kw * 64 + lane];
#pragma unroll
        for (int k2 = 1; k2 < 8; ++k2) v += part[(k2 * 8 + kw) * 64 + lane];
        const int row = MPR + 16 * kw + fr;
        if constexpr (DUAL) {
            __syncthreads();
#pragma unroll
            for (int m = 0; m < 8; ++m) part[(kw * 8 + m) * 64 + lane] = acc2[m];
            __syncthreads();
            f32x4 v2 = part[kw * 64 + lane];
#pragma unroll
            for (int k2 = 1; k2 < 8; ++k2) v2 += part[(k2 * 8 + kw) * 64 + lane];
            E.sample2(row, h * 128 + cc + 4 * fq, v, v2);
        } else E.sample(row, n0 + 4 * fq, v);
        __syncthreads();
    }
}


__device__ __forceinline__ void transpose_item(const float* W, int K, int N, bf16_t* WT, LAS float* scr, int item, int lane) {
    const int nblk = N / 32, kb = item / nblk, nb = item % nblk, k0 = 64 * kb, n0 = 32 * nb;
    float tv[32];
#pragma unroll
    for (int i = 0; i < 32; ++i) tv[i] = W[(size_t)(k0 + 2 * i + (lane >> 5)) * N + n0 + (lane & 31)];
#pragma unroll
    for (int i = 0; i < 32; ++i) scr[(2 * i + (lane >> 5)) * 33 + (lane & 31)] = tv[i];
    asm volatile("s_waitcnt lgkmcnt(0)" ::: "memory");
    const int c = lane & 7;
#pragma unroll
    for (int j = 0; j < 4; ++j) { const int n = (lane >> 3) + 8 * j; const LAS float* s = scr + (8 * c) * 33 + n;
        u32x4 o; o.x = pk2(s[0 * 33], s[1 * 33]); o.y = pk2(s[2 * 33], s[3 * 33]); o.z = pk2(s[4 * 33], s[5 * 33]); o.w = pk2(s[6 * 33], s[7 * 33]);
        *(u32x4*)(WT + (size_t)(n0 + n) * K + k0 + 8 * c) = o; }
    asm volatile("s_waitcnt lgkmcnt(0)" ::: "memory");
}
__device__ __forceinline__ void rms_row_bf16(const float* xrow, const float* g, bf16_t* orow, int lane) {
    const f32x4* xr = (const f32x4*)xrow + lane; f32x4 v[4]; float s = 0.f;
#pragma unroll
    for (int j = 0; j < 4; ++j) { v[j] = xr[64 * j]; s += (v[j][0] * v[j][0] + v[j][1] * v[j][1]) + (v[j][2] * v[j][2] + v[j][3] * v[j][3]); }
    const float rstd = rsqrtf(wave_sum(s) * (1.f / DM) + 1e-6f);
    const f32x4* gr = (const f32x4*)g + lane; u32x2* o8 = (u32x2*)orow + lane;
#pragma unroll
    for (int j = 0; j < 4; ++j) { const f32x4 o = v[j] * rstd * gr[64 * j]; u32x2 w; w.x = pk2(o[0], o[1]); w.y = pk2(o[2], o[3]); o8[64 * j] = w; }
}
__device__ __forceinline__ void rms_rows(const float* xp, const float* xs, const float* g, bf16_t* XN, int gw, int ngw, int lane) {
    for (int row = gw; row < MPAD; row += ngw) {
        if (row < MROWS) rms_row_bf16(row < MPR ? xp + (size_t)row * DM : xs + (size_t)(row - MPR) * DM, g, XN + (size_t)row * DM, lane);
        else { u32x2* o8 = (u32x2*)(XN + (size_t)row * DM) + lane; u32x2 z; z.x = 0u; z.y = 0u;
#pragma unroll
            for (int j = 0; j < 4; ++j) o8[64 * j] = z; }
    }
}

__device__ __forceinline__ void phase_prep(const Params& p, int l, LAS unsigned char* lds, const float* xp, const float* xs, int bid, int G) {
    int tid = threadIdx.x; asm volatile("" : "+v"(tid));
    const int wave = tid >> 6, lane = tid & 63;
    const int gw = bid * 8 + wave, ngw = G * 8;
    bf16_t* W = (bf16_t*)(p.ws + WS_W);
    LAS float* scr = (LAS float*)(lds + wave * 8448);
    const float* w_in = p.in[7] + (size_t)l * DM * INCOLS; const float* w_pb = p.in[21] + (size_t)l * DRNN * DM; const float* w_pc = p.in[22] + (size_t)l * DCH * DM;
    const float* w_o = p.in[23] + (size_t)l * DM * DM; const float* wg = p.in[25] + (size_t)l * DM * DFF; const float* wu = p.in[26] + (size_t)l * DM * DFF; const float* wd = p.in[29] + (size_t)l * DFF * DM;
    constexpr int I_IN = (DM / 64) * (INCOLS / 32), I_PB = (DRNN / 64) * (DM / 32), I_PC = (DCH / 64) * (DM / 32), I_O = (DM / 64) * (DM / 32), I_G = (DM / 64) * (DFF / 32), I_D = (DFF / 64) * (DM / 32);
    constexpr int NITEMS = I_IN + I_PB + I_PC + I_O + 2 * I_G + I_D;
    for (int it = gw; it < NITEMS; it += ngw) {
        int r = it;
        if (r < I_IN) { transpose_item(w_in, DM, INCOLS, W + W_IN, scr, r, lane); continue; } r -= I_IN;
        if (r < I_PB) { transpose_item(w_pb, DRNN, DM, W + W_PB, scr, r, lane); continue; } r -= I_PB;
        if (r < I_PC) { transpose_item(w_pc, DCH, DM, W + W_PC, scr, r, lane); continue; } r -= I_PC;
        if (r < I_O) { transpose_item(w_o, DM, DM, W + W_O, scr, r, lane); continue; } r -= I_O;
        if (r < I_G) { transpose_item(wg, DM, DFF, W + W_G, scr, r, lane); continue; } r -= I_G;
        if (r < I_G) { transpose_item(wu, DM, DFF, W + W_U, scr, r, lane); continue; } r -= I_G;
        transpose_item(wd, DFF, DM, W + W_D, scr, r, lane);
    }
    const int gt = bid * 512 + tid, ngt = G * 512;
    { const float* pw = p.in[8] + (size_t)l * 4 * 128 * 128; const float* ps = p.in[9] + (size_t)l * DPOOL; const float* w_pa = p.in[20] + (size_t)l * DPOOL * DM;
      for (int idx = gt; idx < DPOOL * (DM / 4); idx += ngt) { const int n = (idx & 255) * 4, kp = idx >> 8, g = kp >> 7;
          const float* pr = pw + (size_t)kp * 128; const float* sr = ps + g * 128; const float* wr_ = w_pa + (size_t)g * 128 * DM + n; f32x4 s4 = (f32x4){0.f, 0.f, 0.f, 0.f};
#pragma unroll 16
          for (int j = 0; j < 128; ++j) s4 += (pr[j] * sr[j]) * *(const f32x4*)(wr_ + (size_t)j * DM);
          W[W_PA + (size_t)n * DPOOL + kp] = f2bf(s4[0]); W[W_PA + (size_t)(n + 1) * DPOOL + kp] = f2bf(s4[1]);
          W[W_PA + (size_t)(n + 2) * DPOOL + kp] = f2bf(s4[2]); W[W_PA + (size_t)(n + 3) * DPOOL + kp] = f2bf(s4[3]); } }
    { const float* wa = p.in[12] + (size_t)l * 8 * 128 * 128; const float* wx = p.in[14] + (size_t)l * 8 * 128 * 128;
      for (int idx = gt; idx < 8 * 256 * 256; idx += ngt) { const int k = idx & 255, n = (idx >> 8) & 255, h = idx >> 16; float v = 0.f;
          if ((k >> 7) == (h & 1)) v = (n < 128 ? wa : wx)[((size_t)h * 128 + (k & 127)) * 128 + (n & 127)];
          W[W_RI + idx] = f2bf(v); } }
    if (gt < DRNN) { const float y = __expf(-p.in[16][(size_t)l * DRNN + gt]);
        const float lp = y < 0.05f ? y * (1.f - y * (0.5f - y * (0.33333334f - y * (0.25f - y * 0.2f)))) : __logf(1.f + y);
        ((float*)(p.ws + WS_SP))[gt] = -8.f * lp; }
    rms_rows(xp, xs, p.in[6] + (size_t)l * DM, (bf16_t*)(p.ws + WS_XN), gw, ngw, lane);
}

__device__ __forceinline__ void phase_mix(const Params& p, int l, LAS unsigned char* lds, int bid, int G) {
    int tid = threadIdx.x; asm volatile("" : "+v"(tid));
    const int wave = tid >> 6, lane = tid & 63;
    const bf16_t* Za = (const bf16_t*)(p.ws + WS_Z); const bf16_t* Zbx = Za + UE; const bf16_t* Zgu = Za + 5 * UE; const bf16_t* Zgv = Za + 6 * UE;
    bf16_t* Y0 = (bf16_t*)(p.ws + WS_Y); bf16_t* Yd = Y0 + 2 * UE; bf16_t* Yc = Y0 + 3 * UE;
    const float* vg = p.in[17] + (size_t)l * DCH; const float* cws = p.in[18] + (size_t)l * 4 * 128 * 128; const float* cbs = p.in[19] + (size_t)l * 4 * 128;
    if (bid < 128) {
        const int r0 = bid * 128;
        LAS float* rstd = (LAS float*)lds; LAS bf16_t* VT = (LAS bf16_t*)(lds + 1024);
        { const int j = tid >> 2, q = tid & 3; const u32x4* src = (const u32x4*)(Zgv + (size_t)(r0 + j) * DCH + q * 128); float s = 0.f;
#pragma unroll
          for (int i = 0; i < 16; ++i) { const F8 v = unpack8(src[i]); s += (v.a[0] * v.a[0] + v.a[1] * v.a[1]) + (v.a[2] * v.a[2] + v.a[3] * v.a[3]) + (v.b[0] * v.b[0] + v.b[1] * v.b[1]) + (v.b[2] * v.b[2] + v.b[3] * v.b[3]); }
          s += __shfl_xor(s, 1); s += __shfl_xor(s, 2);
          if (q == 0) rstd[j] = rsqrtf(s * (1.f / DCH) + 1e-6f); }
        __syncthreads();
        const int fr = lane & 15, fq = lane >> 4;
        for (int g = 0; g < 4; ++g) {
            { const int j = tid >> 2, q = tid & 3; const float rs = rstd[j];
              const u32x4* src = (const u32x4*)(Zgv + (size_t)(r0 + j) * DCH + g * 128 + q * 32); const float* gg = vg + g * 128 + q * 32;
#pragma unroll
              for (int i = 0; i < 4; ++i) { const F8 v = unpack8(src[i]); const f32x4 g0 = *(const f32x4*)(gg + 8 * i), g1 = *(const f32x4*)(gg + 8 * i + 4);
                  const int d = q * 32 + 8 * i;
#pragma unroll
                  for (int e = 0; e < 4; ++e) { VT[(d + e) * 136 + j] = f2bf(v.a[e] * rs * g0[e]); VT[(d + 4 + e) * 136 + j] = f2bf(v.b[e] * rs * g1[e]); } } }
            __syncthreads();
            const int i = 16 * wave + fr; bf16x8 af[4];
#pragma unroll
            for (int ks = 0; ks < 4; ++ks) { const int k0 = 32 * ks + 8 * fq; const float* wrow = cws + ((size_t)g * 128 + i) * 128 + k0;
                const f32x4 a0 = *(const f32x4*)wrow, a1 = *(const f32x4*)(wrow + 4); u32x4 w;
                w.x = pk2(k0 + 0 <= i ? a0[0] : 0.f, k0 + 1 <= i ? a0[1] : 0.f); w.y = pk2(k0 + 2 <= i ? a0[2] : 0.f, k0 + 3 <= i ? a0[3] : 0.f);
                w.z = pk2(k0 + 4 <= i ? a1[0] : 0.f, k0 + 5 <= i ? a1[1] : 0.f); w.w = pk2(k0 + 6 <= i ? a1[2] : 0.f, k0 + 7 <= i ? a1[3] : 0.f);
                af[ks] = __builtin_bit_cast(bf16x8, w); }
            const float bsv = cbs[g * 128 + i];
#pragma unroll
            for (int dt = 0; dt < 8; ++dt) {
                f32x4 c4 = (f32x4){0.f, 0.f, 0.f, 0.f};
#pragma unroll
                for (int ks = 0; ks < 4; ++ks) { const bf16x8 vf = *(const LAS bf16x8*)(VT + (16 * dt + fr) * 136 + 32 * ks + 8 * fq);
                    c4 = __builtin_amdgcn_mfma_f32_16x16x32_bf16(vf, af[ks], c4, 0, 0, 0); }
                const size_t off = (size_t)(r0 + i) * DCH + g * 128 + 16 * dt + 4 * fq;
                const u32x2 uu = *(const u32x2*)(Zgu + off); u32x2 o;
                o.x = pk2(bf_lo(uu.x) * (c4[0] + bsv), bf_hi(uu.x) * (c4[1] + bsv)); o.y = pk2(bf_lo(uu.y) * (c4[2] + bsv), bf_hi(uu.y) * (c4[3] + bsv));
                *(u32x2*)(Yc + off) = o;
            }
            __syncthreads();
        }
    } else if (bid < 144) {
        const int s = (bid - 128) * 8 + wave, row = MPR + s, c = lane * 8, g = lane >> 4;
        const F8 v = unpack8(*(const u32x4*)(Zgv + (size_t)row * DCH + c));
        float ss = (v.a[0] * v.a[0] + v.a[1] * v.a[1]) + (v.a[2] * v.a[2] + v.a[3] * v.a[3]) + (v.b[0] * v.b[0] + v.b[1] * v.b[1]) + (v.b[2] * v.b[2] + v.b[3] * v.b[3]);
        const float rs = rsqrtf(wave_sum(ss) * (1.f / DCH) + 1e-6f);
        const f32x4 vn0 = v.a * rs * *(const f32x4*)(vg + c), vn1 = v.b * rs * *(const f32x4*)(vg + c + 4);
        float* ov = p.out + O_CV_S + ((size_t)l * NS + s) * DCH + c; *(f32x4*)ov = vn0; *(f32x4*)(ov + 4) = vn1;
        const float w00 = cws[(size_t)g * 128 * 128], b0 = cbs[g * 128];
        const F8 uu = unpack8(*(const u32x4*)(Zgu + (size_t)row * DCH + c));
        *(u32x4*)(Yc + (size_t)row * DCH + c) = pack8(uu.a * (vn0 * w00 + b0), uu.b * (vn1 * w00 + b0));
    }
    if (bid >= 128) {
    const int et = (bid - 128) * 512 + tid, net = (G - 128) * 512;
    { const float* cw = p.in[10] + (size_t)l * 4 * DRNN; const float* cb = p.in[11] + (size_t)l * DRNN; const float* st = p.in[3] + (size_t)l * NS * 3 * DRNN;
      for (int idx = et; idx < (MPR / 8) * 128; idx += net) { const int r0 = (idx >> 7) * 8, c = (idx & 127) * 8, t0 = r0 & 2047;
          const f32x4 w00 = *(const f32x4*)(cw + c), w01 = *(const f32x4*)(cw + c + 4), w10 = *(const f32x4*)(cw + DRNN + c), w11 = *(const f32x4*)(cw + DRNN + c + 4);
          const f32x4 w20 = *(const f32x4*)(cw + 2 * DRNN + c), w21 = *(const f32x4*)(cw + 2 * DRNN + c + 4), w30 = *(const f32x4*)(cw + 3 * DRNN + c), w31 = *(const f32x4*)(cw + 3 * DRNN + c + 4);
          const f32x4 b0 = *(const f32x4*)(cb + c), b1 = *(const f32x4*)(cb + c + 4);
          F8 x1, x2, x3; const u32x4 zz = (u32x4){0u, 0u, 0u, 0u};
          x3 = unpack8(t0 >= 3 ? *(const u32x4*)(Zbx + (size_t)(r0 - 3) * DRNN + c) : zz); x2 = unpack8(t0 >= 2 ? *(const u32x4*)(Zbx + (size_t)(r0 - 2) * DRNN + c) : zz); x1 = unpack8(t0 >= 1 ? *(const u32x4*)(Zbx + (size_t)(r0 - 1) * DRNN + c) : zz);
#pragma unroll
          for (int i = 0; i < 8; ++i) { const F8 x0 = unpack8(*(const u32x4*)(Zbx + (size_t)(r0 + i) * DRNN + c));
              *(u32x4*)(Y0 + (size_t)(r0 + i) * DRNN + c) = pack8(b0 + w30 * x0.a + w20 * x1.a + w10 * x2.a + w00 * x3.a, b1 + w31 * x0.b + w21 * x1.b + w11 * x2.b + w01 * x3.b);
              x3 = x2; x2 = x1; x1 = x0; } }
      for (int idx = et; idx < NS * 128; idx += net) { const int row = MPR + (idx >> 7), c = (idx & 127) * 8;
          f32x4 s0 = *(const f32x4*)(cb + c), s1 = *(const f32x4*)(cb + c + 4);
          { const F8 x = unpack8(*(const u32x4*)(Zbx + (size_t)row * DRNN + c)); s0 += *(const f32x4*)(cw + 3 * DRNN + c) * x.a; s1 += *(const f32x4*)(cw + 3 * DRNN + c + 4) * x.b; }
          const float* sp = st + (size_t)(row - MPR) * 3 * DRNN + c;
#pragma unroll
          for (int k = 0; k < 3; ++k) { s0 += *(const f32x4*)(cw + k * DRNN + c) * *(const f32x4*)(sp + k * DRNN); s1 += *(const f32x4*)(cw + k * DRNN + c + 4) * *(const f32x4*)(sp + k * DRNN + 4); }
          *(u32x4*)(Y0 + (size_t)row * DRNN + c) = pack8(s0, s1); } }
    { const float* st = p.in[2] + (size_t)l * NS * 15 * DPOOL;
      for (int idx = et; idx < (MPR / 8) * 64; idx += net) { const int g = (idx >> 6) & 3, rb = ((idx >> 8) << 2) + ((idx >> 4) & 3), c = g * 128 + (idx & 15) * 8, w = 2 << g, r0 = rb * 8, t0 = r0 & 2047;
          f32x4 s0 = (f32x4){0.f, 0.f, 0.f, 0.f}, s1 = s0;
#pragma unroll
          for (int j = 1; j < 16; ++j) if (j < w && t0 >= j) { const F8 x = unpack8(*(const u32x4*)(Za + (size_t)(r0 - j) * DPOOL + c)); s0 += x.a; s1 += x.b; }
#pragma unroll
          for (int i = 0; i < 8; ++i) { const F8 cur = unpack8(*(const u32x4*)(Za + (size_t)(r0 + i) * DPOOL + c)); s0 += cur.a; s1 += cur.b;
              const int t = t0 + i; const float ic = 1.f / (float)(t + 1 < w ? t + 1 : w);
              *(u32x4*)(Yd + (size_t)(r0 + i) * DPOOL + c) = pack8(s0 * ic - cur.a, s1 * ic - cur.b);
              if (t >= w - 1) { const F8 old = unpack8(*(const u32x4*)(Za + (size_t)(r0 + i - (w - 1)) * DPOOL + c)); s0 -= old.a; s1 -= old.b; } } }
      for (int idx = et; idx < NS * 64; idx += net) { const int row = MPR + (idx >> 6), c = (idx & 63) * 8, w = 2 << (c >> 7);
          const F8 cur = unpack8(*(const u32x4*)(Za + (size_t)row * DPOOL + c)); f32x4 s0 = cur.a, s1 = cur.b;
          const float* sp = st + (size_t)(row - MPR) * 15 * DPOOL + c;
          for (int j = 1; j < w; ++j) { s0 += *(const f32x4*)(sp + (15 - j) * DPOOL); s1 += *(const f32x4*)(sp + (15 - j) * DPOOL + 4); }
          const float ic = 1.f / (float)w;
          *(u32x4*)(Yd + (size_t)row * DPOOL + c) = pack8(s0 * ic - cur.a, s1 * ic - cur.b); } }
    }
    const int gt = bid * 512 + tid, ngt = G * 512;
    { const float* sp = p.in[2] + (size_t)l * NS * 15 * DPOOL; float* o = p.out + O_POOL_S + (size_t)l * NS * 15 * DPOOL;
      for (int idx = gt; idx < NS * 14 * (DPOOL / 4); idx += ngt) { const int c = (idx & 127) * 4, r = (idx >> 7) % 14, s = (idx >> 7) / 14;
          *(f32x4*)(o + ((size_t)s * 15 + r) * DPOOL + c) = *(const f32x4*)(sp + ((size_t)s * 15 + r + 1) * DPOOL + c); } }
    { const float* sp = p.in[3] + (size_t)l * NS * 3 * DRNN; float* o = p.out + O_RC_S + (size_t)l * NS * 3 * DRNN;
      for (int idx = gt; idx < NS * 2 * (DRNN / 4); idx += ngt) { const int c = (idx & 255) * 4, r = (idx >> 8) & 1, s = idx >> 9;
          *(f32x4*)(o + ((size_t)s * 3 + r) * DRNN + c) = *(const f32x4*)(sp + ((size_t)s * 3 + r + 1) * DRNN + c); } }
    { const float* sp = p.in[5] + (size_t)l * NS * 2 * DFF; float* o = p.out + O_FF_S + (size_t)l * NS * 2 * DFF;
      for (int idx = gt; idx < NS * (DFF / 4); idx += ngt) { const int c = (idx % 768) * 4, s = idx / 768;
          *(f32x4*)(o + ((size_t)s * 2) * DFF + c) = *(const f32x4*)(sp + ((size_t)s * 2 + 1) * DFF + c); } }
}

__device__ __forceinline__ void phase_scan(const Params& p, int l, LAS unsigned char* lds, int bid, int G) {
    int tid = threadIdx.x; asm volatile("" : "+v"(tid));
    const bf16_t* LA = (const bf16_t*)(p.ws + WS_Z) + UE; const bf16_t* BV = (const bf16_t*)(p.ws + WS_Z) + 5 * UE; const bf16_t* GB = (const bf16_t*)(p.ws + WS_Z) + 3 * UE;
    bf16_t* Y0 = (bf16_t*)(p.ws + WS_Y);
    LAS float* sP = (LAS float*)lds; LAS float* sH = sP + 4096; LAS float* sC = sH + 4096; LAS float* sPg = sC + 4096; LAS float* sHg = sPg + 512;
    for (int item = bid; item < 256; item += G) {
        const int b = item >> 5, c0 = (item & 31) * 32, seg = tid >> 2, lg = tid & 3;
        const size_t base = ((size_t)b * SEQ + seg * 16) * DRNN + c0 + lg * 8;
        f32x4 P0 = (f32x4){1.f, 1.f, 1.f, 1.f}, P1 = P0, h0 = (f32x4){0.f, 0.f, 0.f, 0.f}, h1 = h0;
#pragma unroll
        for (int t = 0; t < 16; ++t) { const F8 la = unpack8(*(const u32x4*)(LA + base + (size_t)t * DRNN)), bv = unpack8(*(const u32x4*)(BV + base + (size_t)t * DRNN));
            f32x4 a0, a1;
#pragma unroll
            for (int e = 0; e < 4; ++e) { a0[e] = __builtin_amdgcn_exp2f(1.442695041f * la.a[e]); a1[e] = __builtin_amdgcn_exp2f(1.442695041f * la.b[e]); }
            h0 = a0 * h0 + bv.a; h1 = a1 * h1 + bv.b; P0 *= a0; P1 *= a1; }
        { const int o = seg * 32 + lg * 8; *(LAS f32x4*)(sP + o) = P0; *(LAS f32x4*)(sP + o + 4) = P1; *(LAS f32x4*)(sH + o) = h0; *(LAS f32x4*)(sH + o + 4) = h1; }
        __syncthreads();
        const int ch = tid & 31, sg = tid >> 5;
        { float Pg = 1.f, hg = 0.f;
#pragma unroll
          for (int k = 0; k < 8; ++k) { const float pp = sP[(sg * 8 + k) * 32 + ch], hh = sH[(sg * 8 + k) * 32 + ch]; hg = pp * hg + hh; Pg *= pp; }
          sPg[sg * 32 + ch] = Pg; sHg[sg * 32 + ch] = hg; }
        __syncthreads();
        { float carry = 0.f;
          for (int k = 0; k < sg; ++k) carry = sPg[k * 32 + ch] * carry + sHg[k * 32 + ch];
#pragma unroll
          for (int k = 0; k < 8; ++k) { const int o = (sg * 8 + k) * 32 + ch; sC[o] = carry; carry = sP[o] * carry + sH[o]; }
          if (sg == 15) p.out[O_H_P + ((size_t)l * NB + b) * DRNN + c0 + ch] = carry; }
        __syncthreads();
        { const int o = seg * 32 + lg * 8; h0 = *(LAS f32x4*)(sC + o); h1 = *(LAS f32x4*)(sC + o + 4); }
#pragma unroll
        for (int t = 0; t < 16; ++t) { const F8 la = unpack8(*(const u32x4*)(LA + base + (size_t)t * DRNN)), bv = unpack8(*(const u32x4*)(BV + base + (size_t)t * DRNN)), gt = unpack8(*(const u32x4*)(GB + base + (size_t)t * DRNN));
            f32x4 a0, a1;
#pragma unroll
            for (int e = 0; e < 4; ++e) { a0[e] = __builtin_amdgcn_exp2f(1.442695041f * la.a[e]); a1[e] = __builtin_amdgcn_exp2f(1.442695041f * la.b[e]); }
            h0 = a0 * h0 + bv.a; h1 = a1 * h1 + bv.b;
            *(u32x4*)(Y0 + base + (size_t)t * DRNN) = pack8(gt.a * h0, gt.b * h1); }
        __syncthreads();
    }
    { const float* hin = p.in[4] + (size_t)l * NS * DRNN; float* oh = p.out + O_H_S + (size_t)l * NS * DRNN;
      for (int idx = bid * 512 + tid; idx < NS * DRNN; idx += G * 512) { const size_t off = (size_t)MPR * DRNN + idx;
          const float a = __expf(bf2f(LA[off])), h = a * hin[idx] + bf2f(BV[off]); oh[idx] = h; Y0[off] = f2bf(bf2f(GB[off]) * h); } }
}

__device__ __forceinline__ void phase_merge(const Params& p, int bid, int NG) {
    const bf16_t* G = (const bf16_t*)(p.ws + WS_Z); bf16_t* XN = (bf16_t*)(p.ws + WS_XN);
    int tid = threadIdx.x; asm volatile("" : "+v"(tid));
    for (int idx = bid * 512 + tid; idx < MPAD * 128; idx += NG * 512) { const int row = idx >> 7, c = (idx & 127) * 8;
        const bf16_t* gr = G + (size_t)row * 3072 + c; const F8 a = unpack8(*(const u32x4*)gr), b = unpack8(*(const u32x4*)(gr + 1024)), d = unpack8(*(const u32x4*)(gr + 2048));
        *(u32x4*)(XN + (size_t)row * DM + c) = pack8(a.a + b.a + d.a, a.b + b.b + d.b); }
}

__device__ __forceinline__ void phase_final(const Params& p, int bid, int G) {
    int tid = threadIdx.x; asm volatile("" : "+v"(tid));
    const int wave = tid >> 6, lane = tid & 63; const float* g = p.in[30];
    for (int row = bid * 8 + wave; row < MROWS; row += G * 8) {
        f32x4* xr = (f32x4*)(p.out + (size_t)row * DM) + lane; f32x4 v[4]; float s = 0.f;
#pragma unroll
        for (int j = 0; j < 4; ++j) { v[j] = xr[64 * j]; s += (v[j][0] * v[j][0] + v[j][1] * v[j][1]) + (v[j][2] * v[j][2] + v[j][3] * v[j][3]); }
        const float rstd = rsqrtf(wave_sum(s) * (1.f / DM) + 1e-6f); const f32x4* gr = (const f32x4*)g + lane;
#pragma unroll
        for (int j = 0; j < 4; ++j) xr[64 * j] = v[j] * rstd * gr[64 * j];
    }
}


#define XB_TMO      128
#define XB_XCNT(j)  (256  + 64 * (j))
#define XB_XSUB(j)  (1280 + 64 * (j))
#define XB_XGEN(j)  (2304 + 64 * (j))
#define XB_TOP      3328
#define XB_TOPGEN   3392
#define XCD_BAR_WORDS 3456
#define XB_SPIN_CAP (1u << 18)
__device__ __forceinline__ unsigned xb_ld(unsigned* p)              { return __hip_atomic_load(p, __ATOMIC_RELAXED, __HIP_MEMORY_SCOPE_AGENT); }
__device__ __forceinline__ unsigned xb_add(unsigned* p, unsigned v) { return __hip_atomic_fetch_add(p, v, __ATOMIC_RELAXED, __HIP_MEMORY_SCOPE_AGENT); }
__device__ __forceinline__ unsigned xb_xcc_id() { return (unsigned)__builtin_amdgcn_s_getreg((3 << 11) | 20) & 0xFu; }
#define XB_SPIN(cond, bar) do { unsigned _sp = 0; while (cond) { __builtin_amdgcn_s_sleep(1); \
    if ((++_sp & 255u) == 0u) { if (xb_ld(&(bar)[XB_TMO])) break; if (_sp > XB_SPIN_CAP) { atomicAdd(&(bar)[XB_TMO], 1u); break; } } } } while (0)
__device__ __forceinline__ void xcd_barrier_complete(unsigned* bar, unsigned x, unsigned G, unsigned& nloc, unsigned& nx) {
    unsigned sum, cnt, mine, sp = 0u;
    for (;;) {
        sum = 0u; cnt = 0u; mine = 0u;
#pragma unroll
        for (unsigned j = 0; j < 16; ++j) { const unsigned c = xb_ld(&bar[XB_XCNT(j)]); sum += c; cnt += (c > 0u) ? 1u : 0u; mine = (j == x) ? c : mine; }
        if (sum == G) break;
        __builtin_amdgcn_s_sleep(1);
        if ((++sp & 255u) == 0u) { if (xb_ld(&bar[XB_TMO])) break; if (sp > XB_SPIN_CAP) { atomicAdd(&bar[XB_TMO], 1u); break; } }
    }
    nloc = mine > 0u ? mine : 1u; nx = cnt > 0u ? cnt : 1u;
}
__device__ __forceinline__ void xcd_barrier(unsigned* bar, volatile LAS unsigned* st, unsigned G) {
    asm volatile("s_waitcnt vmcnt(0)" ::: "memory");
    __syncthreads();
    if (threadIdx.x == 0) {
        const unsigned x = xb_xcc_id();
        __builtin_amdgcn_s_waitcnt(0);
        unsigned nloc = st[0], nx = st[1];
        if (nloc == 0u) { xcd_barrier_complete(bar, x, G, nloc, nx); st[0] = nloc; st[1] = nx; }
        const unsigned old = xb_add(&bar[XB_XSUB(x)], 1u);
        const unsigned gen = old / nloc;
        if (old + 1u == (gen + 1u) * nloc) {
            __builtin_amdgcn_fence(__ATOMIC_RELEASE, "agent");
            asm volatile("s_waitcnt vmcnt(0)" ::: "memory");
            const unsigned og = xb_add(&bar[XB_TOP], 1u);
            const unsigned tg = og / nx;
            if (og + 1u == (tg + 1u) * nx) xb_add(&bar[XB_TOPGEN], 1u);
            else XB_SPIN(xb_ld(&bar[XB_TOPGEN]) == tg, bar);
            __builtin_amdgcn_fence(__ATOMIC_ACQUIRE, "agent");
            xb_add(&bar[XB_XGEN(x)], 1u);
            asm volatile("s_waitcnt vmcnt(0)" ::: "memory");
        } else {
            XB_SPIN(xb_ld(&bar[XB_XGEN(x)]) == gen, bar);
            __builtin_amdgcn_fence(__ATOMIC_ACQUIRE, "agent");
            asm volatile("s_waitcnt vmcnt(0)" ::: "memory");
        }
    }
    __syncthreads();
}

__global__ void __launch_bounds__(512, 2) mega(Params pk) {
    extern __shared__ __attribute__((aligned(16))) unsigned char shm[];
    LAS unsigned char* lds = (LAS unsigned char*)shm;
    cg::grid_group grid = cg::this_grid();
    volatile LAS unsigned* bst = (volatile LAS unsigned*)(lds + 131072 + 1024);
    if (threadIdx.x < 2) bst[threadIdx.x] = 0u;
    if (blockIdx.x == 0) for (int i = threadIdx.x; i < XCD_BAR_WORDS; i += 512) ((unsigned*)(pk.ws + WS_BAR))[i] = 0u;
    __syncthreads();
    bool posted = false;
    for (int ph = pk.ph_lo; ph < pk.ph_hi; ++ph) {
        Params p = pk; int G = gridDim.x, bid = blockIdx.x;
        asm volatile("" : "+s"(p.ws), "+s"(p.out), "+s"(G), "+s"(bid));
        bf16_t* XN = (bf16_t*)(p.ws + WS_XN); bf16_t* Z = (bf16_t*)(p.ws + WS_Z); bf16_t* Y0 = (bf16_t*)(p.ws + WS_Y); bf16_t* W = (bf16_t*)(p.ws + WS_W); bf16_t* H = (bf16_t*)(p.ws + WS_H);
        if (ph == NPH - 1) { phase_final(p, bid, G); }
        else {
            const int l = ph / PH_PER_LAYER, k = ph % PH_PER_LAYER;
            const float* xp = l == 0 ? p.in[0] : p.out; const float* xs = l == 0 ? p.in[1] : p.out + (size_t)MPR * DM;
            pg8::Order S; pg8::Gemm g;
            for (int rep = ((REPMASK >> k) & 1u) ? 2 : 1; rep > 0; --rep)
            switch (k) {
            case 0: phase_prep(p, l, lds, xp, xs, bid, G); break;
            case 1: { S.init(64, ZC / 256, G, bid, 0); g = {XN, W + W_IN, DM, DM, DM}; EpiZ E{Z, p.out, l}; pg8::gemm_phase(lds, g, S, E);
                      sample_gemm<false>(lds, XN + (size_t)MPR * DM, DM, W + W_IN, DM, DM, ZC / 16, bid, G, E); } break;
            case 2: phase_mix(p, l, lds, bid, G); break;
            case 3: { S.init(64, 8, G, bid, 1); g = {Y0, W + W_RI, DRNN, 256, 256};
                      EpiRI E{Y0, Z + UE, Z + 5 * UE, p.in[13] + (size_t)l * DRNN, p.in[15] + (size_t)l * DRNN, (const float*)(p.ws + WS_SP)}; pg8::gemm_phase(lds, g, S, E);
                      sample_gemm<true>(lds, Y0 + (size_t)MPR * DRNN, DRNN, W + W_RI, 256, 256, 64, bid, G, E); } break;
            case 4: phase_scan(p, l, lds, bid, G); break;
            case 5: { S.init(64, 12, G, bid, 0); g = {XN, W + W_IN + (size_t)ZC * DM, DM, DM, DM}; EpiG E{Z}; pg8::gemm_phase(lds, g, S, E);
                      sample_gemm<false>(lds, XN + (size_t)MPR * DM, DM, W + W_IN + (size_t)ZC * DM, DM, DM, 3072 / 16, bid, G, E); } break;
            case 6: { { S.init(64, 4, G, bid, 0); g = {Y0 + 2 * UE, W + W_PA, DPOOL, DPOOL, DPOOL}; EpiP E{Z, XN, 0, 1}; pg8::gemm_phase(lds, g, S, E);
                        sample_gemm<false>(lds, Y0 + 2 * UE + (size_t)MPR * DPOOL, DPOOL, W + W_PA, DPOOL, DPOOL, 64, bid, G, E); }
                      { S.init(64, 4, G, bid, 0); g = {Y0, W + W_PB, DRNN, DRNN, DRNN}; EpiP E{Z, XN, 1024, 0}; pg8::gemm_phase(lds, g, S, E);
                        sample_gemm<false>(lds, Y0 + (size_t)MPR * DRNN, DRNN, W + W_PB, DRNN, DRNN, 64, bid, G, E); }
                      { S.init(64, 4, G, bid, 0); g = {Y0 + 3 * UE, W + W_PC, DCH, DCH, DCH}; EpiP E{Z, XN, 2048, 0}; pg8::gemm_phase(lds, g, S, E);
                        sample_gemm<false>(lds, Y0 + 3 * UE + (size_t)MPR * DCH, DCH, W + W_PC, DCH, DCH, 64, bid, G, E); } } break;
            case 7: break;
            case 8: { S.init(64, 4, G, bid, 0); g = {XN, W + W_O, DM, DM, DM}; EpiX E{xp, xs, p.out}; pg8::gemm_phase(lds, g, S, E);
                      sample_gemm<false>(lds, XN + (size_t)MPR * DM, DM, W + W_O, DM, DM, 64, bid, G, E); } break;
            case 9: { int tid = threadIdx.x; asm volatile("" : "+v"(tid)); const int wave = tid >> 6, lane = tid & 63; rms_rows(p.out, p.out + (size_t)MPR * DM, p.in[24] + (size_t)l * DM, XN, bid * 8 + wave, G * 8, lane); } break;
            case 10: { S.init(64, 12, G, bid, 0); g = {XN, W + W_G, DM, DM, DM}; EpiGpre E{Z, p.out, l}; pg8::gemm_phase(lds, g, S, E);
                       sample_gemm<false>(lds, XN + (size_t)MPR * DM, DM, W + W_G, DM, DM, 192, bid, G, E); } break;
            case 11: { S.init(64, 12, G, bid, 0); g = {XN, W + W_U, DM, DM, DM};
                       EpiH E{Z, H, p.in[27] + (size_t)l * 3 * DFF, p.in[28] + (size_t)l * DFF, p.in[5] + (size_t)l * NS * 2 * DFF}; pg8::gemm_phase(lds, g, S, E);
                       sample_gemm<false>(lds, XN + (size_t)MPR * DM, DM, W + W_U, DM, DM, 192, bid, G, E); } break;
            default: { S.init(64, 4, G, bid, 0); g = {H, W + W_D, DFF, DFF, DFF}; EpiX E{p.out, p.out + (size_t)MPR * DM, p.out}; pg8::gemm_phase(lds, g, S, E);
                       sample_gemm<false>(lds, H + (size_t)MPR * DFF, DFF, W + W_D, DFF, DFF, 64, bid, G, E); } break;
            }
        }
        if (ph + 1 < pk.ph_hi && (ph % PH_PER_LAYER) != 7) {
            if (!posted) {
                grid.sync(); posted = true;
                if (threadIdx.x == 0) (void)xb_add(&((unsigned*)(pk.ws + WS_BAR))[XB_XCNT(xb_xcc_id())], 1u);
            } else xcd_barrier((unsigned*)(pk.ws + WS_BAR), bst, (unsigned)gridDim.x);
            for (int e = 0; e < EXTRA_SYNCS; ++e) xcd_barrier((unsigned*)(pk.ws + WS_BAR), bst, (unsigned)gridDim.x);
        }
    }
}

extern "C" void kernel_launch(void* const* d_in, const int* in_sizes, int n_in, void* d_out, int out_size, void* d_ws, size_t ws_size, hipStream_t stream) {
    static int grid = 0;
    if (grid == 0) {
        int dev = 0, cus = 0, per_cu = 0;
        hipGetDevice(&dev);
        hipDeviceGetAttribute(&cus, hipDeviceAttributeMultiprocessorCount, dev);
        if (hipFuncSetAttribute((const void*)mega, hipFuncAttributeMaxDynamicSharedMemorySize, LDS_BYTES) != hipSuccess) fprintf(stderr, "kernel_launch: hipFuncSetAttribute failed\n");
        if (hipOccupancyMaxActiveBlocksPerMultiprocessor(&per_cu, (const void*)mega, 512, LDS_BYTES) != hipSuccess || per_cu < 1) { fprintf(stderr, "kernel_launch: occupancy query says %d blocks per CU\n", per_cu); per_cu = 1; }
        (void)hipGetLastError();
        grid = cus;
        if (n_in != 31 || ws_size < WS_END) fprintf(stderr, "kernel_launch: unexpected n_in %d / ws_size %zu (need %zu)\n", n_in, ws_size, (size_t)WS_END);
    }
    Params p{};
    for (int i = 0; i < 31; ++i) p.in[i] = (const float*)d_in[i];
    p.out = (float*)d_out; p.ws = (unsigned char*)d_ws; p.ph_lo = 0; p.ph_hi = NPH;
    void* args[] = {&p};
    hipError_t e = hipLaunchCooperativeKernel((const void*)mega, dim3(grid), dim3(512), args, LDS_BYTES, stream);
    if (e != hipSuccess) fprintf(stderr, "cooperative launch failed: %s (grid %d)\n", hipGetErrorString(e), grid);
}
```

```cpp
#include <hip/hip_runtime.h>
#include <hip/hip_cooperative_groups.h>
#include <cstdio>
#include <cstdint>
namespace cg = cooperative_groups;

#define LAS __attribute__((address_space(3)))
typedef unsigned short bf16_t;
typedef short bf16x8 __attribute__((ext_vector_type(8)));
typedef float f32x4 __attribute__((ext_vector_type(4)));
typedef float f32x2 __attribute__((ext_vector_type(2)));
typedef unsigned u32x4 __attribute__((ext_vector_type(4)));
typedef unsigned u32x2 __attribute__((ext_vector_type(2)));

constexpr int DM = 1024, NB = 8, SEQ = 2048, MPR = NB * SEQ, NS = 128, MROWS = MPR + NS, MPAD = 16640, NTM = MPAD / 256;
constexpr int DPOOL = 512, DRNN = 1024, DCH = 512, DFF = 3072, INCOLS = 6656, ZC = 3584;
constexpr int NLAYER = 2, PH_PER_LAYER = 13, NPH = NLAYER * PH_PER_LAYER + 1;
constexpr size_t O_Y = 0;
constexpr size_t O_POOL_P = (size_t)MROWS * DM;
constexpr size_t O_POOL_S = O_POOL_P + (size_t)2 * NB * 15 * DPOOL;
constexpr size_t O_RC_P = O_POOL_S + (size_t)2 * NS * 15 * DPOOL;
constexpr size_t O_RC_S = O_RC_P + (size_t)2 * NB * 3 * DRNN;
constexpr size_t O_H_P = O_RC_S + (size_t)2 * NS * 3 * DRNN;
constexpr size_t O_H_S = O_H_P + (size_t)2 * NB * DRNN;
constexpr size_t O_FF_P = O_H_S + (size_t)2 * NS * DRNN;
constexpr size_t O_FF_S = O_FF_P + (size_t)2 * NB * 2 * DFF;
constexpr size_t O_CV_S = O_FF_S + (size_t)2 * NS * 2 * DFF;
constexpr size_t UE = (size_t)MPAD * 512, UB = UE * 2;
constexpr size_t WS_BAR = 16384;
constexpr size_t WS_SP = 4096;
constexpr size_t WS_XN = 1u << 20;
constexpr size_t WS_Z = WS_XN + 2 * UB;
constexpr size_t WS_Y = WS_Z + 7 * UB;
constexpr size_t WS_W = WS_Y + 4 * UB;
constexpr size_t WS_H = WS_Z + 6 * UB;
constexpr size_t W_IN = 0;
constexpr size_t W_PA = W_IN + (size_t)INCOLS * DM;
constexpr size_t W_PB = W_PA + (size_t)DM * DPOOL;
constexpr size_t W_PC = W_PB + (size_t)DM * DRNN;
constexpr size_t W_O = W_PC + (size_t)DM * DCH;
constexpr size_t W_G = W_O + (size_t)DM * DM;
constexpr size_t W_U = W_G + (size_t)DFF * DM;
constexpr size_t W_D = W_U + (size_t)DFF * DM;
constexpr size_t W_RI = W_D + (size_t)DM * DFF;
constexpr size_t W_END = W_RI + (size_t)8 * 256 * 256;
constexpr size_t WS_END = WS_W + W_END * 2;
static_assert(WS_END <= (256u << 20), "workspace");
static_assert(WS_H + 6 * UB <= WS_W + (W_G)*2, "h overlay must not reach wg/wu/wd");
constexpr int LDS_BYTES = 131072 + 2048;
#ifndef REPMASK
#define REPMASK 0u
#endif
#ifndef EXTRA_SYNCS
#define EXTRA_SYNCS 0
#endif

struct Params { const float* in[31]; float* out; unsigned char* ws; int ph_lo, ph_hi; };

__device__ __forceinline__ int tidx_of(int wvid) { unsigned z = 0u; asm volatile("" : "+v"(z));
    return wvid * 64 + (int)__builtin_amdgcn_mbcnt_hi(~0u, __builtin_amdgcn_mbcnt_lo(~0u, z)); }
#define TIDX tidx_of(wvid)
__device__ __forceinline__ float bf_lo(unsigned w) { return __builtin_bit_cast(float, w << 16); }
__device__ __forceinline__ float bf_hi(unsigned w) { return __builtin_bit_cast(float, w & 0xffff0000u); }
__device__ __forceinline__ float bf2f(bf16_t b) { return __builtin_bit_cast(float, (unsigned)b << 16); }
typedef __bf16 bf16x2_t __attribute__((ext_vector_type(2)));
__device__ __forceinline__ unsigned pk2(float lo, float hi) { f32x2 v = {lo, hi}; bf16x2_t b = __builtin_convertvector(v, bf16x2_t); return __builtin_bit_cast(unsigned, b); }
__device__ __forceinline__ bf16_t f2bf(float f) { return (bf16_t)(pk2(f, 0.f) & 0xffffu); }
struct F8 { f32x4 a, b; };
__device__ __forceinline__ F8 unpack8(u32x4 w) { F8 r; r.a[0] = bf_lo(w.x); r.a[1] = bf_hi(w.x); r.a[2] = bf_lo(w.y); r.a[3] = bf_hi(w.y); r.b[0] = bf_lo(w.z); r.b[1] = bf_hi(w.z); r.b[2] = bf_lo(w.w); r.b[3] = bf_hi(w.w); return r; }
__device__ __forceinline__ u32x4 pack8(f32x4 a, f32x4 b) { u32x4 w; w.x = pk2(a[0], a[1]); w.y = pk2(a[2], a[3]); w.z = pk2(b[0], b[1]); w.w = pk2(b[2], b[3]); return w; }
__device__ __forceinline__ float gelu_t(float x) {
    const float u = 0.7978845608f * (x + 0.044715f * x * x * x);
    const float e = __builtin_amdgcn_exp2f(-2.885390082f * u);
    return x * __builtin_amdgcn_rcpf(1.f + e);
}
__device__ __forceinline__ f32x4 gelu4(f32x4 v) { f32x4 r; r[0] = gelu_t(v[0]); r[1] = gelu_t(v[1]); r[2] = gelu_t(v[2]); r[3] = gelu_t(v[3]); return r; }
__device__ __forceinline__ float sigm(float x) { return __builtin_amdgcn_rcpf(1.f + __builtin_amdgcn_exp2f(-1.442695041f * x)); }
__device__ __forceinline__ f32x4 sigm4(f32x4 v) { f32x4 r; r[0] = sigm(v[0]); r[1] = sigm(v[1]); r[2] = sigm(v[2]); r[3] = sigm(v[3]); return r; }
__device__ __forceinline__ float wave_sum(float v) {
#pragma unroll
    for (int o = 1; o < 64; o <<= 1) v += __shfl_xor(v, o);
    return v;
}

__device__ __forceinline__ unsigned dpp_shr1(unsigned old, unsigned src) { return (unsigned)__builtin_amdgcn_update_dpp((int)old, (int)src, 0x111, 0xf, 0xf, false); }
__device__ __forceinline__ unsigned dpp_shr2(unsigned old, unsigned src) { return (unsigned)__builtin_amdgcn_update_dpp((int)old, (int)src, 0x112, 0xf, 0xf, false); }
__device__ __forceinline__ unsigned dpp_ror1(unsigned src) { return (unsigned)__builtin_amdgcn_update_dpp(0, (int)src, 0x121, 0xf, 0xf, false); }
__device__ __forceinline__ unsigned dpp_ror2(unsigned src) { return (unsigned)__builtin_amdgcn_update_dpp(0, (int)src, 0x122, 0xf, 0xf, false); }

namespace pg8 {
constexpr int BM = 256, BK = 64, HALF = 128, HTB = HALF * BK * 2, STAGE_BYTES = 8 * HTB, NXCD = 8, WGM = 8;
__device__ __forceinline__ int lds_byte(int r, int c) { const int st = (r >> 4) * 2 + (c >> 5), rr = r & 15, cc = c & 31, ob = rr * 64 + cc * 2; return st * 1024 + (ob ^ (((ob >> 9) & 1) << 5)); }
__device__ __forceinline__ void stage_rc(int b, int& R, int& C) { const int st = b / 1024, sb = b % 1024, swz = sb ^ (((sb >> 9) & 1) << 5); R = (st >> 1) * 16 + swz / 64; C = (st & 1) * 32 + (swz % 64) / 2; }
__device__ __forceinline__ int perm32(int rho) { const int n = rho >> 4, i = rho & 15; return 8 * (i >> 2) + 4 * n + (i & 3); }

struct Unit { int pm, pn, ka; };
struct Gemm { const bf16_t* A; const bf16_t* Bt; int lda, ldb, K; };

struct Order {
    int nM, nN, nwg, G, c, mode;
    __device__ __forceinline__ void init(int nM_, int nN_, int G_, int c_, int mode_) { nM = nM_; nN = nN_; nwg = nM * nN; G = G_; c = c_; mode = mode_; }
    __device__ __forceinline__ bool next(int i, Unit& u) const {
        const long L = (long)i * G + c; if (L >= nwg) return false;
        int wgid = (int)L; { const int q = nwg / NXCD, r = nwg % NXCD, xcd = wgid % NXCD, off = wgid / NXCD; wgid = (xcd < r ? xcd * (q + 1) : r * (q + 1) + (xcd - r) * q) + off; }
        const int nig = WGM * nN, gid = wgid / nig, fm = gid * WGM, gsz = (nM - fm) < WGM ? (nM - fm) : WGM;
        u.pm = fm + ((wgid % nig) % gsz); u.pn = (wgid % nig) / gsz; u.ka = mode ? ((u.pn & ~1) * 128) : 0; return true;
    }
};

template <class Epi>
__device__ __forceinline__ void gemm_phase(LAS unsigned char* lds, const Gemm g, const Order& S, const Epi& E, const int wvid) {
    int tid = TIDX; asm volatile("" : "+v"(tid));
    const int wid = __builtin_amdgcn_readfirstlane(tid >> 6), lane = tid & 63, wr = wid >> 2, wc = wid & 3, fr = lane & 15, fq = lane >> 4;
    const int K = g.K, nt = K / BK;
    unsigned voffA[2], voffB[2];
#pragma unroll
    for (int i = 0; i < 2; ++i) { int R, C; stage_rc(tid * 16 + i * 8192, R, C); const int Rb = Epi::PERM ? ((R & ~31) + perm32(R & 31)) : R;
        voffA[i] = (unsigned)(R * g.lda + C) * 2u; voffB[i] = (unsigned)(Rb * g.ldb + C) * 2u; }
    const size_t kstep = (size_t)(BK * 2);
    const size_t hstepA = (size_t)HALF * g.lda * 2, tstepA = 2 * hstepA;
    const size_t hstepB = (size_t)HALF * g.ldb * 2, tstepB = 2 * hstepB;
    const unsigned ldsw = (unsigned)wid * 1024u;
    const int aoff = lds_byte(wr * 64 + fr, fq * 8), boff = lds_byte(wc * 32 + fr, fq * 8);
#define PG8_SA(b, h) (((b) * 2 + (h)) * HTB)
#define PG8_SB(b, h) ((4 + (b) * 2 + (h)) * HTB)
#define PG8_STAGE(bufoff, gbase, voff) do { _Pragma("unroll") for (int _i = 0; _i < 2; ++_i) \
        __builtin_amdgcn_global_load_lds((const unsigned*)((const char*)(gbase) + (voff)[_i]), (LAS unsigned*)(lds + (bufoff) + ldsw + _i * 8192), 16, 0, 0); } while (0)
#define PG8_LDA(dst, b, h) do { _Pragma("unroll") for (int m = 0; m < 4; ++m) _Pragma("unroll") for (int k = 0; k < 2; ++k) dst[m][k] = *(const LAS bf16x8*)(lds + PG8_SA(b, h) + aoff + m * 2048 + k * 1024); } while (0)
#define PG8_LDB(dst, b, h) do { _Pragma("unroll") for (int n = 0; n < 2; ++n) _Pragma("unroll") for (int k = 0; k < 2; ++k) dst[n][k] = *(const LAS bf16x8*)(lds + PG8_SB(b, h) + boff + n * 2048 + k * 1024); } while (0)
#define PG8_MMA(ai, bj, At, Bt) do { __builtin_amdgcn_s_setprio(1); _Pragma("unroll") for (int m = 0; m < 4; ++m) _Pragma("unroll") for (int n = 0; n < 2; ++n) _Pragma("unroll") for (int k = 0; k < 2; ++k) \
        acc[ai][bj][m][n] = __builtin_amdgcn_mfma_f32_16x16x32_bf16(Bt[n][k], At[m][k], acc[ai][bj][m][n], 0, 0, 0); __builtin_amdgcn_s_setprio(0); } while (0)
#define PG8_WAIT_V(n) asm volatile("s_waitcnt vmcnt(" #n ")" ::: "memory")
#define PG8_WAIT_L(n) asm volatile("s_waitcnt lgkmcnt(" #n ")" ::: "memory")
#define PG8_BAR __builtin_amdgcn_s_barrier()
#define PG8_SCHED __builtin_amdgcn_sched_barrier(0)
    Unit cur, nxt; int ui = 0;
    if (!S.next(0, cur)) return;
    f32x4 acc[2][2][4][2];
#pragma unroll
    for (int a = 0; a < 2; ++a)
#pragma unroll
        for (int b = 0; b < 2; ++b)
#pragma unroll
            for (int m = 0; m < 4; ++m)
#pragma unroll
                for (int n = 0; n < 2; ++n) acc[a][b][m][n] = (f32x4){0.f, 0.f, 0.f, 0.f};
    bf16x8 At[4][2], B0[2][2], B1[2][2];
    const char* cA = (const char*)g.A + (size_t)cur.pm * tstepA + (size_t)cur.ka * 2; const char* cB = (const char*)g.Bt + (size_t)cur.pn * tstepB;
    PG8_STAGE(PG8_SB(0, 0), cB, voffB); PG8_STAGE(PG8_SB(0, 1), cB + hstepB, voffB); PG8_STAGE(PG8_SA(0, 0), cA, voffA); PG8_STAGE(PG8_SA(0, 1), cA + hstepA, voffA);
    if (wr == 1) PG8_BAR;
    PG8_WAIT_V(2); PG8_BAR;
    PG8_STAGE(PG8_SB(1, 0), cB + kstep, voffB); PG8_STAGE(PG8_SA(1, 0), cA + kstep, voffA); PG8_STAGE(PG8_SB(1, 1), cB + hstepB + kstep, voffB);
    PG8_WAIT_V(6); PG8_BAR;
    for (;;) {
        const bool has_next = S.next(ui + 1, nxt);
        const char* nA = has_next ? (const char*)g.A + (size_t)nxt.pm * tstepA + (size_t)nxt.ka * 2 : cA; const char* nB = has_next ? (const char*)g.Bt + (size_t)nxt.pn * tstepB : cB;
#pragma unroll 1
        for (int t = 0; t < nt; t += 2) {
            const bool last = (t == nt - 2);
            const char* a1 = cA + (size_t)(t + 1) * kstep;
            const char* a2 = last ? nA : cA + (size_t)(t + 2) * kstep; const char* b2 = last ? nB : cB + (size_t)(t + 2) * kstep;
            const char* a3 = a2 + kstep; const char* b3 = b2 + kstep;
            PG8_LDB(B0, 0, 0); PG8_LDB(B1, 0, 1); PG8_SCHED; PG8_LDA(At, 0, 0); PG8_STAGE(PG8_SA(1, 1), a1 + hstepA, voffA);
            PG8_WAIT_V(8); PG8_WAIT_L(0); PG8_BAR; PG8_MMA(0, 0, At, B0); PG8_MMA(0, 1, At, B1); PG8_BAR; PG8_SCHED;
            PG8_LDA(At, 0, 1); PG8_STAGE(PG8_SB(0, 0), b2, voffB); PG8_STAGE(PG8_SB(0, 1), b2 + hstepB, voffB); PG8_STAGE(PG8_SA(0, 0), a2, voffA);
            PG8_WAIT_V(8); PG8_WAIT_L(0); PG8_BAR; PG8_MMA(1, 0, At, B0); PG8_MMA(1, 1, At, B1); PG8_BAR; PG8_SCHED;
            PG8_LDB(B0, 1, 0); PG8_LDB(B1, 1, 1); PG8_SCHED; PG8_LDA(At, 1, 0); PG8_STAGE(PG8_SA(0, 1), a2 + hstepA, voffA);
            PG8_WAIT_V(8); PG8_WAIT_L(0); PG8_BAR; PG8_MMA(0, 0, At, B0); PG8_MMA(0, 1, At, B1); PG8_BAR; PG8_SCHED;
            PG8_LDA(At, 1, 1); PG8_STAGE(PG8_SB(1, 0), b3, voffB); PG8_STAGE(PG8_SB(1, 1), b3 + hstepB, voffB); PG8_STAGE(PG8_SA(1, 0), a3, voffA);
            PG8_WAIT_V(8); PG8_WAIT_L(0); PG8_BAR; PG8_MMA(1, 0, At, B0); PG8_MMA(1, 1, At, B1); PG8_BAR; PG8_SCHED;
        }
        if (wr == 0) PG8_BAR;
        { int fr2 = fr, fq2 = fq; asm volatile("" : "+v"(fr2), "+v"(fq2));
          E(acc, cur, wr, wc, fr2, fq2); }
        if (!has_next) break;
#pragma unroll
        for (int a = 0; a < 2; ++a)
#pragma unroll
            for (int b = 0; b < 2; ++b)
#pragma unroll
                for (int m = 0; m < 4; ++m)
#pragma unroll
                    for (int n = 0; n < 2; ++n) acc[a][b][m][n] = (f32x4){0.f, 0.f, 0.f, 0.f};
        cur = nxt; cA = nA; cB = nB; ++ui;
        if (wr == 1) PG8_BAR;
    }
    PG8_WAIT_V(0);
    PG8_BAR;
#undef PG8_SA
#undef PG8_SB
#undef PG8_STAGE
#undef PG8_LDA
#undef PG8_LDB
#undef PG8_MMA
#undef PG8_WAIT_V
#undef PG8_WAIT_L
#undef PG8_BAR
#undef PG8_SCHED
}
}
using pg8::Unit;

#define EPI_ARGS const f32x4 (&acc)[2][2][4][2], const Unit& u, int wr, int wc, int fr, int fq
struct EpiZ {
    static constexpr bool PERM = true;
    bf16_t* Z; float* out; int l;
    __device__ __forceinline__ void operator()(EPI_ARGS) const {
        const int pn = u.pn; bf16_t* base; int ld, ct; bool act;
        if (pn < 2) { base = Z; ld = 512; ct = pn * 256; act = false; }
        else if (pn < 6) { base = Z + UE; ld = 1024; ct = (pn - 2) * 256; act = false; }
        else if (pn < 10) { base = Z + 3 * UE; ld = 1024; ct = (pn - 6) * 256; act = true; }
        else if (pn < 12) { base = Z + 5 * UE; ld = 512; ct = (pn - 10) * 256; act = true; }
        else { base = Z + 6 * UE; ld = 512; ct = (pn - 12) * 256; act = true; }
        const bool st = (pn < 6) && (((u.pm & 7) == 7) || u.pm == 64);
#pragma unroll
        for (int ai = 0; ai < 2; ++ai)
#pragma unroll
            for (int m = 0; m < 4; ++m) {
                const int row = u.pm * 256 + ai * 128 + wr * 64 + m * 16 + fr;
#pragma unroll
                for (int bj = 0; bj < 2; ++bj) {
                    f32x4 v0 = acc[ai][bj][m][0], v1 = acc[ai][bj][m][1];
                    const int c = ct + bj * 128 + wc * 32 + 8 * fq;
                    if (st) {
                        float* o = nullptr;
                        if (row < MPR) { const int t = row & 2047, b = row >> 11;
                            if (pn < 2) { if (t >= 2033) o = out + O_POOL_P + ((size_t)(l * NB + b) * 15 + (t - 2033)) * DPOOL + c; }
                            else { if (t >= 2045) o = out + O_RC_P + ((size_t)(l * NB + b) * 3 + (t - 2045)) * DRNN + c; } }
                        else if (row < MROWS) { const int s = row - MPR;
                            if (pn < 2) o = out + O_POOL_S + ((size_t)(l * NS + s) * 15 + 14) * DPOOL + c;
                            else o = out + O_RC_S + ((size_t)(l * NS + s) * 3 + 2) * DRNN + c; }
                        if (o) { *(f32x4*)o = v0; *(f32x4*)(o + 4) = v1; }
                    }
                    if (act) { v0 = gelu4(v0); v1 = gelu4(v1); }
                    *(u32x4*)(base + (size_t)row * ld + c) = pack8(v0, v1);
                    asm volatile("" ::: "memory");
                }
            }
    }
    __device__ __forceinline__ void sample(int row, int col, f32x4 v) const {
        const int s = row - MPR; bf16_t* dst;
        if (col < 512) { dst = Z + (size_t)row * 512 + col; *(f32x4*)(out + O_POOL_S + ((size_t)(l * NS + s) * 15 + 14) * DPOOL + col) = v; }
        else if (col < 1536) { dst = Z + UE + (size_t)row * 1024 + (col - 512); *(f32x4*)(out + O_RC_S + ((size_t)(l * NS + s) * 3 + 2) * DRNN + (col - 512)) = v; }
        else if (col < 2560) { dst = Z + 3 * UE + (size_t)row * 1024 + (col - 1536); v = gelu4(v); }
        else if (col < 3072) { dst = Z + 5 * UE + (size_t)row * 512 + (col - 2560); v = gelu4(v); }
        else { dst = Z + 6 * UE + (size_t)row * 512 + (col - 3072); v = gelu4(v); }
        u32x2 w; w.x = pk2(v[0], v[1]); w.y = pk2(v[2], v[3]); *(u32x2*)dst = w;
    }
};
struct EpiRI {
    static constexpr bool PERM = true;
    const bf16_t* BC; bf16_t* LA; bf16_t* BV; const float* ba; const float* bx; const float* sp;
    __device__ __forceinline__ void operator()(EPI_ARGS) const {
        const int ch = u.pn * 128 + wc * 32 + 8 * fq;
        f32x4 bav[2], bxv[2], spv[2];
#pragma unroll
        for (int n = 0; n < 2; ++n) { bav[n] = *(const f32x4*)(ba + ch + 4 * n); bxv[n] = *(const f32x4*)(bx + ch + 4 * n); spv[n] = *(const f32x4*)(sp + ch + 4 * n); }
#pragma unroll
        for (int ai = 0; ai < 2; ++ai) {
            u32x4 xw[4];
#pragma unroll
            for (int m = 0; m < 4; ++m) xw[m] = *(const u32x4*)(BC + (size_t)(u.pm * 256 + ai * 128 + wr * 64 + m * 16 + fr) * DRNN + ch);
#pragma unroll
            for (int m = 0; m < 4; ++m) {
                const int row = u.pm * 256 + ai * 128 + wr * 64 + m * 16 + fr;
                const F8 xc8 = unpack8(xw[m]); f32x4 lav[2], bv[2];
#pragma unroll
                for (int n = 0; n < 2; ++n) {
                    const f32x4 xc = n ? xc8.b : xc8.a;
                    const f32x4 r0 = sigm4(acc[ai][0][m][n] + bav[n]), i0 = sigm4(acc[ai][1][m][n] + bxv[n]);
                    lav[n] = r0 * spv[n];
#pragma unroll
                    for (int j = 0; j < 4; ++j) { const float x = -2.f * lav[n][j];
                        const float em = x < 0.03f ? x * (1.f - x * (0.5f - x * (0.16666667f - x * 0.041666668f))) : 1.f - __expf(-x);
                        bv[n][j] = __builtin_sqrtf(em) * i0[j] * xc[j]; }
                }
                *(u32x4*)(LA + (size_t)row * DRNN + ch) = pack8(lav[0], lav[1]);
                *(u32x4*)(BV + (size_t)row * DRNN + ch) = pack8(bv[0], bv[1]);
            }
            asm volatile("" ::: "memory");
        }
    }
    __device__ __forceinline__ void sample2(int row, int ch, f32x4 vr, f32x4 vi) const {
        const f32x4 ba0 = *(const f32x4*)(ba + ch), bx0 = *(const f32x4*)(bx + ch), sp0 = *(const f32x4*)(sp + ch);
        const u32x2 xw = *(const u32x2*)(BC + (size_t)row * DRNN + ch);
        const f32x4 xc = (f32x4){bf_lo(xw.x), bf_hi(xw.x), bf_lo(xw.y), bf_hi(xw.y)};
        const f32x4 r0 = sigm4(vr + ba0), i0 = sigm4(vi + bx0), la0 = r0 * sp0; f32x4 b0;
#pragma unroll
        for (int j = 0; j < 4; ++j) { const float x = -2.f * la0[j];
            const float em = x < 0.03f ? x * (1.f - x * (0.5f - x * (0.16666667f - x * 0.041666668f))) : 1.f - __expf(-x);
            b0[j] = __builtin_sqrtf(em) * i0[j] * xc[j]; }
        u32x2 wl, wb; wl.x = pk2(la0[0], la0[1]); wl.y = pk2(la0[2], la0[3]); wb.x = pk2(b0[0], b0[1]); wb.y = pk2(b0[2], b0[3]);
        *(u32x2*)(LA + (size_t)row * DRNN + ch) = wl; *(u32x2*)(BV + (size_t)row * DRNN + ch) = wb;
    }
};
struct EpiG {
    static constexpr bool PERM = true;
    bf16_t* G;
    __device__ __forceinline__ void operator()(EPI_ARGS) const {
#pragma unroll
        for (int ai = 0; ai < 2; ++ai)
#pragma unroll
            for (int m = 0; m < 4; ++m) {
                const int row = u.pm * 256 + ai * 128 + wr * 64 + m * 16 + fr;
#pragma unroll
                for (int bj = 0; bj < 2; ++bj) {
                    const int c = u.pn * 256 + bj * 128 + wc * 32 + 8 * fq;
                    *(u32x4*)(G + (size_t)row * 3072 + c) = pack8(sigm4(acc[ai][bj][m][0]), sigm4(acc[ai][bj][m][1]));
                    asm volatile("" ::: "memory");
                }
            }
    }
    __device__ __forceinline__ void sample(int row, int col, f32x4 v) const {
        v = sigm4(v); u32x2 w; w.x = pk2(v[0], v[1]); w.y = pk2(v[2], v[3]); *(u32x2*)(G + (size_t)row * 3072 + col) = w;
    }
};
struct EpiP {
    static constexpr bool PERM = true;
    const bf16_t* G; bf16_t* M; int goff; int first;
    __device__ __forceinline__ void operator()(EPI_ARGS) const {
#pragma unroll
        for (int ai = 0; ai < 2; ++ai)
#pragma unroll
            for (int bj = 0; bj < 2; ++bj) {
                const int c = u.pn * 256 + bj * 128 + wc * 32 + 8 * fq;
                u32x4 gw[4], ow[4];
#pragma unroll
                for (int m = 0; m < 4; ++m) { const int row = u.pm * 256 + ai * 128 + wr * 64 + m * 16 + fr;
                    gw[m] = *(const u32x4*)(G + (size_t)row * 3072 + goff + c);
                    if (!first) ow[m] = *(const u32x4*)(M + (size_t)row * DM + c); }
#pragma unroll
                for (int m = 0; m < 4; ++m) { const int row = u.pm * 256 + ai * 128 + wr * 64 + m * 16 + fr;
                    const F8 gt = unpack8(gw[m]);
                    f32x4 o0 = gt.a * acc[ai][bj][m][0], o1 = gt.b * acc[ai][bj][m][1];
                    if (!first) { const F8 old = unpack8(ow[m]); o0 += old.a; o1 += old.b; }
                    *(u32x4*)(M + (size_t)row * DM + c) = pack8(o0, o1); }
                asm volatile("" ::: "memory");
            }
    }
    __device__ __forceinline__ void sample(int row, int col, f32x4 v) const {
        const u32x2 g = *(const u32x2*)(G + (size_t)row * 3072 + goff + col); u32x2* mp = (u32x2*)(M + (size_t)row * DM + col);
        f32x4 o = (f32x4){bf_lo(g.x) * v[0], bf_hi(g.x) * v[1], bf_lo(g.y) * v[2], bf_hi(g.y) * v[3]};
        if (!first) { const u32x2 old = *mp; o += (f32x4){bf_lo(old.x), bf_hi(old.x), bf_lo(old.y), bf_hi(old.y)}; }
        u32x2 w; w.x = pk2(o[0], o[1]); w.y = pk2(o[2], o[3]); *mp = w;
    }
};
struct EpiX {
    static constexpr bool PERM = false;
    const float* xin_p; const float* xin_s; float* xout;
    __device__ __forceinline__ void operator()(EPI_ARGS) const {
#pragma unroll
        for (int ai = 0; ai < 2; ++ai)
#pragma unroll
            for (int mp = 0; mp < 2; ++mp) {
                f32x4 xv[2][2][2];
#pragma unroll
                for (int mm = 0; mm < 2; ++mm) { const int row = u.pm * 256 + ai * 128 + wr * 64 + (2 * mp + mm) * 16 + fr; const float* src = xin_p + (size_t)row * DM;
#pragma unroll
                    for (int bj = 0; bj < 2; ++bj)
#pragma unroll
                        for (int n = 0; n < 2; ++n) xv[mm][bj][n] = *(const f32x4*)(src + u.pn * 256 + bj * 128 + wc * 32 + 16 * n + 4 * fq); }
#pragma unroll
                for (int mm = 0; mm < 2; ++mm) { const int row = u.pm * 256 + ai * 128 + wr * 64 + (2 * mp + mm) * 16 + fr; float* dst = xout + (size_t)row * DM;
#pragma unroll
                    for (int bj = 0; bj < 2; ++bj)
#pragma unroll
                        for (int n = 0; n < 2; ++n) *(f32x4*)(dst + u.pn * 256 + bj * 128 + wc * 32 + 16 * n + 4 * fq) = xv[mm][bj][n] + acc[ai][bj][2 * mp + mm][n]; }
                asm volatile("" ::: "memory");
            }
    }
    __device__ __forceinline__ void sample(int row, int col, f32x4 v) const {
        *(f32x4*)(xout + (size_t)row * DM + col) = *(const f32x4*)(xin_s + (size_t)(row - MPR) * DM + col) + v;
    }
};
struct EpiGpre {
    static constexpr bool PERM = true;
    bf16_t* GP; float* out; int l;
    __device__ __forceinline__ void operator()(EPI_ARGS) const {
        const bool st = ((u.pm & 7) == 7) || u.pm == 64;
#pragma unroll
        for (int ai = 0; ai < 2; ++ai)
#pragma unroll
            for (int m = 0; m < 4; ++m) {
                const int row = u.pm * 256 + ai * 128 + wr * 64 + m * 16 + fr;
#pragma unroll
                for (int bj = 0; bj < 2; ++bj) {
                    const f32x4 v0 = acc[ai][bj][m][0], v1 = acc[ai][bj][m][1];
                    const int c = u.pn * 256 + bj * 128 + wc * 32 + 8 * fq;
                    if (st) {
                        float* o = nullptr;
                        if (row < MPR) { const int t = row & 2047, b = row >> 11; if (t >= 2046) o = out + O_FF_P + ((size_t)(l * NB + b) * 2 + (t - 2046)) * DFF + c; }
                        else if (row < MROWS) { const int s = row - MPR; o = out + O_FF_S + ((size_t)(l * NS + s) * 2 + 1) * DFF + c; }
                        if (o) { *(f32x4*)o = v0; *(f32x4*)(o + 4) = v1; }
                    }
                    *(u32x4*)(GP + (size_t)row * 3072 + c) = pack8(v0, v1);
                    asm volatile("" ::: "memory");
                }
            }
    }
    __device__ __forceinline__ void sample(int row, int col, f32x4 v) const {
        *(f32x4*)(out + O_FF_S + ((size_t)(l * NS + (row - MPR)) * 2 + 1) * DFF + col) = v;
        u32x2 w; w.x = pk2(v[0], v[1]); w.y = pk2(v[2], v[3]); *(u32x2*)(GP + (size_t)row * 3072 + col) = w;
    }
};
struct EpiH {
    static constexpr bool PERM = true;
    const bf16_t* GP; bf16_t* H; const float* cw; const float* cb; const float* st;
    __device__ __forceinline__ void operator()(EPI_ARGS) const {
#pragma unroll
        for (int bj = 0; bj < 2; ++bj) {
            const int c = u.pn * 256 + bj * 128 + wc * 32 + 8 * fq;
            const f32x4 w00 = *(const f32x4*)(cw + c), w01 = *(const f32x4*)(cw + c + 4);
            const f32x4 w10 = *(const f32x4*)(cw + DFF + c), w11 = *(const f32x4*)(cw + DFF + c + 4);
            const f32x4 w20 = *(const f32x4*)(cw + 2 * DFF + c), w21 = *(const f32x4*)(cw + 2 * DFF + c + 4);
            const f32x4 cb0 = *(const f32x4*)(cb + c), cb1 = *(const f32x4*)(cb + c + 4);
#pragma unroll
            for (int ai = 0; ai < 2; ++ai) {
                const int base = u.pm * 256 + ai * 128 + wr * 64, t0 = base & 2047;
                u32x4 q0[4], E = (u32x4){0u, 0u, 0u, 0u};
#pragma unroll
                for (int m = 0; m < 4; ++m) q0[m] = *(const u32x4*)(GP + (size_t)(base + 16 * m + fr) * 3072 + c);
                if (fr >= 14 && t0 != 0) E = *(const u32x4*)(GP + (size_t)(base - 16 + fr) * 3072 + c);
#pragma unroll
                for (int m = 0; m < 4; ++m) { const int row = base + 16 * m + fr, t = row & 2047;
                    const u32x4 P = m ? q0[m > 0 ? m - 1 : 0] : E; u32x4 r1, r2;
                    r1.x = dpp_shr1(dpp_ror1(P.x), q0[m].x); r1.y = dpp_shr1(dpp_ror1(P.y), q0[m].y); r1.z = dpp_shr1(dpp_ror1(P.z), q0[m].z); r1.w = dpp_shr1(dpp_ror1(P.w), q0[m].w);
                    r2.x = dpp_shr2(dpp_ror2(P.x), q0[m].x); r2.y = dpp_shr2(dpp_ror2(P.y), q0[m].y); r2.z = dpp_shr2(dpp_ror2(P.z), q0[m].z); r2.w = dpp_shr2(dpp_ror2(P.w), q0[m].w);
                    const F8 g0 = unpack8(q0[m]), g1 = unpack8(r1), g2 = unpack8(r2);
                    const float k1 = t >= 1 ? 1.f : 0.f, k2 = t >= 2 ? 1.f : 0.f;
                    const f32x4 s0 = cb0 + w20 * g0.a + (w10 * g1.a) * k1 + (w00 * g2.a) * k2, s1 = cb1 + w21 * g0.b + (w11 * g1.b) * k1 + (w01 * g2.b) * k2;
                    *(u32x4*)(H + (size_t)row * 3072 + c) = pack8(gelu4(s0) * acc[ai][bj][m][0], gelu4(s1) * acc[ai][bj][m][1]); }
                asm volatile("" ::: "memory");
            }
        }
    }
    __device__ __forceinline__ void sample(int row, int col, f32x4 v) const {
        const u32x2 gw = *(const u32x2*)(GP + (size_t)row * 3072 + col); const f32x4 g0 = (f32x4){bf_lo(gw.x), bf_hi(gw.x), bf_lo(gw.y), bf_hi(gw.y)};
        const float* sp = st + (size_t)(row - MPR) * 2 * DFF + col;
        const f32x4 s0 = *(const f32x4*)(cb + col) + *(const f32x4*)(cw + 2 * DFF + col) * g0 + *(const f32x4*)(cw + col) * *(const f32x4*)sp + *(const f32x4*)(cw + DFF + col) * *(const f32x4*)(sp + DFF);
        const f32x4 h = gelu4(s0) * v; u32x2 w; w.x = pk2(h[0], h[1]); w.y = pk2(h[2], h[3]); *(u32x2*)(H + (size_t)row * 3072 + col) = w;
    }
};

template <bool DUAL, class Epi>
__device__ __forceinline__ void sample_gemm(LAS unsigned char* lds, const bf16_t* A, int lda, const bf16_t* Bt, int ldb, int K, int nstrips, int bid, int G, const Epi& E, const int wvid) {
    int tid = TIDX; asm volatile("" : "+v"(tid));
    const int kw = __builtin_amdgcn_readfirstlane(tid >> 6), lane = tid & 63, fr = lane & 15, fq = lane >> 4;
    const int kslice = K >> 3, nks = kslice >> 5;
    LAS f32x4* part = (LAS f32x4*)lds;
    for (int strip = G - 1 - bid; strip < nstrips; strip += G) {
        int n0 = strip * 16, acol = 0, h = 0, cc = 0;
        if (DUAL) { h = strip >> 3; cc = (strip & 7) * 16; n0 = h * 256 + cc; acol = (h & ~1) * 128; }
        f32x4 acc[8], acc2[8];
#pragma unroll
        for (int m = 0; m < 8; ++m) { acc[m] = (f32x4){0.f, 0.f, 0.f, 0.f}; acc2[m] = acc[m]; }
        typedef const __attribute__((address_space(1))) bf16x8* gfrag;
        const bf16_t* bp = Bt + (size_t)(n0 + fr) * ldb + kw * kslice + 8 * fq;
        const bf16_t* ap = A + (size_t)fr * lda + acol + kw * kslice + 8 * fq;
#pragma unroll 1
        for (int ks0 = 0; ks0 < nks; ks0 += 2) {
            bf16x8 bb[2], bb2[2], aa[2][8];
#pragma unroll
            for (int u = 0; u < 2; ++u) if (ks0 + u < nks) {
                bb[u] = *(gfrag)(bp + (ks0 + u) * 32);
                if (DUAL) bb2[u] = *(gfrag)(bp + (size_t)128 * ldb + (ks0 + u) * 32);
#pragma unroll
                for (int m = 0; m < 8; ++m) aa[u][m] = *(gfrag)(ap + (size_t)(16 * m) * lda + (ks0 + u) * 32);
            }
            __builtin_amdgcn_sched_barrier(0);
#pragma unroll
            for (int u = 0; u < 2; ++u) if (ks0 + u < nks) {
#pragma unroll
                for (int m = 0; m < 8; ++m) { acc[m] = __builtin_amdgcn_mfma_f32_16x16x32_bf16(bb[u], aa[u][m], acc[m], 0, 0, 0);
                    if (DUAL) acc2[m] = __builtin_amdgcn_mfma_f32_16x16x32_bf16(bb2[u], aa[u][m], acc2[m], 0, 0, 0); }
            }
            __builtin_amdgcn_sched_barrier(0);
        }
#pragma unroll
        for (int m = 0; m < 8; ++m) part[(kw * 8 + m) * 64 + lane] = acc[m];
        __syncthreads();
        f32x4 v = part[kw * 64 + lane];
#pragma unroll
        for (int k2 = 1; k2 < 8; ++k2) v += part[(k2 * 8 + kw) * 64 + lane];
        const int row = MPR + 16 * kw + fr;
        if constexpr (DUAL) {
            __syncthreads();
#pragma unroll
            for (int m = 0; m < 8; ++m) part[(kw * 8 + m) * 64 + lane] = acc2[m];
            __syncthreads();
            f32x4 v2 = part[kw * 64 + lane];
#pragma unroll
            for (int k2 = 1; k2 < 8; ++k2) v2 += part[(k2 * 8 + kw) * 64 + lane];
            E.sample2(row, h * 128 + cc + 4 * fq, v, v2);
        } else E.sample(row, n0 + 4 * fq, v);
        __syncthreads();
    }
}


__device__ __forceinline__ void transpose_item(const float* W, int K, int N, bf16_t* WT, LAS float* scr, int item, int lane) {
    const int nblk = N / 32, kb = item / nblk, nb = item % nblk, k0 = 64 * kb, n0 = 32 * nb;
    float tv[32];
#pragma unroll
    for (int i = 0; i < 32; ++i) tv[i] = W[(size_t)(k0 + 2 * i + (lane >> 5)) * N + n0 + (lane & 31)];
#pragma unroll
    for (int i = 0; i < 32; ++i) scr[(2 * i + (lane >> 5)) * 33 + (lane & 31)] = tv[i];
    asm volatile("s_waitcnt lgkmcnt(0)" ::: "memory");
    const int c = lane & 7;
#pragma unroll
    for (int j = 0; j < 4; ++j) { const int n = (lane >> 3) + 8 * j; const LAS float* s = scr + (8 * c) * 33 + n;
        u32x4 o; o.x = pk2(s[0 * 33], s[1 * 33]); o.y = pk2(s[2 * 33], s[3 * 33]); o.z = pk2(s[4 * 33], s[5 * 33]); o.w = pk2(s[6 * 33], s[7 * 33]);
        *(u32x4*)(WT + (size_t)(n0 + n) * K + k0 + 8 * c) = o; }
    asm volatile("s_waitcnt lgkmcnt(0)" ::: "memory");
}
__device__ __forceinline__ void rms_row_bf16(const float* xrow, const float* g, bf16_t* orow, int lane) {
    const f32x4* xr = (const f32x4*)xrow + lane; f32x4 v[4]; float s = 0.f;
#pragma unroll
    for (int j = 0; j < 4; ++j) { v[j] = xr[64 * j]; s += (v[j][0] * v[j][0] + v[j][1] * v[j][1]) + (v[j][2] * v[j][2] + v[j][3] * v[j][3]); }
    const float rstd = rsqrtf(wave_sum(s) * (1.f / DM) + 1e-6f);
    const f32x4* gr = (const f32x4*)g + lane; u32x2* o8 = (u32x2*)orow + lane;
#pragma unroll
    for (int j = 0; j < 4; ++j) { const f32x4 o = v[j] * rstd * gr[64 * j]; u32x2 w; w.x = pk2(o[0], o[1]); w.y = pk2(o[2], o[3]); o8[64 * j] = w; }
}
__device__ __forceinline__ void rms_rows(const float* xp, const float* xs, const float* g, bf16_t* XN, int gw, int ngw, int lane) {
    for (int row = gw; row < MPAD; row += ngw) {
        if (row < MROWS) rms_row_bf16(row < MPR ? xp + (size_t)row * DM : xs + (size_t)(row - MPR) * DM, g, XN + (size_t)row * DM, lane);
        else { u32x2* o8 = (u32x2*)(XN + (size_t)row * DM) + lane; u32x2 z; z.x = 0u; z.y = 0u;
#pragma unroll
            for (int j = 0; j < 4; ++j) o8[64 * j] = z; }
    }
}

__device__ __forceinline__ void phase_prep(const Params& p, int l, LAS unsigned char* lds, const float* xp, const float* xs, int bid, int G, const int wvid) {
    int tid = TIDX; asm volatile("" : "+v"(tid));
    const int wave = tid >> 6, lane = tid & 63;
    const int gw = bid * 8 + wave, ngw = G * 8;
    bf16_t* W = (bf16_t*)(p.ws + WS_W);
    LAS float* scr = (LAS float*)(lds + wave * 8448);
    const float* w_in = p.in[7] + (size_t)l * DM * INCOLS; const float* w_pb = p.in[21] + (size_t)l * DRNN * DM; const float* w_pc = p.in[22] + (size_t)l * DCH * DM;
    const float* w_o = p.in[23] + (size_t)l * DM * DM; const float* wg = p.in[25] + (size_t)l * DM * DFF; const float* wu = p.in[26] + (size_t)l * DM * DFF; const float* wd = p.in[29] + (size_t)l * DFF * DM;
    constexpr int I_IN = (DM / 64) * (INCOLS / 32), I_PB = (DRNN / 64) * (DM / 32), I_PC = (DCH / 64) * (DM / 32), I_O = (DM / 64) * (DM / 32), I_G = (DM / 64) * (DFF / 32), I_D = (DFF / 64) * (DM / 32);
    constexpr int NITEMS = I_IN + I_PB + I_PC + I_O + 2 * I_G + I_D;
    for (int it = gw; it < NITEMS; it += ngw) {
        int r = it;
        if (r < I_IN) { transpose_item(w_in, DM, INCOLS, W + W_IN, scr, r, lane); continue; } r -= I_IN;
        if (r < I_PB) { transpose_item(w_pb, DRNN, DM, W + W_PB, scr, r, lane); continue; } r -= I_PB;
        if (r < I_PC) { transpose_item(w_pc, DCH, DM, W + W_PC, scr, r, lane); continue; } r -= I_PC;
        if (r < I_O) { transpose_item(w_o, DM, DM, W + W_O, scr, r, lane); continue; } r -= I_O;
        if (r < I_G) { transpose_item(wg, DM, DFF, W + W_G, scr, r, lane); continue; } r -= I_G;
        if (r < I_G) { transpose_item(wu, DM, DFF, W + W_U, scr, r, lane); continue; } r -= I_G;
        transpose_item(wd, DFF, DM, W + W_D, scr, r, lane);
    }
    const int gt = bid * 512 + tid, ngt = G * 512;
    { const float* pw = p.in[8] + (size_t)l * 4 * 128 * 128; const float* ps = p.in[9] + (size_t)l * DPOOL; const float* w_pa = p.in[20] + (size_t)l * DPOOL * DM;
      for (int idx = gt; idx < DPOOL * (DM / 4); idx += ngt) { const int n = (idx & 255) * 4, kp = idx >> 8, g = kp >> 7;
          const float* pr = pw + (size_t)kp * 128; const float* sr = ps + g * 128; const float* wr_ = w_pa + (size_t)g * 128 * DM + n; f32x4 s4 = (f32x4){0.f, 0.f, 0.f, 0.f};
#pragma unroll 16
          for (int j = 0; j < 128; ++j) s4 += (pr[j] * sr[j]) * *(const f32x4*)(wr_ + (size_t)j * DM);
          W[W_PA + (size_t)n * DPOOL + kp] = f2bf(s4[0]); W[W_PA + (size_t)(n + 1) * DPOOL + kp] = f2bf(s4[1]);
          W[W_PA + (size_t)(n + 2) * DPOOL + kp] = f2bf(s4[2]); W[W_PA + (size_t)(n + 3) * DPOOL + kp] = f2bf(s4[3]); } }
    { const float* wa = p.in[12] + (size_t)l * 8 * 128 * 128; const float* wx = p.in[14] + (size_t)l * 8 * 128 * 128;
      for (int idx = gt; idx < 8 * 256 * 256; idx += ngt) { const int k = idx & 255, n = (idx >> 8) & 255, h = idx >> 16; float v = 0.f;
          if ((k >> 7) == (h & 1)) v = (n < 128 ? wa : wx)[((size_t)h * 128 + (k & 127)) * 128 + (n & 127)];
          W[W_RI + idx] = f2bf(v); } }
    if (gt < DRNN) { const float y = __expf(-p.in[16][(size_t)l * DRNN + gt]);
        const float lp = y < 0.05f ? y * (1.f - y * (0.5f - y * (0.33333334f - y * (0.25f - y * 0.2f)))) : __logf(1.f + y);
        ((float*)(p.ws + WS_SP))[gt] = -8.f * lp; }
    rms_rows(xp, xs, p.in[6] + (size_t)l * DM, (bf16_t*)(p.ws + WS_XN), gw, ngw, lane);
}

__device__ __forceinline__ void phase_mix(const Params& p, int l, LAS unsigned char* lds, int bid, int G, const int wvid) {
    int tid = TIDX; asm volatile("" : "+v"(tid));
    const int wave = tid >> 6, lane = tid & 63;
    const bf16_t* Za = (const bf16_t*)(p.ws + WS_Z); const bf16_t* Zbx = Za + UE; const bf16_t* Zgu = Za + 5 * UE; const bf16_t* Zgv = Za + 6 * UE;
    bf16_t* Y0 = (bf16_t*)(p.ws + WS_Y); bf16_t* Yd = Y0 + 2 * UE; bf16_t* Yc = Y0 + 3 * UE;
    const float* vg = p.in[17] + (size_t)l * DCH; const float* cws = p.in[18] + (size_t)l * 4 * 128 * 128; const float* cbs = p.in[19] + (size_t)l * 4 * 128;
    if (bid < 128) {
        const int r0 = bid * 128;
        LAS float* rstd = (LAS float*)lds; LAS bf16_t* VT = (LAS bf16_t*)(lds + 1024);
        { const int j = tid >> 2, q = tid & 3; const u32x4* src = (const u32x4*)(Zgv + (size_t)(r0 + j) * DCH + q * 128); float s = 0.f;
#pragma unroll
          for (int i = 0; i < 16; ++i) { const F8 v = unpack8(src[i]); s += (v.a[0] * v.a[0] + v.a[1] * v.a[1]) + (v.a[2] * v.a[2] + v.a[3] * v.a[3]) + (v.b[0] * v.b[0] + v.b[1] * v.b[1]) + (v.b[2] * v.b[2] + v.b[3] * v.b[3]); }
          s += __shfl_xor(s, 1); s += __shfl_xor(s, 2);
          if (q == 0) rstd[j] = rsqrtf(s * (1.f / DCH) + 1e-6f); }
        __syncthreads();
        const int fr = lane & 15, fq = lane >> 4;
        for (int g = 0; g < 4; ++g) {
            { const int j = tid >> 2, q = tid & 3; const float rs = rstd[j];
              const u32x4* src = (const u32x4*)(Zgv + (size_t)(r0 + j) * DCH + g * 128 + q * 32); const float* gg = vg + g * 128 + q * 32;
#pragma unroll
              for (int i = 0; i < 4; ++i) { const F8 v = unpack8(src[i]); const f32x4 g0 = *(const f32x4*)(gg + 8 * i), g1 = *(const f32x4*)(gg + 8 * i + 4);
                  const int d = q * 32 + 8 * i;
#pragma unroll
                  for (int e = 0; e < 4; ++e) { VT[(d + e) * 136 + j] = f2bf(v.a[e] * rs * g0[e]); VT[(d + 4 + e) * 136 + j] = f2bf(v.b[e] * rs * g1[e]); } } }
            __syncthreads();
            const int i = 16 * wave + fr; bf16x8 af[4];
#pragma unroll
            for (int ks = 0; ks < 4; ++ks) { const int k0 = 32 * ks + 8 * fq; const float* wrow = cws + ((size_t)g * 128 + i) * 128 + k0;
                const f32x4 a0 = *(const f32x4*)wrow, a1 = *(const f32x4*)(wrow + 4); u32x4 w;
                w.x = pk2(k0 + 0 <= i ? a0[0] : 0.f, k0 + 1 <= i ? a0[1] : 0.f); w.y = pk2(k0 + 2 <= i ? a0[2] : 0.f, k0 + 3 <= i ? a0[3] : 0.f);
                w.z = pk2(k0 + 4 <= i ? a1[0] : 0.f, k0 + 5 <= i ? a1[1] : 0.f); w.w = pk2(k0 + 6 <= i ? a1[2] : 0.f, k0 + 7 <= i ? a1[3] : 0.f);
                af[ks] = __builtin_bit_cast(bf16x8, w); }
            const float bsv = cbs[g * 128 + i];
#pragma unroll
            for (int dt = 0; dt < 8; ++dt) {
                f32x4 c4 = (f32x4){0.f, 0.f, 0.f, 0.f};
#pragma unroll
                for (int ks = 0; ks < 4; ++ks) { const bf16x8 vf = *(const LAS bf16x8*)(VT + (16 * dt + fr) * 136 + 32 * ks + 8 * fq);
                    c4 = __builtin_amdgcn_mfma_f32_16x16x32_bf16(vf, af[ks], c4, 0, 0, 0); }
                const size_t off = (size_t)(r0 + i) * DCH + g * 128 + 16 * dt + 4 * fq;
                const u32x2 uu = *(const u32x2*)(Zgu + off); u32x2 o;
                o.x = pk2(bf_lo(uu.x) * (c4[0] + bsv), bf_hi(uu.x) * (c4[1] + bsv)); o.y = pk2(bf_lo(uu.y) * (c4[2] + bsv), bf_hi(uu.y) * (c4[3] + bsv));
                *(u32x2*)(Yc + off) = o;
            }
            __syncthreads();
        }
    } else if (bid < 144) {
        const int s = (bid - 128) * 8 + wave, row = MPR + s, c = lane * 8, g = lane >> 4;
        const F8 v = unpack8(*(const u32x4*)(Zgv + (size_t)row * DCH + c));
        float ss = (v.a[0] * v.a[0] + v.a[1] * v.a[1]) + (v.a[2] * v.a[2] + v.a[3] * v.a[3]) + (v.b[0] * v.b[0] + v.b[1] * v.b[1]) + (v.b[2] * v.b[2] + v.b[3] * v.b[3]);
        const float rs = rsqrtf(wave_sum(ss) * (1.f / DCH) + 1e-6f);
        const f32x4 vn0 = v.a * rs * *(const f32x4*)(vg + c), vn1 = v.b * rs * *(const f32x4*)(vg + c + 4);
        float* ov = p.out + O_CV_S + ((size_t)l * NS + s) * DCH + c; *(f32x4*)ov = vn0; *(f32x4*)(ov + 4) = vn1;
        const float w00 = cws[(size_t)g * 128 * 128], b0 = cbs[g * 128];
        const F8 uu = unpack8(*(const u32x4*)(Zgu + (size_t)row * DCH + c));
        *(u32x4*)(Yc + (size_t)row * DCH + c) = pack8(uu.a * (vn0 * w00 + b0), uu.b * (vn1 * w00 + b0));
    }
    if (bid >= 128) {
    const int et = (bid - 128) * 512 + tid, net = (G - 128) * 512;
    { const float* cw = p.in[10] + (size_t)l * 4 * DRNN; const float* cb = p.in[11] + (size_t)l * DRNN; const float* st = p.in[3] + (size_t)l * NS * 3 * DRNN;
      for (int idx = et; idx < (MPR / 8) * 128; idx += net) { const int r0 = (idx >> 7) * 8, c = (idx & 127) * 8, t0 = r0 & 2047;
          const f32x4 w00 = *(const f32x4*)(cw + c), w01 = *(const f32x4*)(cw + c + 4), w10 = *(const f32x4*)(cw + DRNN + c), w11 = *(const f32x4*)(cw + DRNN + c + 4);
          const f32x4 w20 = *(const f32x4*)(cw + 2 * DRNN + c), w21 = *(const f32x4*)(cw + 2 * DRNN + c + 4), w30 = *(const f32x4*)(cw + 3 * DRNN + c), w31 = *(const f32x4*)(cw + 3 * DRNN + c + 4);
          const f32x4 b0 = *(const f32x4*)(cb + c), b1 = *(const f32x4*)(cb + c + 4);
          F8 x1, x2, x3; const u32x4 zz = (u32x4){0u, 0u, 0u, 0u};
          x3 = unpack8(t0 >= 3 ? *(const u32x4*)(Zbx + (size_t)(r0 - 3) * DRNN + c) : zz); x2 = unpack8(t0 >= 2 ? *(const u32x4*)(Zbx + (size_t)(r0 - 2) * DRNN + c) : zz); x1 = unpack8(t0 >= 1 ? *(const u32x4*)(Zbx + (size_t)(r0 - 1) * DRNN + c) : zz);
#pragma unroll
          for (int i = 0; i < 8; ++i) { const F8 x0 = unpack8(*(const u32x4*)(Zbx + (size_t)(r0 + i) * DRNN + c));
              *(u32x4*)(Y0 + (size_t)(r0 + i) * DRNN + c) = pack8(b0 + w30 * x0.a + w20 * x1.a + w10 * x2.a + w00 * x3.a, b1 + w31 * x0.b + w21 * x1.b + w11 * x2.b + w01 * x3.b);
              x3 = x2; x2 = x1; x1 = x0; } }
      for (int idx = et; idx < NS * 128; idx += net) { const int row = MPR + (idx >> 7), c = (idx & 127) * 8;
          f32x4 s0 = *(const f32x4*)(cb + c), s1 = *(const f32x4*)(cb + c + 4);
          { const F8 x = unpack8(*(const u32x4*)(Zbx + (size_t)row * DRNN + c)); s0 += *(const f32x4*)(cw + 3 * DRNN + c) * x.a; s1 += *(const f32x4*)(cw + 3 * DRNN + c + 4) * x.b; }
          const float* sp = st + (size_t)(row - MPR) * 3 * DRNN + c;
#pragma unroll
          for (int k = 0; k < 3; ++k) { s0 += *(const f32x4*)(cw + k * DRNN + c) * *(const f32x4*)(sp + k * DRNN); s1 += *(const f32x4*)(cw + k * DRNN + c + 4) * *(const f32x4*)(sp + k * DRNN + 4); }
          *(u32x4*)(Y0 + (size_t)row * DRNN + c) = pack8(s0, s1); } }
    { const float* st = p.in[2] + (size_t)l * NS * 15 * DPOOL;
      for (int idx = et; idx < (MPR / 8) * 64; idx += net) { const int g = (idx >> 6) & 3, rb = ((idx >> 8) << 2) + ((idx >> 4) & 3), c = g * 128 + (idx & 15) * 8, w = 2 << g, r0 = rb * 8, t0 = r0 & 2047;
          f32x4 s0 = (f32x4){0.f, 0.f, 0.f, 0.f}, s1 = s0;
#pragma unroll
          for (int j = 1; j < 16; ++j) if (j < w && t0 >= j) { const F8 x = unpack8(*(const u32x4*)(Za + (size_t)(r0 - j) * DPOOL + c)); s0 += x.a; s1 += x.b; }
#pragma unroll
          for (int i = 0; i < 8; ++i) { const F8 cur = unpack8(*(const u32x4*)(Za + (size_t)(r0 + i) * DPOOL + c)); s0 += cur.a; s1 += cur.b;
              const int t = t0 + i; const float ic = 1.f / (float)(t + 1 < w ? t + 1 : w);
              *(u32x4*)(Yd + (size_t)(r0 + i) * DPOOL + c) = pack8(s0 * ic - cur.a, s1 * ic - cur.b);
              if (t >= w - 1) { const F8 old = unpack8(*(const u32x4*)(Za + (size_t)(r0 + i - (w - 1)) * DPOOL + c)); s0 -= old.a; s1 -= old.b; } } }
      for (int idx = et; idx < NS * 64; idx += net) { const int row = MPR + (idx >> 6), c = (idx & 63) * 8, w = 2 << (c >> 7);
          const F8 cur = unpack8(*(const u32x4*)(Za + (size_t)row * DPOOL + c)); f32x4 s0 = cur.a, s1 = cur.b;
          const float* sp = st + (size_t)(row - MPR) * 15 * DPOOL + c;
          for (int j = 1; j < w; ++j) { s0 += *(const f32x4*)(sp + (15 - j) * DPOOL); s1 += *(const f32x4*)(sp + (15 - j) * DPOOL + 4); }
          const float ic = 1.f / (float)w;
          *(u32x4*)(Yd + (size_t)row * DPOOL + c) = pack8(s0 * ic - cur.a, s1 * ic - cur.b); } }
    }
    const int gt = bid * 512 + tid, ngt = G * 512;
    { const float* sp = p.in[2] + (size_t)l * NS * 15 * DPOOL; float* o = p.out + O_POOL_S + (size_t)l * NS * 15 * DPOOL;
      for (int idx = gt; idx < NS * 14 * (DPOOL / 4); idx += ngt) { const int c = (idx & 127) * 4, r = (idx >> 7) % 14, s = (idx >> 7) / 14;
          *(f32x4*)(o + ((size_t)s * 15 + r) * DPOOL + c) = *(const f32x4*)(sp + ((size_t)s * 15 + r + 1) * DPOOL + c); } }
    { const float* sp = p.in[3] + (size_t)l * NS * 3 * DRNN; float* o = p.out + O_RC_S + (size_t)l * NS * 3 * DRNN;
      for (int idx = gt; idx < NS * 2 * (DRNN / 4); idx += ngt) { const int c = (idx & 255) * 4, r = (idx >> 8) & 1, s = idx >> 9;
          *(f32x4*)(o + ((size_t)s * 3 + r) * DRNN + c) = *(const f32x4*)(sp + ((size_t)s * 3 + r + 1) * DRNN + c); } }
    { const float* sp = p.in[5] + (size_t)l * NS * 2 * DFF; float* o = p.out + O_FF_S + (size_t)l * NS * 2 * DFF;
      for (int idx = gt; idx < NS * (DFF / 4); idx += ngt) { const int c = (idx % 768) * 4, s = idx / 768;
          *(f32x4*)(o + ((size_t)s * 2) * DFF + c) = *(const f32x4*)(sp + ((size_t)s * 2 + 1) * DFF + c); } }
}

__device__ __forceinline__ void phase_scan(const Params& p, int l, LAS unsigned char* lds, int bid, int G, const int wvid) {
    int tid = TIDX; asm volatile("" : "+v"(tid));
    const bf16_t* LA = (const bf16_t*)(p.ws + WS_Z) + UE; const bf16_t* BV = (const bf16_t*)(p.ws + WS_Z) + 5 * UE; const bf16_t* GB = (const bf16_t*)(p.ws + WS_Z) + 3 * UE;
    bf16_t* Y0 = (bf16_t*)(p.ws + WS_Y);
    LAS float* sP = (LAS float*)lds; LAS float* sH = sP + 4096; LAS float* sC = sH + 4096; LAS float* sPg = sC + 4096; LAS float* sHg = sPg + 512;
    for (int item = bid; item < 256; item += G) {
        const int b = item >> 5, c0 = (item & 31) * 32, seg = tid >> 2, lg = tid & 3;
        const size_t base = ((size_t)b * SEQ + seg * 16) * DRNN + c0 + lg * 8;
        f32x4 P0 = (f32x4){1.f, 1.f, 1.f, 1.f}, P1 = P0, h0 = (f32x4){0.f, 0.f, 0.f, 0.f}, h1 = h0;
#pragma unroll
        for (int t = 0; t < 16; ++t) { const F8 la = unpack8(*(const u32x4*)(LA + base + (size_t)t * DRNN)), bv = unpack8(*(const u32x4*)(BV + base + (size_t)t * DRNN));
            f32x4 a0, a1;
#pragma unroll
            for (int e = 0; e < 4; ++e) { a0[e] = __builtin_amdgcn_exp2f(1.442695041f * la.a[e]); a1[e] = __builtin_amdgcn_exp2f(1.442695041f * la.b[e]); }
            h0 = a0 * h0 + bv.a; h1 = a1 * h1 + bv.b; P0 *= a0; P1 *= a1; }
        { const int o = seg * 32 + lg * 8; *(LAS f32x4*)(sP + o) = P0; *(LAS f32x4*)(sP + o + 4) = P1; *(LAS f32x4*)(sH + o) = h0; *(LAS f32x4*)(sH + o + 4) = h1; }
        __syncthreads();
        const int ch = tid & 31, sg = tid >> 5;
        { float Pg = 1.f, hg = 0.f;
#pragma unroll
          for (int k = 0; k < 8; ++k) { const float pp = sP[(sg * 8 + k) * 32 + ch], hh = sH[(sg * 8 + k) * 32 + ch]; hg = pp * hg + hh; Pg *= pp; }
          sPg[sg * 32 + ch] = Pg; sHg[sg * 32 + ch] = hg; }
        __syncthreads();
        { float carry = 0.f;
          for (int k = 0; k < sg; ++k) carry = sPg[k * 32 + ch] * carry + sHg[k * 32 + ch];
#pragma unroll
          for (int k = 0; k < 8; ++k) { const int o = (sg * 8 + k) * 32 + ch; sC[o] = carry; carry = sP[o] * carry + sH[o]; }
          if (sg == 15) p.out[O_H_P + ((size_t)l * NB + b) * DRNN + c0 + ch] = carry; }
        __syncthreads();
        { const int o = seg * 32 + lg * 8; h0 = *(LAS f32x4*)(sC + o); h1 = *(LAS f32x4*)(sC + o + 4); }
#pragma unroll
        for (int t = 0; t < 16; ++t) { const F8 la = unpack8(*(const u32x4*)(LA + base + (size_t)t * DRNN)), bv = unpack8(*(const u32x4*)(BV + base + (size_t)t * DRNN)), gt = unpack8(*(const u32x4*)(GB + base + (size_t)t * DRNN));
            f32x4 a0, a1;
#pragma unroll
            for (int e = 0; e < 4; ++e) { a0[e] = __builtin_amdgcn_exp2f(1.442695041f * la.a[e]); a1[e] = __builtin_amdgcn_exp2f(1.442695041f * la.b[e]); }
            h0 = a0 * h0 + bv.a; h1 = a1 * h1 + bv.b;
            *(u32x4*)(Y0 + base + (size_t)t * DRNN) = pack8(gt.a * h0, gt.b * h1); }
        __syncthreads();
    }
    { const float* hin = p.in[4] + (size_t)l * NS * DRNN; float* oh = p.out + O_H_S + (size_t)l * NS * DRNN;
      for (int idx = bid * 512 + tid; idx < NS * DRNN; idx += G * 512) { const size_t off = (size_t)MPR * DRNN + idx;
          const float a = __expf(bf2f(LA[off])), h = a * hin[idx] + bf2f(BV[off]); oh[idx] = h; Y0[off] = f2bf(bf2f(GB[off]) * h); } }
}

__device__ __forceinline__ void phase_merge(const Params& p, int bid, int NG, const int wvid) {
    const bf16_t* G = (const bf16_t*)(p.ws + WS_Z); bf16_t* XN = (bf16_t*)(p.ws + WS_XN);
    int tid = TIDX; asm volatile("" : "+v"(tid));
    for (int idx = bid * 512 + tid; idx < MPAD * 128; idx += NG * 512) { const int row = idx >> 7, c = (idx & 127) * 8;
        const bf16_t* gr = G + (size_t)row * 3072 + c; const F8 a = unpack8(*(const u32x4*)gr), b = unpack8(*(const u32x4*)(gr + 1024)), d = unpack8(*(const u32x4*)(gr + 2048));
        *(u32x4*)(XN + (size_t)row * DM + c) = pack8(a.a + b.a + d.a, a.b + b.b + d.b); }
}

__device__ __forceinline__ void phase_final(const Params& p, int bid, int G, const int wvid) {
    int tid = TIDX; asm volatile("" : "+v"(tid));
    const int wave = tid >> 6, lane = tid & 63; const float* g = p.in[30];
    for (int row = bid * 8 + wave; row < MROWS; row += G * 8) {
        f32x4* xr = (f32x4*)(p.out + (size_t)row * DM) + lane; f32x4 v[4]; float s = 0.f;
#pragma unroll
        for (int j = 0; j < 4; ++j) { v[j] = xr[64 * j]; s += (v[j][0] * v[j][0] + v[j][1] * v[j][1]) + (v[j][2] * v[j][2] + v[j][3] * v[j][3]); }
        const float rstd = rsqrtf(wave_sum(s) * (1.f / DM) + 1e-6f); const f32x4* gr = (const f32x4*)g + lane;
#pragma unroll
        for (int j = 0; j < 4; ++j) xr[64 * j] = v[j] * rstd * gr[64 * j];
    }
}


#define XB_TMO      128
#define XB_XCNT(j)  (256  + 64 * (j))
#define XB_XSUB(j)  (1280 + 64 * (j))
#define XB_XGEN(j)  (2304 + 64 * (j))
#define XB_TOP      3328
#define XB_TOPGEN   3392
#define XCD_BAR_WORDS 3456
#define XB_SPIN_CAP (1u << 18)
__device__ __forceinline__ unsigned xb_ld(unsigned* p)              { return __hip_atomic_load(p, __ATOMIC_RELAXED, __HIP_MEMORY_SCOPE_AGENT); }
__device__ __forceinline__ unsigned xb_add(unsigned* p, unsigned v) { return __hip_atomic_fetch_add(p, v, __ATOMIC_RELAXED, __HIP_MEMORY_SCOPE_AGENT); }
__device__ __forceinline__ unsigned xb_xcc_id() { return (unsigned)__builtin_amdgcn_s_getreg((3 << 11) | 20) & 0xFu; }
#define XB_SPIN(cond, bar) do { unsigned _sp = 0; while (cond) { __builtin_amdgcn_s_sleep(1); \
    if ((++_sp & 255u) == 0u) { if (xb_ld(&(bar)[XB_TMO])) break; if (_sp > XB_SPIN_CAP) { atomicAdd(&(bar)[XB_TMO], 1u); break; } } } } while (0)
__device__ __forceinline__ void xcd_barrier_complete(unsigned* bar, unsigned x, unsigned G, unsigned& nloc, unsigned& nx) {
    unsigned sum, cnt, mine, sp = 0u;
    for (;;) {
        sum = 0u; cnt = 0u; mine = 0u;
#pragma unroll
        for (unsigned j = 0; j < 16; ++j) { const unsigned c = xb_ld(&bar[XB_XCNT(j)]); sum += c; cnt += (c > 0u) ? 1u : 0u; mine = (j == x) ? c : mine; }
        if (sum == G) break;
        __builtin_amdgcn_s_sleep(1);
        if ((++sp & 255u) == 0u) { if (xb_ld(&bar[XB_TMO])) break; if (sp > XB_SPIN_CAP) { atomicAdd(&bar[XB_TMO], 1u); break; } }
    }
    nloc = mine > 0u ? mine : 1u; nx = cnt > 0u ? cnt : 1u;
}
__device__ __forceinline__ void xcd_barrier(unsigned* bar, volatile LAS unsigned* st, unsigned G, const int wvid) {
    asm volatile("s_waitcnt vmcnt(0)" ::: "memory");
    __syncthreads();
    if (TIDX == 0) {
        const unsigned x = xb_xcc_id();
        __builtin_amdgcn_s_waitcnt(0);
        unsigned nloc = st[0], nx = st[1];
        if (nloc == 0u) { xcd_barrier_complete(bar, x, G, nloc, nx); st[0] = nloc; st[1] = nx; }
        const unsigned old = xb_add(&bar[XB_XSUB(x)], 1u);
        const unsigned gen = old / nloc;
        if (old + 1u == (gen + 1u) * nloc) {
            __builtin_amdgcn_fence(__ATOMIC_RELEASE, "agent");
            asm volatile("s_waitcnt vmcnt(0)" ::: "memory");
            const unsigned og = xb_add(&bar[XB_TOP], 1u);
            const unsigned tg = og / nx;
            if (og + 1u == (tg + 1u) * nx) xb_add(&bar[XB_TOPGEN], 1u);
            else XB_SPIN(xb_ld(&bar[XB_TOPGEN]) == tg, bar);
            __builtin_amdgcn_fence(__ATOMIC_ACQUIRE, "agent");
            xb_add(&bar[XB_XGEN(x)], 1u);
            asm volatile("s_waitcnt vmcnt(0)" ::: "memory");
        } else {
            XB_SPIN(xb_ld(&bar[XB_XGEN(x)]) == gen, bar);
            __builtin_amdgcn_fence(__ATOMIC_ACQUIRE, "agent");
            asm volatile("s_waitcnt vmcnt(0)" ::: "memory");
        }
    }
    __syncthreads();
}

__global__ void __launch_bounds__(512, 2) mega(Params pk) {
    extern __shared__ __attribute__((aligned(16))) unsigned char shm[];
    LAS unsigned char* lds = (LAS unsigned char*)shm;
    cg::grid_group grid = cg::this_grid();
    const int wvid = __builtin_amdgcn_readfirstlane((int)threadIdx.x >> 6);
    volatile LAS unsigned* bst = (volatile LAS unsigned*)(lds + 131072 + 1024);
    if (TIDX < 2) bst[TIDX] = 0u;
    if (blockIdx.x == 0) for (int i = TIDX; i < XCD_BAR_WORDS; i += 512) ((unsigned*)(pk.ws + WS_BAR))[i] = 0u;
    __syncthreads();
    bool posted = false;
    for (int ph = pk.ph_lo; ph < pk.ph_hi; ++ph) {
        Params p = pk; int G = gridDim.x, bid = blockIdx.x;
        asm volatile("" : "+s"(p.ws), "+s"(p.out), "+s"(G), "+s"(bid));
        bf16_t* XN = (bf16_t*)(p.ws + WS_XN); bf16_t* Z = (bf16_t*)(p.ws + WS_Z); bf16_t* Y0 = (bf16_t*)(p.ws + WS_Y); bf16_t* W = (bf16_t*)(p.ws + WS_W); bf16_t* H = (bf16_t*)(p.ws + WS_H);
        if (ph == NPH - 1) { phase_final(p, bid, G, wvid); }
        else {
            const int l = ph / PH_PER_LAYER, k = ph % PH_PER_LAYER;
            const float* xp = l == 0 ? p.in[0] : p.out; const float* xs = l == 0 ? p.in[1] : p.out + (size_t)MPR * DM;
            pg8::Order S; pg8::Gemm g;
            for (int rep = ((REPMASK >> k) & 1u) ? 2 : 1; rep > 0; --rep)
            switch (k) {
            case 0: phase_prep(p, l, lds, xp, xs, bid, G, wvid); break;
            case 1: { S.init(64, ZC / 256, G, bid, 0); g = {XN, W + W_IN, DM, DM, DM}; EpiZ E{Z, p.out, l}; pg8::gemm_phase(lds, g, S, E, wvid);
                      sample_gemm<false>(lds, XN + (size_t)MPR * DM, DM, W + W_IN, DM, DM, ZC / 16, bid, G, E, wvid); } break;
            case 2: phase_mix(p, l, lds, bid, G, wvid); break;
            case 3: { S.init(64, 8, G, bid, 1); g = {Y0, W + W_RI, DRNN, 256, 256};
                      EpiRI E{Y0, Z + UE, Z + 5 * UE, p.in[13] + (size_t)l * DRNN, p.in[15] + (size_t)l * DRNN, (const float*)(p.ws + WS_SP)}; pg8::gemm_phase(lds, g, S, E, wvid);
                      sample_gemm<true>(lds, Y0 + (size_t)MPR * DRNN, DRNN, W + W_RI, 256, 256, 64, bid, G, E, wvid); } break;
            case 4: phase_scan(p, l, lds, bid, G, wvid); break;
            case 5: { S.init(64, 12, G, bid, 0); g = {XN, W + W_IN + (size_t)ZC * DM, DM, DM, DM}; EpiG E{Z}; pg8::gemm_phase(lds, g, S, E, wvid);
                      sample_gemm<false>(lds, XN + (size_t)MPR * DM, DM, W + W_IN + (size_t)ZC * DM, DM, DM, 3072 / 16, bid, G, E, wvid); } break;
            case 6: { { S.init(64, 4, G, bid, 0); g = {Y0 + 2 * UE, W + W_PA, DPOOL, DPOOL, DPOOL}; EpiP E{Z, XN, 0, 1}; pg8::gemm_phase(lds, g, S, E, wvid);
                        sample_gemm<false>(lds, Y0 + 2 * UE + (size_t)MPR * DPOOL, DPOOL, W + W_PA, DPOOL, DPOOL, 64, bid, G, E, wvid); }
                      { S.init(64, 4, G, bid, 0); g = {Y0, W + W_PB, DRNN, DRNN, DRNN}; EpiP E{Z, XN, 1024, 0}; pg8::gemm_phase(lds, g, S, E, wvid);
                        sample_gemm<false>(lds, Y0 + (size_t)MPR * DRNN, DRNN, W + W_PB, DRNN, DRNN, 64, bid, G, E, wvid); }
                      { S.init(64, 4, G, bid, 0); g = {Y0 + 3 * UE, W + W_PC, DCH, DCH, DCH}; EpiP E{Z, XN, 2048, 0}; pg8::gemm_phase(lds, g, S, E, wvid);
                        sample_gemm<false>(lds, Y0 + 3 * UE + (size_t)MPR * DCH, DCH, W + W_PC, DCH, DCH, 64, bid, G, E, wvid); } } break;
            case 7: break;
            case 8: { S.init(64, 4, G, bid, 0); g = {XN, W + W_O, DM, DM, DM}; EpiX E{xp, xs, p.out}; pg8::gemm_phase(lds, g, S, E, wvid);
                      sample_gemm<false>(lds, XN + (size_t)MPR * DM, DM, W + W_O, DM, DM, 64, bid, G, E, wvid); } break;
            case 9: { int tid = TIDX; asm volatile("" : "+v"(tid)); const int wave = tid >> 6, lane = tid & 63; rms_rows(p.out, p.out + (size_t)MPR * DM, p.in[24] + (size_t)l * DM, XN, bid * 8 + wave, G * 8, lane); } break;
            case 10: { S.init(64, 12, G, bid, 0); g = {XN, W + W_G, DM, DM, DM}; EpiGpre E{Z, p.out, l}; pg8::gemm_phase(lds, g, S, E, wvid);
                       sample_gemm<false>(lds, XN + (size_t)MPR * DM, DM, W + W_G, DM, DM, 192, bid, G, E, wvid); } break;
            case 11: { S.init(64, 12, G, bid, 0); g = {XN, W + W_U, DM, DM, DM};
                       EpiH E{Z, H, p.in[27] + (size_t)l * 3 * DFF, p.in[28] + (size_t)l * DFF, p.in[5] + (size_t)l * NS * 2 * DFF}; pg8::gemm_phase(lds, g, S, E, wvid);
                       sample_gemm<false>(lds, XN + (size_t)MPR * DM, DM, W + W_U, DM, DM, 192, bid, G, E, wvid); } break;
            default: { S.init(64, 4, G, bid, 0); g = {H, W + W_D, DFF, DFF, DFF}; EpiX E{p.out, p.out + (size_t)MPR * DM, p.out}; pg8::gemm_phase(lds, g, S, E, wvid);
                       sample_gemm<false>(lds, H + (size_t)MPR * DFF, DFF, W + W_D, DFF, DFF, 64, bid, G, E, wvid); } break;
            }
        }
        if (ph + 1 < pk.ph_hi && (ph % PH_PER_LAYER) != 7) {
            if (!posted) {
                grid.sync(); posted = true;
                if (TIDX == 0) (void)xb_add(&((unsigned*)(pk.ws + WS_BAR))[XB_XCNT(xb_xcc_id())], 1u);
            } else xcd_barrier((unsigned*)(pk.ws + WS_BAR), bst, (unsigned)gridDim.x, wvid);
            for (int e = 0; e < EXTRA_SYNCS; ++e) xcd_barrier((unsigned*)(pk.ws + WS_BAR), bst, (unsigned)gridDim.x, wvid);
        }
    }
}

extern "C" void kernel_launch(void* const* d_in, const int* in_sizes, int n_in, void* d_out, int out_size, void* d_ws, size_t ws_size, hipStream_t stream) {
    static int grid = 0;
    if (grid == 0) {
        int dev = 0, cus = 0, per_cu = 0;
        hipGetDevice(&dev);
        hipDeviceGetAttribute(&cus, hipDeviceAttributeMultiprocessorCount, dev);
        if (hipFuncSetAttribute((const void*)mega, hipFuncAttributeMaxDynamicSharedMemorySize, LDS_BYTES) != hipSuccess) fprintf(stderr, "kernel_launch: hipFuncSetAttribute failed\n");
        if (hipOccupancyMaxActiveBlocksPerMultiprocessor(&per_cu, (const void*)mega, 512, LDS_BYTES) != hipSuccess || per_cu < 1) { fprintf(stderr, "kernel_launch: occupancy query says %d blocks per CU\n", per_cu); per_cu = 1; }
        (void)hipGetLastError();
        grid = cus;
        if (n_in != 31 || ws_size < WS_END) fprintf(stderr, "kernel_launch: unexpected n_in %d / ws_size %zu (need %zu)\n", n_in, ws_size, (size_t)WS_END);
    }
    Params p{};
    for (int i = 0; i < 31; ++i) p.in[i] = (const float*)d_in[i];
    p.out = (float*)d_out; p.ws = (unsigned char*)d_ws; p.ph_lo = 0; p.ph_hi = NPH;
    void* args[] = {&p};
    hipError_t e = hipLaunchCooperativeKernel((const void*)mega, dim3(grid), dim3(512), args, LDS_BYTES, stream);
    if (e != hipSuccess) fprintf(stderr, "cooperative launch failed: %s (grid %d)\n", hipGetErrorString(e), grid);
}
```

```cpp
#include <hip/hip_runtime.h>
#include <hip/hip_cooperative_groups.h>
#include <cstdio>
#include <cstdint>
namespace cg = cooperative_groups;

#define LAS __attribute__((address_space(3)))
typedef unsigned short bf16_t;
typedef short bf16x8 __attribute__((ext_vector_type(8)));
typedef float f32x4 __attribute__((ext_vector_type(4)));
typedef float f32x2 __attribute__((ext_vector_type(2)));
typedef unsigned u32x4 __attribute__((ext_vector_type(4)));
typedef unsigned u32x2 __attribute__((ext_vector_type(2)));

constexpr int DM = 1024, NB = 8, SEQ = 2048, MPR = NB * SEQ, NS = 128, MROWS = MPR + NS, MPAD = 16640, NTM = MPAD / 256;
constexpr int DPOOL = 512, DRNN = 1024, DCH = 512, DFF = 3072, INCOLS = 6656, ZC = 3584;
constexpr int NLAYER = 2, PH_PER_LAYER = 13, NPH = NLAYER * PH_PER_LAYER + 1;
constexpr size_t O_Y = 0;
constexpr size_t O_POOL_P = (size_t)MROWS * DM;
constexpr size_t O_POOL_S = O_POOL_P + (size_t)2 * NB * 15 * DPOOL;
constexpr size_t O_RC_P = O_POOL_S + (size_t)2 * NS * 15 * DPOOL;
constexpr size_t O_RC_S = O_RC_P + (size_t)2 * NB * 3 * DRNN;
constexpr size_t O_H_P = O_RC_S + (size_t)2 * NS * 3 * DRNN;
constexpr size_t O_H_S = O_H_P + (size_t)2 * NB * DRNN;
constexpr size_t O_FF_P = O_H_S + (size_t)2 * NS * DRNN;
constexpr size_t O_FF_S = O_FF_P + (size_t)2 * NB * 2 * DFF;
constexpr size_t O_CV_S = O_FF_S + (size_t)2 * NS * 2 * DFF;
constexpr size_t UE = (size_t)MPAD * 512, UB = UE * 2;
constexpr size_t WS_BAR = 16384;
constexpr size_t WS_SP = 4096;
constexpr size_t WS_XN = 1u << 20;
constexpr size_t WS_Z = WS_XN + 2 * UB;
constexpr size_t WS_Y = WS_Z + 7 * UB;
constexpr size_t WS_W = WS_Y + 4 * UB;
constexpr size_t WS_H = WS_Z + 6 * UB;
constexpr size_t W_IN = 0;
constexpr size_t W_PA = W_IN + (size_t)INCOLS * DM;
constexpr size_t W_PB = W_PA + (size_t)DM * DPOOL;
constexpr size_t W_PC = W_PB + (size_t)DM * DRNN;
constexpr size_t W_O = W_PC + (size_t)DM * DCH;
constexpr size_t W_G = W_O + (size_t)DM * DM;
constexpr size_t W_U = W_G + (size_t)DFF * DM;
constexpr size_t W_D = W_U + (size_t)DFF * DM;
constexpr size_t W_RI = W_D + (size_t)DM * DFF;
constexpr size_t W_END = W_RI + (size_t)8 * 256 * 256;
constexpr size_t WS_END = WS_W + W_END * 2;
static_assert(WS_END <= (256u << 20), "workspace");
static_assert(WS_H + 6 * UB <= WS_W + (W_G)*2, "h overlay must not reach wg/wu/wd");
constexpr int LDS_BYTES = 131072 + 2048;
#ifndef REPMASK
#define REPMASK 0u
#endif
#ifndef EXTRA_SYNCS
#define EXTRA_SYNCS 0
#endif

struct Params { const float* in[31]; float* out; unsigned char* ws; int ph_lo, ph_hi; };

__device__ __forceinline__ int tidx_of(int wvid) { unsigned z = 0u; asm volatile("" : "+v"(z));
    return wvid * 64 + (int)__builtin_amdgcn_mbcnt_hi(~0u, __builtin_amdgcn_mbcnt_lo(~0u, z)); }
#define TIDX tidx_of(wvid)
__device__ __forceinline__ float bf_lo(unsigned w) { return __builtin_bit_cast(float, w << 16); }
__device__ __forceinline__ float bf_hi(unsigned w) { return __builtin_bit_cast(float, w & 0xffff0000u); }
__device__ __forceinline__ float bf2f(bf16_t b) { return __builtin_bit_cast(float, (unsigned)b << 16); }
typedef __bf16 bf16x2_t __attribute__((ext_vector_type(2)));
__device__ __forceinline__ unsigned pk2(float lo, float hi) { f32x2 v = {lo, hi}; bf16x2_t b = __builtin_convertvector(v, bf16x2_t); return __builtin_bit_cast(unsigned, b); }
__device__ __forceinline__ bf16_t f2bf(float f) { return (bf16_t)(pk2(f, 0.f) & 0xffffu); }
struct F8 { f32x4 a, b; };
__device__ __forceinline__ F8 unpack8(u32x4 w) { F8 r; r.a[0] = bf_lo(w.x); r.a[1] = bf_hi(w.x); r.a[2] = bf_lo(w.y); r.a[3] = bf_hi(w.y); r.b[0] = bf_lo(w.z); r.b[1] = bf_hi(w.z); r.b[2] = bf_lo(w.w); r.b[3] = bf_hi(w.w); return r; }
__device__ __forceinline__ u32x4 pack8(f32x4 a, f32x4 b) { u32x4 w; w.x = pk2(a[0], a[1]); w.y = pk2(a[2], a[3]); w.z = pk2(b[0], b[1]); w.w = pk2(b[2], b[3]); return w; }
__device__ __forceinline__ float gelu_t(float x) {
    const float u = 0.7978845608f * (x + 0.044715f * x * x * x);
    const float e = __builtin_amdgcn_exp2f(-2.885390082f * u);
    return x * __builtin_amdgcn_rcpf(1.f + e);
}
__device__ __forceinline__ f32x4 gelu4(f32x4 v) { f32x4 r; r[0] = gelu_t(v[0]); r[1] = gelu_t(v[1]); r[2] = gelu_t(v[2]); r[3] = gelu_t(v[3]); return r; }
__device__ __forceinline__ float sigm(float x) { return __builtin_amdgcn_rcpf(1.f + __builtin_amdgcn_exp2f(-1.442695041f * x)); }
__device__ __forceinline__ f32x4 sigm4(f32x4 v) { f32x4 r; r[0] = sigm(v[0]); r[1] = sigm(v[1]); r[2] = sigm(v[2]); r[3] = sigm(v[3]); return r; }
__device__ __forceinline__ float wave_sum(float v) {
#pragma unroll
    for (int o = 1; o < 64; o <<= 1) v += __shfl_xor(v, o);
    return v;
}

__device__ __forceinline__ unsigned dpp_shr1(unsigned old, unsigned src) { return (unsigned)__builtin_amdgcn_update_dpp((int)old, (int)src, 0x111, 0xf, 0xf, false); }
__device__ __forceinline__ unsigned dpp_shr2(unsigned old, unsigned src) { return (unsigned)__builtin_amdgcn_update_dpp((int)old, (int)src, 0x112, 0xf, 0xf, false); }
__device__ __forceinline__ unsigned dpp_ror1(unsigned src) { return (unsigned)__builtin_amdgcn_update_dpp(0, (int)src, 0x121, 0xf, 0xf, false); }
__device__ __forceinline__ unsigned dpp_ror2(unsigned src) { return (unsigned)__builtin_amdgcn_update_dpp(0, (int)src, 0x122, 0xf, 0xf, false); }

namespace pg8 {
constexpr int BM = 256, BK = 64, HALF = 128, HTB = HALF * BK * 2, STAGE_BYTES = 8 * HTB, NXCD = 8, WGM = 8;
__device__ __forceinline__ int lds_byte(int r, int c) { const int st = (r >> 4) * 2 + (c >> 5), rr = r & 15, cc = c & 31, ob = rr * 64 + cc * 2; return st * 1024 + (ob ^ (((ob >> 9) & 1) << 5)); }
__device__ __forceinline__ void stage_rc(int b, int& R, int& C) { const int st = b / 1024, sb = b % 1024, swz = sb ^ (((sb >> 9) & 1) << 5); R = (st >> 1) * 16 + swz / 64; C = (st & 1) * 32 + (swz % 64) / 2; }
__device__ __forceinline__ int perm32(int rho) { const int n = rho >> 4, i = rho & 15; return 8 * (i >> 2) + 4 * n + (i & 3); }

struct Unit { int pm, pn, ka; };
struct Gemm { const bf16_t* A; const bf16_t* Bt; int lda, ldb, K; };

struct Order {
    int nM, nN, nwg, G, c, mode;
    __device__ __forceinline__ void init(int nM_, int nN_, int G_, int c_, int mode_) { nM = nM_; nN = nN_; nwg = nM * nN; G = G_; c = c_; mode = mode_; }
    __device__ __forceinline__ bool next(int i, Unit& u) const {
        const long L = (long)i * G + c; if (L >= nwg) return false;
        int wgid = (int)L; { const int q = nwg / NXCD, r = nwg % NXCD, xcd = wgid % NXCD, off = wgid / NXCD; wgid = (xcd < r ? xcd * (q + 1) : r * (q + 1) + (xcd - r) * q) + off; }
        const int nig = WGM * nN, gid = wgid / nig, fm = gid * WGM, gsz = (nM - fm) < WGM ? (nM - fm) : WGM;
        u.pm = fm + ((wgid % nig) % gsz); u.pn = (wgid % nig) / gsz; u.ka = mode ? ((u.pn & ~1) * 128) : 0; return true;
    }
};

template <class Epi>
__device__ __forceinline__ void gemm_phase(LAS unsigned char* lds, const Gemm g, const Order& S, const Epi& E, const int wvid) {
    int tid = TIDX; asm volatile("" : "+v"(tid));
    const int wid = __builtin_amdgcn_readfirstlane(tid >> 6), lane = tid & 63, wr = wid >> 2, wc = wid & 3, fr = lane & 15, fq = lane >> 4;
    const int K = g.K, nt = K / BK;
    unsigned voffA[2], voffB[2];
#pragma unroll
    for (int i = 0; i < 2; ++i) { int R, C; stage_rc(tid * 16 + i * 8192, R, C); const int Rb = Epi::PERM ? ((R & ~31) + perm32(R & 31)) : R;
        voffA[i] = (unsigned)(R * g.lda + C) * 2u; voffB[i] = (unsigned)(Rb * g.ldb + C) * 2u; }
    const size_t kstep = (size_t)(BK * 2);
    const size_t hstepA = (size_t)HALF * g.lda * 2, tstepA = 2 * hstepA;
    const size_t hstepB = (size_t)HALF * g.ldb * 2, tstepB = 2 * hstepB;
    const unsigned ldsw = (unsigned)wid * 1024u;
    const int aoff = lds_byte(wr * 64 + fr, fq * 8), boff = lds_byte(wc * 32 + fr, fq * 8);
#define PG8_SA(b, h) (((b) * 2 + (h)) * HTB)
#define PG8_SB(b, h) ((4 + (b) * 2 + (h)) * HTB)
#define PG8_STAGE(bufoff, gbase, voff) do { _Pragma("unroll") for (int _i = 0; _i < 2; ++_i) \
        __builtin_amdgcn_global_load_lds((const unsigned*)((const char*)(gbase) + (voff)[_i]), (LAS unsigned*)(lds + (bufoff) + ldsw + _i * 8192), 16, 0, 0); } while (0)
#define PG8_LDA(dst, b, h) do { _Pragma("unroll") for (int m = 0; m < 4; ++m) _Pragma("unroll") for (int k = 0; k < 2; ++k) dst[m][k] = *(const LAS bf16x8*)(lds + PG8_SA(b, h) + aoff + m * 2048 + k * 1024); } while (0)
#define PG8_LDB(dst, b, h) do { _Pragma("unroll") for (int n = 0; n < 2; ++n) _Pragma("unroll") for (int k = 0; k < 2; ++k) dst[n][k] = *(const LAS bf16x8*)(lds + PG8_SB(b, h) + boff + n * 2048 + k * 1024); } while (0)
#define PG8_MMA(ai, bj, At, Bt) do { __builtin_amdgcn_s_setprio(1); _Pragma("unroll") for (int m = 0; m < 4; ++m) _Pragma("unroll") for (int n = 0; n < 2; ++n) _Pragma("unroll") for (int k = 0; k < 2; ++k) \
        acc[ai][bj][m][n] = __builtin_amdgcn_mfma_f32_16x16x32_bf16(Bt[n][k], At[m][k], acc[ai][bj][m][n], 0, 0, 0); __builtin_amdgcn_s_setprio(0); } while (0)
#define PG8_WAIT_V(n) asm volatile("s_waitcnt vmcnt(" #n ")" ::: "memory")
#define PG8_WAIT_L(n) asm volatile("s_waitcnt lgkmcnt(" #n ")" ::: "memory")
#define PG8_BAR __builtin_amdgcn_s_barrier()
#define PG8_SCHED __builtin_amdgcn_sched_barrier(0)
    Unit cur, nxt; int ui = 0;
    if (!S.next(0, cur)) return;
    f32x4 acc[2][2][4][2];
#pragma unroll
    for (int a = 0; a < 2; ++a)
#pragma unroll
        for (int b = 0; b < 2; ++b)
#pragma unroll
            for (int m = 0; m < 4; ++m)
#pragma unroll
                for (int n = 0; n < 2; ++n) acc[a][b][m][n] = (f32x4){0.f, 0.f, 0.f, 0.f};
    bf16x8 At[4][2], B0[2][2], B1[2][2];
    const char* cA = (const char*)g.A + (size_t)cur.pm * tstepA + (size_t)cur.ka * 2; const char* cB = (const char*)g.Bt + (size_t)cur.pn * tstepB;
    PG8_STAGE(PG8_SB(0, 0), cB, voffB); PG8_STAGE(PG8_SB(0, 1), cB + hstepB, voffB); PG8_STAGE(PG8_SA(0, 0), cA, voffA); PG8_STAGE(PG8_SA(0, 1), cA + hstepA, voffA);
    if (wr == 1) PG8_BAR;
    PG8_WAIT_V(2); PG8_BAR;
    PG8_STAGE(PG8_SB(1, 0), cB + kstep, voffB); PG8_STAGE(PG8_SA(1, 0), cA + kstep, voffA); PG8_STAGE(PG8_SB(1, 1), cB + hstepB + kstep, voffB);
    PG8_WAIT_V(6); PG8_BAR;
    for (;;) {
        const bool has_next = S.next(ui + 1, nxt);
        const char* nA = has_next ? (const char*)g.A + (size_t)nxt.pm * tstepA + (size_t)nxt.ka * 2 : cA; const char* nB = has_next ? (const char*)g.Bt + (size_t)nxt.pn * tstepB : cB;
#pragma unroll 1
        for (int t = 0; t < nt; t += 2) {
            const bool last = (t == nt - 2);
            const char* a1 = cA + (size_t)(t + 1) * kstep;
            const char* a2 = last ? nA : cA + (size_t)(t + 2) * kstep; const char* b2 = last ? nB : cB + (size_t)(t + 2) * kstep;
            const char* a3 = a2 + kstep; const char* b3 = b2 + kstep;
            PG8_LDB(B0, 0, 0); PG8_LDB(B1, 0, 1); PG8_SCHED; PG8_LDA(At, 0, 0); PG8_STAGE(PG8_SA(1, 1), a1 + hstepA, voffA);
            PG8_WAIT_V(8); PG8_WAIT_L(0); PG8_BAR; PG8_MMA(0, 0, At, B0); PG8_MMA(0, 1, At, B1); PG8_BAR; PG8_SCHED;
            PG8_LDA(At, 0, 1); PG8_STAGE(PG8_SB(0, 0), b2, voffB); PG8_STAGE(PG8_SB(0, 1), b2 + hstepB, voffB); PG8_STAGE(PG8_SA(0, 0), a2, voffA);
            PG8_WAIT_V(8); PG8_WAIT_L(0); PG8_BAR; PG8_MMA(1, 0, At, B0); PG8_MMA(1, 1, At, B1); PG8_BAR; PG8_SCHED;
            PG8_LDB(B0, 1, 0); PG8_LDB(B1, 1, 1); PG8_SCHED; PG8_LDA(At, 1, 0); PG8_STAGE(PG8_SA(0, 1), a2 + hstepA, voffA);
            PG8_WAIT_V(8); PG8_WAIT_L(0); PG8_BAR; PG8_MMA(0, 0, At, B0); PG8_MMA(0, 1, At, B1); PG8_BAR; PG8_SCHED;
            PG8_LDA(At, 1, 1); PG8_STAGE(PG8_SB(1, 0), b3, voffB); PG8_STAGE(PG8_SB(1, 1), b3 + hstepB, voffB); PG8_STAGE(PG8_SA(1, 0), a3, voffA);
            PG8_WAIT_V(8); PG8_WAIT_L(0); PG8_BAR; PG8_MMA(1, 0, At, B0); PG8_MMA(1, 1, At, B1); PG8_BAR; PG8_SCHED;
        }
        if (wr == 0) PG8_BAR;
        { int fr2 = fr, fq2 = fq; asm volatile("" : "+v"(fr2), "+v"(fq2));
          E(acc, cur, wr, wc, fr2, fq2); }
        if (!has_next) break;
#pragma unroll
        for (int a = 0; a < 2; ++a)
#pragma unroll
            for (int b = 0; b < 2; ++b)
#pragma unroll
                for (int m = 0; m < 4; ++m)
#pragma unroll
                    for (int n = 0; n < 2; ++n) acc[a][b][m][n] = (f32x4){0.f, 0.f, 0.f, 0.f};
        cur = nxt; cA = nA; cB = nB; ++ui;
        if (wr == 1) PG8_BAR;
    }
    PG8_WAIT_V(0);
    PG8_BAR;
#undef PG8_SA
#undef PG8_SB
#undef PG8_STAGE
#undef PG8_LDA
#undef PG8_LDB
#undef PG8_MMA
#undef PG8_WAIT_V
#undef PG8_WAIT_L
#undef PG8_BAR
#undef PG8_SCHED
}
}
using pg8::Unit;

#define EPI_ARGS const f32x4 (&acc)[2][2][4][2], const Unit& u, int wr, int wc, int fr, int fq
struct EpiZ {
    static constexpr bool PERM = true;
    bf16_t* Z; float* out; int l;
    __device__ __forceinline__ void operator()(EPI_ARGS) const {
        const int pn = u.pn; bf16_t* base; int ld, ct; bool act;
        if (pn < 2) { base = Z; ld = 512; ct = pn * 256; act = false; }
        else if (pn < 6) { base = Z + UE; ld = 1024; ct = (pn - 2) * 256; act = false; }
        else if (pn < 10) { base = Z + 3 * UE; ld = 1024; ct = (pn - 6) * 256; act = true; }
        else if (pn < 12) { base = Z + 5 * UE; ld = 512; ct = (pn - 10) * 256; act = true; }
        else { base = Z + 6 * UE; ld = 512; ct = (pn - 12) * 256; act = true; }
        const bool st = (pn < 6) && (((u.pm & 7) == 7) || u.pm == 64);
#pragma unroll
        for (int ai = 0; ai < 2; ++ai)
#pragma unroll
            for (int m = 0; m < 4; ++m) {
                const int row = u.pm * 256 + ai * 128 + wr * 64 + m * 16 + fr;
#pragma unroll
                for (int bj = 0; bj < 2; ++bj) {
                    f32x4 v0 = acc[ai][bj][m][0], v1 = acc[ai][bj][m][1];
                    const int c = ct + bj * 128 + wc * 32 + 8 * fq;
                    if (st) {
                        float* o = nullptr;
                        if (row < MPR) { const int t = row & 2047, b = row >> 11;
                            if (pn < 2) { if (t >= 2033) o = out + O_POOL_P + ((size_t)(l * NB + b) * 15 + (t - 2033)) * DPOOL + c; }
                            else { if (t >= 2045) o = out + O_RC_P + ((size_t)(l * NB + b) * 3 + (t - 2045)) * DRNN + c; } }
                        else if (row < MROWS) { const int s = row - MPR;
                            if (pn < 2) o = out + O_POOL_S + ((size_t)(l * NS + s) * 15 + 14) * DPOOL + c;
                            else o = out + O_RC_S + ((size_t)(l * NS + s) * 3 + 2) * DRNN + c; }
                        if (o) { *(f32x4*)o = v0; *(f32x4*)(o + 4) = v1; }
                    }
                    if (act) { v0 = gelu4(v0); v1 = gelu4(v1); }
                    *(u32x4*)(base + (size_t)row * ld + c) = pack8(v0, v1);
                    asm volatile("" ::: "memory");
                }
            }
    }
    __device__ __forceinline__ void sample(int row, int col, f32x4 v) const {
        const int s = row - MPR; bf16_t* dst;
        if (col < 512) { dst = Z + (size_t)row * 512 + col; *(f32x4*)(out + O_POOL_S + ((size_t)(l * NS + s) * 15 + 14) * DPOOL + col) = v; }
        else if (col < 1536) { dst = Z + UE + (size_t)row * 1024 + (col - 512); *(f32x4*)(out + O_RC_S + ((size_t)(l * NS + s) * 3 + 2) * DRNN + (col - 512)) = v; }
        else if (col < 2560) { dst = Z + 3 * UE + (size_t)row * 1024 + (col - 1536); v = gelu4(v); }
        else if (col < 3072) { dst = Z + 5 * UE + (size_t)row * 512 + (col - 2560); v = gelu4(v); }
        else { dst = Z + 6 * UE + (size_t)row * 512 + (col - 3072); v = gelu4(v); }
        u32x2 w; w.x = pk2(v[0], v[1]); w.y = pk2(v[2], v[3]); *(u32x2*)dst = w;
    }
};
struct EpiRI {
    static constexpr bool PERM = true;
    const bf16_t* BC; bf16_t* LA; bf16_t* BV; const float* ba; const float* bx; const float* sp;
    __device__ __forceinline__ void operator()(EPI_ARGS) const {
        const int ch = u.pn * 128 + wc * 32 + 8 * fq;
        f32x4 bav[2], bxv[2], spv[2];
#pragma unroll
        for (int n = 0; n < 2; ++n) { bav[n] = *(const f32x4*)(ba + ch + 4 * n); bxv[n] = *(const f32x4*)(bx + ch + 4 * n); spv[n] = *(const f32x4*)(sp + ch + 4 * n); }
#pragma unroll
        for (int ai = 0; ai < 2; ++ai) {
            u32x4 xw[4];
#pragma unroll
            for (int m = 0; m < 4; ++m) xw[m] = *(const u32x4*)(BC + (size_t)(u.pm * 256 + ai * 128 + wr * 64 + m * 16 + fr) * DRNN + ch);
#pragma unroll
            for (int m = 0; m < 4; ++m) {
                const int row = u.pm * 256 + ai * 128 + wr * 64 + m * 16 + fr;
                const F8 xc8 = unpack8(xw[m]); f32x4 lav[2], bv[2];
#pragma unroll
                for (int n = 0; n < 2; ++n) {
                    const f32x4 xc = n ? xc8.b : xc8.a;
                    const f32x4 r0 = sigm4(acc[ai][0][m][n] + bav[n]), i0 = sigm4(acc[ai][1][m][n] + bxv[n]);
                    lav[n] = r0 * spv[n];
#pragma unroll
                    for (int j = 0; j < 4; ++j) { const float x = -2.f * lav[n][j];
                        const float em = x < 0.03f ? x * (1.f - x * (0.5f - x * (0.16666667f - x * 0.041666668f))) : 1.f - __expf(-x);
                        bv[n][j] = __builtin_sqrtf(em) * i0[j] * xc[j]; }
                }
                *(u32x4*)(LA + (size_t)row * DRNN + ch) = pack8(lav[0], lav[1]);
                *(u32x4*)(BV + (size_t)row * DRNN + ch) = pack8(bv[0], bv[1]);
            }
            asm volatile("" ::: "memory");
        }
    }
    __device__ __forceinline__ void sample2(int row, int ch, f32x4 vr, f32x4 vi) const {
        const f32x4 ba0 = *(const f32x4*)(ba + ch), bx0 = *(const f32x4*)(bx + ch), sp0 = *(const f32x4*)(sp + ch);
        const u32x2 xw = *(const u32x2*)(BC + (size_t)row * DRNN + ch);
        const f32x4 xc = (f32x4){bf_lo(xw.x), bf_hi(xw.x), bf_lo(xw.y), bf_hi(xw.y)};
        const f32x4 r0 = sigm4(vr + ba0), i0 = sigm4(vi + bx0), la0 = r0 * sp0; f32x4 b0;
#pragma unroll
        for (int j = 0; j < 4; ++j) { const float x = -2.f * la0[j];
            const float em = x < 0.03f ? x * (1.f - x * (0.5f - x * (0.16666667f - x * 0.041666668f))) : 1.f - __expf(-x);
            b0[j] = __builtin_sqrtf(em) * i0[j] * xc[j]; }
        u32x2 wl, wb; wl.x = pk2(la0[0], la0[1]); wl.y = pk2(la0[2], la0[3]); wb.x = pk2(b0[0], b0[1]); wb.y = pk2(b0[2], b0[3]);
        *(u32x2*)(LA + (size_t)row * DRNN + ch) = wl; *(u32x2*)(BV + (size_t)row * DRNN + ch) = wb;
    }
};
struct EpiG {
    static constexpr bool PERM = true;
    bf16_t* G;
    __device__ __forceinline__ void operator()(EPI_ARGS) const {
#pragma unroll
        for (int ai = 0; ai < 2; ++ai)
#pragma unroll
            for (int m = 0; m < 4; ++m) {
                const int row = u.pm * 256 + ai * 128 + wr * 64 + m * 16 + fr;
#pragma unroll
                for (int bj = 0; bj < 2; ++bj) {
                    const int c = u.pn * 256 + bj * 128 + wc * 32 + 8 * fq;
                    *(u32x4*)(G + (size_t)row * 3072 + c) = pack8(sigm4(acc[ai][bj][m][0]), sigm4(acc[ai][bj][m][1]));
                    asm volatile("" ::: "memory");
                }
            }
    }
    __device__ __forceinline__ void sample(int row, int col, f32x4 v) const {
        v = sigm4(v); u32x2 w; w.x = pk2(v[0], v[1]); w.y = pk2(v[2], v[3]); *(u32x2*)(G + (size_t)row * 3072 + col) = w;
    }
};
struct EpiP {
    static constexpr bool PERM = true;
    const bf16_t* G; bf16_t* M; int goff; int first;
    __device__ __forceinline__ void operator()(EPI_ARGS) const {
#pragma unroll
        for (int ai = 0; ai < 2; ++ai)
#pragma unroll
            for (int bj = 0; bj < 2; ++bj) {
                const int c = u.pn * 256 + bj * 128 + wc * 32 + 8 * fq;
                u32x4 gw[4], ow[4];
#pragma unroll
                for (int m = 0; m < 4; ++m) { const int row = u.pm * 256 + ai * 128 + wr * 64 + m * 16 + fr;
                    gw[m] = *(const u32x4*)(G + (size_t)row * 3072 + goff + c);
                    if (!first) ow[m] = *(const u32x4*)(M + (size_t)row * DM + c); }
#pragma unroll
                for (int m = 0; m < 4; ++m) { const int row = u.pm * 256 + ai * 128 + wr * 64 + m * 16 + fr;
                    const F8 gt = unpack8(gw[m]);
                    f32x4 o0 = gt.a * acc[ai][bj][m][0], o1 = gt.b * acc[ai][bj][m][1];
                    if (!first) { const F8 old = unpack8(ow[m]); o0 += old.a; o1 += old.b; }
                    *(u32x4*)(M + (size_t)row * DM + c) = pack8(o0, o1); }
                asm volatile("" ::: "memory");
            }
    }
    __device__ __forceinline__ void sample(int row, int col, f32x4 v) const {
        const u32x2 g = *(const u32x2*)(G + (size_t)row * 3072 + goff + col); u32x2* mp = (u32x2*)(M + (size_t)row * DM + col);
        f32x4 o = (f32x4){bf_lo(g.x) * v[0], bf_hi(g.x) * v[1], bf_lo(g.y) * v[2], bf_hi(g.y) * v[3]};
        if (!first) { const u32x2 old = *mp; o += (f32x4){bf_lo(old.x), bf_hi(old.x), bf_lo(old.y), bf_hi(old.y)}; }
        u32x2 w; w.x = pk2(o[0], o[1]); w.y = pk2(o[2], o[3]); *mp = w;
    }
};
struct EpiX {
    static constexpr bool PERM = false;
    const float* xin_p; const float* xin_s; float* xout;
    __device__ __forceinline__ void operator()(EPI_ARGS) const {
#pragma unroll
        for (int ai = 0; ai < 2; ++ai)
#pragma unroll
            for (int mp = 0; mp < 2; ++mp) {
                f32x4 xv[2][2][2];
#pragma unroll
                for (int mm = 0; mm < 2; ++mm) { const int row = u.pm * 256 + ai * 128 + wr * 64 + (2 * mp + mm) * 16 + fr; const float* src = xin_p + (size_t)row * DM;
#pragma unroll
                    for (int bj = 0; bj < 2; ++bj)
#pragma unroll
                        for (int n = 0; n < 2; ++n) xv[mm][bj][n] = *(const f32x4*)(src + u.pn * 256 + bj * 128 + wc * 32 + 16 * n + 4 * fq); }
#pragma unroll
                for (int mm = 0; mm < 2; ++mm) { const int row = u.pm * 256 + ai * 128 + wr * 64 + (2 * mp + mm) * 16 + fr; float* dst = xout + (size_t)row * DM;
#pragma unroll
                    for (int bj = 0; bj < 2; ++bj)
#pragma unroll
                        for (int n = 0; n < 2; ++n) *(f32x4*)(dst + u.pn * 256 + bj * 128 + wc * 32 + 16 * n + 4 * fq) = xv[mm][bj][n] + acc[ai][bj][2 * mp + mm][n]; }
                asm volatile("" ::: "memory");
            }
    }
    __device__ __forceinline__ void sample(int row, int col, f32x4 v) const {
        *(f32x4*)(xout + (size_t)row * DM + col) = *(const f32x4*)(xin_s + (size_t)(row - MPR) * DM + col) + v;
    }
};
struct EpiGpre {
    static constexpr bool PERM = true;
    bf16_t* GP; float* out; int l;
    __device__ __forceinline__ void operator()(EPI_ARGS) const {
        const bool st = ((u.pm & 7) == 7) || u.pm == 64;
#pragma unroll
        for (int ai = 0; ai < 2; ++ai)
#pragma unroll
            for (int m = 0; m < 4; ++m) {
                const int row = u.pm * 256 + ai * 128 + wr * 64 + m * 16 + fr;
#pragma unroll
                for (int bj = 0; bj < 2; ++bj) {
                    const f32x4 v0 = acc[ai][bj][m][0], v1 = acc[ai][bj][m][1];
                    const int c = u.pn * 256 + bj * 128 + wc * 32 + 8 * fq;
                    if (st) {
                        float* o = nullptr;
                        if (row < MPR) { const int t = row & 2047, b = row >> 11; if (t >= 2046) o = out + O_FF_P + ((size_t)(l * NB + b) * 2 + (t - 2046)) * DFF + c; }
                        else if (row < MROWS) { const int s = row - MPR; o = out + O_FF_S + ((size_t)(l * NS + s) * 2 + 1) * DFF + c; }
                        if (o) { *(f32x4*)o = v0; *(f32x4*)(o + 4) = v1; }
                    }
                    *(u32x4*)(GP + (size_t)row * 3072 + c) = pack8(v0, v1);
                    asm volatile("" ::: "memory");
                }
            }
    }
    __device__ __forceinline__ void sample(int row, int col, f32x4 v) const {
        *(f32x4*)(out + O_FF_S + ((size_t)(l * NS + (row - MPR)) * 2 + 1) * DFF + col) = v;
        u32x2 w; w.x = pk2(v[0], v[1]); w.y = pk2(v[2], v[3]); *(u32x2*)(GP + (size_t)row * 3072 + col) = w;
    }
};
struct EpiH {
    static constexpr bool PERM = true;
    const bf16_t* GP; bf16_t* H; const float* cw; const float* cb; const float* st;
    __device__ __forceinline__ void operator()(EPI_ARGS) const {
#pragma unroll
        for (int bj = 0; bj < 2; ++bj) {
            const int c = u.pn * 256 + bj * 128 + wc * 32 + 8 * fq;
            const f32x4 w00 = *(const f32x4*)(cw + c), w01 = *(const f32x4*)(cw + c + 4);
            const f32x4 w10 = *(const f32x4*)(cw + DFF + c), w11 = *(const f32x4*)(cw + DFF + c + 4);
            const f32x4 w20 = *(const f32x4*)(cw + 2 * DFF + c), w21 = *(const f32x4*)(cw + 2 * DFF + c + 4);
            const f32x4 cb0 = *(const f32x4*)(cb + c), cb1 = *(const f32x4*)(cb + c + 4);
#pragma unroll
            for (int ai = 0; ai < 2; ++ai) {
                const int base = u.pm * 256 + ai * 128 + wr * 64, t0 = base & 2047;
                u32x4 q0[4], E = (u32x4){0u, 0u, 0u, 0u};
#pragma unroll
                for (int m = 0; m < 4; ++m) q0[m] = *(const u32x4*)(GP + (size_t)(base + 16 * m + fr) * 3072 + c);
                if (fr >= 14 && t0 != 0) E = *(const u32x4*)(GP + (size_t)(base - 16 + fr) * 3072 + c);
#pragma unroll
                for (int m = 0; m < 4; ++m) { const int row = base + 16 * m + fr, t = row & 2047;
                    const u32x4 P = m ? q0[m > 0 ? m - 1 : 0] : E; u32x4 r1, r2;
                    r1.x = dpp_shr1(dpp_ror1(P.x), q0[m].x); r1.y = dpp_shr1(dpp_ror1(P.y), q0[m].y); r1.z = dpp_shr1(dpp_ror1(P.z), q0[m].z); r1.w = dpp_shr1(dpp_ror1(P.w), q0[m].w);
                    r2.x = dpp_shr2(dpp_ror2(P.x), q0[m].x); r2.y = dpp_shr2(dpp_ror2(P.y), q0[m].y); r2.z = dpp_shr2(dpp_ror2(P.z), q0[m].z); r2.w = dpp_shr2(dpp_ror2(P.w), q0[m].w);
                    const F8 g0 = unpack8(q0[m]), g1 = unpack8(r1), g2 = unpack8(r2);
                    const float k1 = t >= 1 ? 1.f : 0.f, k2 = t >= 2 ? 1.f : 0.f;
                    const f32x4 s0 = cb0 + w20 * g0.a + (w10 * g1.a) * k1 + (w00 * g2.a) * k2, s1 = cb1 + w21 * g0.b + (w11 * g1.b) * k1 + (w01 * g2.b) * k2;
                    *(u32x4*)(H + (size_t)row * 3072 + c) = pack8(gelu4(s0) * acc[ai][bj][m][0], gelu4(s1) * acc[ai][bj][m][1]); }
                asm volatile("" ::: "memory");
            }
        }
    }
    __device__ __forceinline__ void sample(int row, int col, f32x4 v) const {
        const u32x2 gw = *(const u32x2*)(GP + (size_t)row * 3072 + col); const f32x4 g0 = (f32x4){bf_lo(gw.x), bf_hi(gw.x), bf_lo(gw.y), bf_hi(gw.y)};
        const float* sp = st + (size_t)(row - MPR) * 2 * DFF + col;
        const f32x4 s0 = *(const f32x4*)(cb + col) + *(const f32x4*)(cw + 2 * DFF + col) * g0 + *(const f32x4*)(cw + col) * *(const f32x4*)sp + *(const f32x4*)(cw + DFF + col) * *(const f32x4*)(sp + DFF);
        const f32x4 h = gelu4(s0) * v; u32x2 w; w.x = pk2(h[0], h[1]); w.y = pk2(h[2], h[3]); *(u32x2*)(H + (size_t)row * 3072 + col) = w;
    }
};

template <bool DUAL, class Epi>
__device__ __forceinline__ void sample_gemm(LAS unsigned char* lds, const bf16_t* A, int lda, const bf16_t* Bt, int ldb, int K, int nstrips, int bid, int G, const Epi& E, const int wvid) {
    int tid = TIDX; asm volatile("" : "+v"(tid));
    const int kw = __builtin_amdgcn_readfirstlane(tid >> 6), lane = tid & 63, fr = lane & 15, fq = lane >> 4;
    const int kslice = K >> 3, nks = kslice >> 5;
    LAS f32x4* part = (LAS f32x4*)lds;
    for (int strip = G - 1 - bid; strip < nstrips; strip += G) {
        int n0 = strip * 16, acol = 0, h = 0, cc = 0;
        if (DUAL) { h = strip >> 3; cc = (strip & 7) * 16; n0 = h * 256 + cc; acol = (h & ~1) * 128; }
        f32x4 acc[8], acc2[8];
#pragma unroll
        for (int m = 0; m < 8; ++m) { acc[m] = (f32x4){0.f, 0.f, 0.f, 0.f}; acc2[m] = acc[m]; }
        typedef const __attribute__((address_space(1))) bf16x8* gfrag;
        const bf16_t* bp = Bt + (size_t)(n0 + fr) * ldb + kw * kslice + 8 * fq;
        const bf16_t* ap = A + (size_t)fr * lda + acol + kw * kslice + 8 * fq;
#pragma unroll 1
        for (int ks0 = 0; ks0 < nks; ks0 += 2) {
            bf16x8 bb[2], bb2[2], aa[2][8];
#pragma unroll
            for (int u = 0; u < 2; ++u) if (ks0 + u < nks) {
                bb[u] = *(gfrag)(bp + (ks0 + u) * 32);
                if (DUAL) bb2[u] = *(gfrag)(bp + (size_t)128 * ldb + (ks0 + u) * 32);
#pragma unroll
                for (int m = 0; m < 8; ++m) aa[u][m] = *(gfrag)(ap + (size_t)(16 * m) * lda + (ks0 + u) * 32);
            }
            __builtin_amdgcn_sched_barrier(0);
#pragma unroll
            for (int u = 0; u < 2; ++u) if (ks0 + u < nks) {
#pragma unroll
                for (int m = 0; m < 8; ++m) { acc[m] = __builtin_amdgcn_mfma_f32_16x16x32_bf16(bb[u], aa[u][m], acc[m], 0, 0, 0);
                    if (DUAL) acc2[m] = __builtin_amdgcn_mfma_f32_16x16x32_bf16(bb2[u], aa[u][m], acc2[m], 0, 0, 0); }
            }
            __builtin_amdgcn_sched_barrier(0);
        }
#pragma unroll
        for (int m = 0; m < 8; ++m) part[(kw * 8 + m) * 64 + lane] = acc[m];
        __syncthreads();
        f32x4 v = part[kw * 64 + lane];
#pragma unroll
        for (int k2 = 1; k2 < 8; ++k2) v += part[(k2 * 8 + kw) * 64 + lane];
        const int row = MPR + 16 * kw + fr;
        if constexpr (DUAL) {
            __syncthreads();
#pragma unroll
            for (int m = 0; m < 8; ++m) part[(kw * 8 + m) * 64 + lane] = acc2[m];
            __syncthreads();
            f32x4 v2 = part[kw * 64 + lane];
#pragma unroll
            for (int k2 = 1; k2 < 8; ++k2) v2 += part[(k2 * 8 + kw) * 64 + lane];
            E.sample2(row, h * 128 + cc + 4 * fq, v, v2);
        } else E.sample(row, n0 + 4 * fq, v);
        __syncthreads();
    }
}


__device__ __forceinline__ void transpose_item(const float* W, int K, int N, bf16_t* WT, LAS float* scr, int item, int lane) {
    const int nblk = N / 32, kb = item / nblk, nb = item % nblk, k0 = 64 * kb, n0 = 32 * nb;
    float tv[32];
#pragma unroll
    for (int i = 0; i < 32; ++i) tv[i] = W[(size_t)(k0 + 2 * i + (lane >> 5)) * N + n0 + (lane & 31)];
#pragma unroll
    for (int i = 0; i < 32; ++i) scr[(2 * i + (lane >> 5)) * 33 + (lane & 31)] = tv[i];
    asm volatile("s_waitcnt lgkmcnt(0)" ::: "memory");
    const int c = lane & 7;
#pragma unroll
    for (int j = 0; j < 4; ++j) { const int n = (lane >> 3) + 8 * j; const LAS float* s = scr + (8 * c) * 33 + n;
        u32x4 o; o.x = pk2(s[0 * 33], s[1 * 33]); o.y = pk2(s[2 * 33], s[3 * 33]); o.z = pk2(s[4 * 33], s[5 * 33]); o.w = pk2(s[6 * 33], s[7 * 33]);
        *(u32x4*)(WT + (size_t)(n0 + n) * K + k0 + 8 * c) = o; }
    asm volatile("s_waitcnt lgkmcnt(0)" ::: "memory");
}
__device__ __forceinline__ void rms_row_bf16(const float* xrow, const float* g, bf16_t* orow, int lane) {
    const f32x4* xr = (const f32x4*)xrow + lane; f32x4 v[4]; float s = 0.f;
#pragma unroll
    for (int j = 0; j < 4; ++j) { v[j] = xr[64 * j]; s += (v[j][0] * v[j][0] + v[j][1] * v[j][1]) + (v[j][2] * v[j][2] + v[j][3] * v[j][3]); }
    const float rstd = rsqrtf(wave_sum(s) * (1.f / DM) + 1e-6f);
    const f32x4* gr = (const f32x4*)g + lane; u32x2* o8 = (u32x2*)orow + lane;
#pragma unroll
    for (int j = 0; j < 4; ++j) { const f32x4 o = v[j] * rstd * gr[64 * j]; u32x2 w; w.x = pk2(o[0], o[1]); w.y = pk2(o[2], o[3]); o8[64 * j] = w; }
}
__device__ __forceinline__ void rms_rows(const float* xp, const float* xs, const float* g, bf16_t* XN, int gw, int ngw, int lane) {
    for (int row = gw; row < MPAD; row += ngw) {
        if (row < MROWS) rms_row_bf16(row < MPR ? xp + (size_t)row * DM : xs + (size_t)(row - MPR) * DM, g, XN + (size_t)row * DM, lane);
        else { u32x2* o8 = (u32x2*)(XN + (size_t)row * DM) + lane; u32x2 z; z.x = 0u; z.y = 0u;
#pragma unroll
            for (int j = 0; j < 4; ++j) o8[64 * j] = z; }
    }
}

__device__ __forceinline__ void phase_prep(const Params& p, int l, LAS unsigned char* lds, const float* xp, const float* xs, int bid, int G, const int wvid) {
    int tid = TIDX; asm volatile("" : "+v"(tid));
    const int wave = tid >> 6, lane = tid & 63;
    const int gw = bid * 8 + wave, ngw = G * 8;
    bf16_t* W = (bf16_t*)(p.ws + WS_W);
    LAS float* scr = (LAS float*)(lds + wave * 8448);
    const float* w_in = p.in[7] + (size_t)l * DM * INCOLS; const float* w_pb = p.in[21] + (size_t)l * DRNN * DM; const float* w_pc = p.in[22] + (size_t)l * DCH * DM;
    const float* w_o = p.in[23] + (size_t)l * DM * DM; const float* wg = p.in[25] + (size_t)l * DM * DFF; const float* wu = p.in[26] + (size_t)l * DM * DFF; const float* wd = p.in[29] + (size_t)l * DFF * DM;
    constexpr int I_IN = (DM / 64) * (INCOLS / 32), I_PB = (DRNN / 64) * (DM / 32), I_PC = (DCH / 64) * (DM / 32), I_O = (DM / 64) * (DM / 32), I_G = (DM / 64) * (DFF / 32), I_D = (DFF / 64) * (DM / 32);
    constexpr int NITEMS = I_IN + I_PB + I_PC + I_O + 2 * I_G + I_D;
    for (int it = gw; it < NITEMS; it += ngw) {
        int r = it;
        if (r < I_IN) { transpose_item(w_in, DM, INCOLS, W + W_IN, scr, r, lane); continue; } r -= I_IN;
        if (r < I_PB) { transpose_item(w_pb, DRNN, DM, W + W_PB, scr, r, lane); continue; } r -= I_PB;
        if (r < I_PC) { transpose_item(w_pc, DCH, DM, W + W_PC, scr, r, lane); continue; } r -= I_PC;
        if (r < I_O) { transpose_item(w_o, DM, DM, W + W_O, scr, r, lane); continue; } r -= I_O;
        if (r < I_G) { transpose_item(wg, DM, DFF, W + W_G, scr, r, lane); continue; } r -= I_G;
        if (r < I_G) { transpose_item(wu, DM, DFF, W + W_U, scr, r, lane); continue; } r -= I_G;
        transpose_item(wd, DFF, DM, W + W_D, scr, r, lane);
    }
    const int gt = bid * 512 + tid, ngt = G * 512;
    { const float* pw = p.in[8] + (size_t)l * 4 * 128 * 128; const float* ps = p.in[9] + (size_t)l * DPOOL; const float* w_pa = p.in[20] + (size_t)l * DPOOL * DM;
      for (int idx = gt; idx < DPOOL * (DM / 4); idx += ngt) { const int n = (idx & 255) * 4, kp = idx >> 8, g = kp >> 7;
          const float* pr = pw + (size_t)kp * 128; const float* sr = ps + g * 128; const float* wr_ = w_pa + (size_t)g * 128 * DM + n; f32x4 s4 = (f32x4){0.f, 0.f, 0.f, 0.f};
#pragma unroll 16
          for (int j = 0; j < 128; ++j) s4 += (pr[j] * sr[j]) * *(const f32x4*)(wr_ + (size_t)j * DM);
          W[W_PA + (size_t)n * DPOOL + kp] = f2bf(s4[0]); W[W_PA + (size_t)(n + 1) * DPOOL + kp] = f2bf(s4[1]);
          W[W_PA + (size_t)(n + 2) * DPOOL + kp] = f2bf(s4[2]); W[W_PA + (size_t)(n + 3) * DPOOL + kp] = f2bf(s4[3]); } }
    { const float* wa = p.in[12] + (size_t)l * 8 * 128 * 128; const float* wx = p.in[14] + (size_t)l * 8 * 128 * 128;
      for (int idx = gt; idx < 8 * 256 * 256; idx += ngt) { const int k = idx & 255, n = (idx >> 8) & 255, h = idx >> 16; float v = 0.f;
          if ((k >> 7) == (h & 1)) v = (n < 128 ? wa : wx)[((size_t)h * 128 + (k & 127)) * 128 + (n & 127)];
          W[W_RI + idx] = f2bf(v); } }
    if (gt < DRNN) { const float y = __expf(-p.in[16][(size_t)l * DRNN + gt]);
        const float lp = y < 0.05f ? y * (1.f - y * (0.5f - y * (0.33333334f - y * (0.25f - y * 0.2f)))) : __logf(1.f + y);
        ((float*)(p.ws + WS_SP))[gt] = -8.f * lp; }
    rms_rows(xp, xs, p.in[6] + (size_t)l * DM, (bf16_t*)(p.ws + WS_XN), gw, ngw, lane);
}

__device__ __forceinline__ void phase_mix(const Params& p, int l, LAS unsigned char* lds, int bid, int G, const int wvid) {
    int tid = TIDX; asm volatile("" : "+v"(tid));
    const int wave = tid >> 6, lane = tid & 63;
    const bf16_t* Za = (const bf16_t*)(p.ws + WS_Z); const bf16_t* Zbx = Za + UE; const bf16_t* Zgu = Za + 5 * UE; const bf16_t* Zgv = Za + 6 * UE;
    bf16_t* Y0 = (bf16_t*)(p.ws + WS_Y); bf16_t* Yd = Y0 + 2 * UE; bf16_t* Yc = Y0 + 3 * UE;
    const float* vg = p.in[17] + (size_t)l * DCH; const float* cws = p.in[18] + (size_t)l * 4 * 128 * 128; const float* cbs = p.in[19] + (size_t)l * 4 * 128;
    if (bid < 128) {
        const int r0 = bid * 128;
        LAS float* rstd = (LAS float*)lds; LAS bf16_t* VT = (LAS bf16_t*)(lds + 1024);
        { const int j = tid >> 2, q = tid & 3; const u32x4* src = (const u32x4*)(Zgv + (size_t)(r0 + j) * DCH + q * 128); float s = 0.f;
#pragma unroll
          for (int i = 0; i < 16; ++i) { const F8 v = unpack8(src[i]); s += (v.a[0] * v.a[0] + v.a[1] * v.a[1]) + (v.a[2] * v.a[2] + v.a[3] * v.a[3]) + (v.b[0] * v.b[0] + v.b[1] * v.b[1]) + (v.b[2] * v.b[2] + v.b[3] * v.b[3]); }
          s += __shfl_xor(s, 1); s += __shfl_xor(s, 2);
          if (q == 0) rstd[j] = rsqrtf(s * (1.f / DCH) + 1e-6f); }
        __syncthreads();
        const int fr = lane & 15, fq = lane >> 4;
        for (int g = 0; g < 4; ++g) {
            { const int j = tid >> 2, q = tid & 3; const float rs = rstd[j];
              const u32x4* src = (const u32x4*)(Zgv + (size_t)(r0 + j) * DCH + g * 128 + q * 32); const float* gg = vg + g * 128 + q * 32;
#pragma unroll
              for (int i = 0; i < 4; ++i) { const F8 v = unpack8(src[i]); const f32x4 g0 = *(const f32x4*)(gg + 8 * i), g1 = *(const f32x4*)(gg + 8 * i + 4);
                  const int d = q * 32 + 8 * i;
#pragma unroll
                  for (int e = 0; e < 4; ++e) { VT[(d + e) * 136 + j] = f2bf(v.a[e] * rs * g0[e]); VT[(d + 4 + e) * 136 + j] = f2bf(v.b[e] * rs * g1[e]); } } }
            __syncthreads();
            const int i = 16 * wave + fr; bf16x8 af[4];
#pragma unroll
            for (int ks = 0; ks < 4; ++ks) { const int k0 = 32 * ks + 8 * fq; const float* wrow = cws + ((size_t)g * 128 + i) * 128 + k0;
                const f32x4 a0 = *(const f32x4*)wrow, a1 = *(const f32x4*)(wrow + 4); u32x4 w;
                w.x = pk2(k0 + 0 <= i ? a0[0] : 0.f, k0 + 1 <= i ? a0[1] : 0.f); w.y = pk2(k0 + 2 <= i ? a0[2] : 0.f, k0 + 3 <= i ? a0[3] : 0.f);
                w.z = pk2(k0 + 4 <= i ? a1[0] : 0.f, k0 + 5 <= i ? a1[1] : 0.f); w.w = pk2(k0 + 6 <= i ? a1[2] : 0.f, k0 + 7 <= i ? a1[3] : 0.f);
                af[ks] = __builtin_bit_cast(bf16x8, w); }
            const float bsv = cbs[g * 128 + i];
#pragma unroll
            for (int dt = 0; dt < 8; ++dt) {
                f32x4 c4 = (f32x4){0.f, 0.f, 0.f, 0.f};
#pragma unroll
                for (int ks = 0; ks < 4; ++ks) { const bf16x8 vf = *(const LAS bf16x8*)(VT + (16 * dt + fr) * 136 + 32 * ks + 8 * fq);
                    c4 = __builtin_amdgcn_mfma_f32_16x16x32_bf16(vf, af[ks], c4, 0, 0, 0); }
                const size_t off = (size_t)(r0 + i) * DCH + g * 128 + 16 * dt + 4 * fq;
                const u32x2 uu = *(const u32x2*)(Zgu + off); u32x2 o;
                o.x = pk2(bf_lo(uu.x) * (c4[0] + bsv), bf_hi(uu.x) * (c4[1] + bsv)); o.y = pk2(bf_lo(uu.y) * (c4[2] + bsv), bf_hi(uu.y) * (c4[3] + bsv));
                *(u32x2*)(Yc + off) = o;
            }
            __syncthreads();
        }
    } else if (bid < 144) {
        const int s = (bid - 128) * 8 + wave, row = MPR + s, c = lane * 8, g = lane >> 4;
        const F8 v = unpack8(*(const u32x4*)(Zgv + (size_t)row * DCH + c));
        float ss = (v.a[0] * v.a[0] + v.a[1] * v.a[1]) + (v.a[2] * v.a[2] + v.a[3] * v.a[3]) + (v.b[0] * v.b[0] + v.b[1] * v.b[1]) + (v.b[2] * v.b[2] + v.b[3] * v.b[3]);
        const float rs = rsqrtf(wave_sum(ss) * (1.f / DCH) + 1e-6f);
        const f32x4 vn0 = v.a * rs * *(const f32x4*)(vg + c), vn1 = v.b * rs * *(const f32x4*)(vg + c + 4);
        float* ov = p.out + O_CV_S + ((size_t)l * NS + s) * DCH + c; *(f32x4*)ov = vn0; *(f32x4*)(ov + 4) = vn1;
        const float w00 = cws[(size_t)g * 128 * 128], b0 = cbs[g * 128];
        const F8 uu = unpack8(*(const u32x4*)(Zgu + (size_t)row * DCH + c));
        *(u32x4*)(Yc + (size_t)row * DCH + c) = pack8(uu.a * (vn0 * w00 + b0), uu.b * (vn1 * w00 + b0));
    }
    if (bid >= 128) {
    const int et = (bid - 128) * 512 + tid, net = (G - 128) * 512;
    { const float* cw = p.in[10] + (size_t)l * 4 * DRNN; const float* cb = p.in[11] + (size_t)l * DRNN; const float* st = p.in[3] + (size_t)l * NS * 3 * DRNN;
      for (int idx = et; idx < (MPR / 8) * 128; idx += net) { const int r0 = (idx >> 7) * 8, c = (idx & 127) * 8, t0 = r0 & 2047;
          const f32x4 w00 = *(const f32x4*)(cw + c), w01 = *(const f32x4*)(cw + c + 4), w10 = *(const f32x4*)(cw + DRNN + c), w11 = *(const f32x4*)(cw + DRNN + c + 4);
          const f32x4 w20 = *(const f32x4*)(cw + 2 * DRNN + c), w21 = *(const f32x4*)(cw + 2 * DRNN + c + 4), w30 = *(const f32x4*)(cw + 3 * DRNN + c), w31 = *(const f32x4*)(cw + 3 * DRNN + c + 4);
          const f32x4 b0 = *(const f32x4*)(cb + c), b1 = *(const f32x4*)(cb + c + 4);
          F8 x1, x2, x3; const u32x4 zz = (u32x4){0u, 0u, 0u, 0u};
          x3 = unpack8(t0 >= 3 ? *(const u32x4*)(Zbx + (size_t)(r0 - 3) * DRNN + c) : zz); x2 = unpack8(t0 >= 2 ? *(const u32x4*)(Zbx + (size_t)(r0 - 2) * DRNN + c) : zz); x1 = unpack8(t0 >= 1 ? *(const u32x4*)(Zbx + (size_t)(r0 - 1) * DRNN + c) : zz);
#pragma unroll
          for (int i = 0; i < 8; ++i) { const F8 x0 = unpack8(*(const u32x4*)(Zbx + (size_t)(r0 + i) * DRNN + c));
              *(u32x4*)(Y0 + (size_t)(r0 + i) * DRNN + c) = pack8(b0 + w30 * x0.a + w20 * x1.a + w10 * x2.a + w00 * x3.a, b1 + w31 * x0.b + w21 * x1.b + w11 * x2.b + w01 * x3.b);
              x3 = x2; x2 = x1; x1 = x0; } }
      for (int idx = et; idx < NS * 128; idx += net) { const int row = MPR + (idx >> 7), c = (idx & 127) * 8;
          f32x4 s0 = *(const f32x4*)(cb + c), s1 = *(const f32x4*)(cb + c + 4);
          { const F8 x = unpack8(*(const u32x4*)(Zbx + (size_t)row * DRNN + c)); s0 += *(const f32x4*)(cw + 3 * DRNN + c) * x.a; s1 += *(const f32x4*)(cw + 3 * DRNN + c + 4) * x.b; }
          const float* sp = st + (size_t)(row - MPR) * 3 * DRNN + c;
#pragma unroll
          for (int k = 0; k < 3; ++k) { s0 += *(const f32x4*)(cw + k * DRNN + c) * *(const f32x4*)(sp + k * DRNN); s1 += *(const f32x4*)(cw + k * DRNN + c + 4) * *(const f32x4*)(sp + k * DRNN + 4); }
          *(u32x4*)(Y0 + (size_t)row * DRNN + c) = pack8(s0, s1); } }
    { const float* st = p.in[2] + (size_t)l * NS * 15 * DPOOL;
      for (int idx = et; idx < (MPR / 8) * 64; idx += net) { const int g = (idx >> 6) & 3, rb = ((idx >> 8) << 2) + ((idx >> 4) & 3), c = g * 128 + (idx & 15) * 8, w = 2 << g, r0 = rb * 8, t0 = r0 & 2047;
          f32x4 s0 = (f32x4){0.f, 0.f, 0.f, 0.f}, s1 = s0;
#pragma unroll
          for (int j = 1; j < 16; ++j) if (j < w && t0 >= j) { const F8 x = unpack8(*(const u32x4*)(Za + (size_t)(r0 - j) * DPOOL + c)); s0 += x.a; s1 += x.b; }
#pragma unroll
          for (int i = 0; i < 8; ++i) { const F8 cur = unpack8(*(const u32x4*)(Za + (size_t)(r0 + i) * DPOOL + c)); s0 += cur.a; s1 += cur.b;
              const int t = t0 + i; const float ic = 1.f / (float)(t + 1 < w ? t + 1 : w);
              *(u32x4*)(Yd + (size_t)(r0 + i) * DPOOL + c) = pack8(s0 * ic - cur.a, s1 * ic - cur.b);
              if (t >= w - 1) { const F8 old = unpack8(*(const u32x4*)(Za + (size_t)(r0 + i - (w - 1)) * DPOOL + c)); s0 -= old.a; s1 -= old.b; } } }
      for (int idx = et; idx < NS * 64; idx += net) { const int row = MPR + (idx >> 6), c = (idx & 63) * 8, w = 2 << (c >> 7);
          const F8 cur = unpack8(*(const u32x4*)(Za + (size_t)row * DPOOL + c)); f32x4 s0 = cur.a, s1 = cur.b;
          const float* sp = st + (size_t)(row - MPR) * 15 * DPOOL + c;
          for (int j = 1; j < w; ++j) { s0 += *(const f32x4*)(sp + (15 - j) * DPOOL); s1 += *(const f32x4*)(sp + (15 - j) * DPOOL + 4); }
          const float ic = 1.f / (float)w;
          *(u32x4*)(Yd + (size_t)row * DPOOL + c) = pack8(s0 * ic - cur.a, s1 * ic - cur.b); } }
    }
    const int gt = bid * 512 + tid, ngt = G * 512;
    { const float* sp = p.in[2] + (size_t)l * NS * 15 * DPOOL; float* o = p.out + O_POOL_S + (size_t)l * NS * 15 * DPOOL;
      for (int idx = gt; idx < NS * 14 * (DPOOL / 4); idx += ngt) { const int c = (idx & 127) * 4, r = (idx >> 7) % 14, s = (idx >> 7) / 14;
          *(f32x4*)(o + ((size_t)s * 15 + r) * DPOOL + c) = *(const f32x4*)(sp + ((size_t)s * 15 + r + 1) * DPOOL + c); } }
    { const float* sp = p.in[3] + (size_t)l * NS * 3 * DRNN; float* o = p.out + O_RC_S + (size_t)l * NS * 3 * DRNN;
      for (int idx = gt; idx < NS * 2 * (DRNN / 4); idx += ngt) { const int c = (idx & 255) * 4, r = (idx >> 8) & 1, s = idx >> 9;
          *(f32x4*)(o + ((size_t)s * 3 + r) * DRNN + c) = *(const f32x4*)(sp + ((size_t)s * 3 + r + 1) * DRNN + c); } }
    { const float* sp = p.in[5] + (size_t)l * NS * 2 * DFF; float* o = p.out + O_FF_S + (size_t)l * NS * 2 * DFF;
      for (int idx = gt; idx < NS * (DFF / 4); idx += ngt) { const int c = (idx % 768) * 4, s = idx / 768;
          *(f32x4*)(o + ((size_t)s * 2) * DFF + c) = *(const f32x4*)(sp + ((size_t)s * 2 + 1) * DFF + c); } }
}

__device__ __forceinline__ void phase_scan(const Params& p, int l, LAS unsigned char* lds, int bid, int G, const int wvid) {
    int tid = TIDX; asm volatile("" : "+v"(tid));
    const bf16_t* LA = (const bf16_t*)(p.ws + WS_Z) + UE; const bf16_t* BV = (const bf16_t*)(p.ws + WS_Z) + 5 * UE; const bf16_t* GB = (const bf16_t*)(p.ws + WS_Z) + 3 * UE;
    bf16_t* Y0 = (bf16_t*)(p.ws + WS_Y);
    LAS float* sP = (LAS float*)lds; LAS float* sH = sP + 4096; LAS float* sC = sH + 4096; LAS float* sPg = sC + 4096; LAS float* sHg = sPg + 512;
    for (int item = bid; item < 256; item += G) {
        const int b = item >> 5, c0 = (item & 31) * 32, seg = tid >> 2, lg = tid & 3;
        const size_t base = ((size_t)b * SEQ + seg * 16) * DRNN + c0 + lg * 8;
        f32x4 P0 = (f32x4){1.f, 1.f, 1.f, 1.f}, P1 = P0, h0 = (f32x4){0.f, 0.f, 0.f, 0.f}, h1 = h0;
#pragma unroll
        for (int t = 0; t < 16; ++t) { const F8 la = unpack8(*(const u32x4*)(LA + base + (size_t)t * DRNN)), bv = unpack8(*(const u32x4*)(BV + base + (size_t)t * DRNN));
            f32x4 a0, a1;
#pragma unroll
            for (int e = 0; e < 4; ++e) { a0[e] = __builtin_amdgcn_exp2f(1.442695041f * la.a[e]); a1[e] = __builtin_amdgcn_exp2f(1.442695041f * la.b[e]); }
            h0 = a0 * h0 + bv.a; h1 = a1 * h1 + bv.b; P0 *= a0; P1 *= a1; }
        { const int o = seg * 32 + lg * 8; *(LAS f32x4*)(sP + o) = P0; *(LAS f32x4*)(sP + o + 4) = P1; *(LAS f32x4*)(sH + o) = h0; *(LAS f32x4*)(sH + o + 4) = h1; }
        __syncthreads();
        const int ch = tid & 31, sg = tid >> 5;
        { float Pg = 1.f, hg = 0.f;
#pragma unroll
          for (int k = 0; k < 8; ++k) { const float pp = sP[(sg * 8 + k) * 32 + ch], hh = sH[(sg * 8 + k) * 32 + ch]; hg = pp * hg + hh; Pg *= pp; }
          sPg[sg * 32 + ch] = Pg; sHg[sg * 32 + ch] = hg; }
        __syncthreads();
        { float carry = 0.f;
          for (int k = 0; k < sg; ++k) carry = sPg[k * 32 + ch] * carry + sHg[k * 32 + ch];
#pragma unroll
          for (int k = 0; k < 8; ++k) { const int o = (sg * 8 + k) * 32 + ch; sC[o] = carry; carry = sP[o] * carry + sH[o]; }
          if (sg == 15) p.out[O_H_P + ((size_t)l * NB + b) * DRNN + c0 + ch] = carry; }
        __syncthreads();
        { const int o = seg * 32 + lg * 8; h0 = *(LAS f32x4*)(sC + o); h1 = *(LAS f32x4*)(sC + o + 4); }
#pragma unroll
        for (int t = 0; t < 16; ++t) { const F8 la = unpack8(*(const u32x4*)(LA + base + (size_t)t * DRNN)), bv = unpack8(*(const u32x4*)(BV + base + (size_t)t * DRNN)), gt = unpack8(*(const u32x4*)(GB + base + (size_t)t * DRNN));
            f32x4 a0, a1;
#pragma unroll
            for (int e = 0; e < 4; ++e) { a0[e] = __builtin_amdgcn_exp2f(1.442695041f * la.a[e]); a1[e] = __builtin_amdgcn_exp2f(1.442695041f * la.b[e]); }
            h0 = a0 * h0 + bv.a; h1 = a1 * h1 + bv.b;
            *(u32x4*)(Y0 + base + (size_t)t * DRNN) = pack8(gt.a * h0, gt.b * h1); }
        __syncthreads();
    }
    { const float* hin = p.in[4] + (size_t)l * NS * DRNN; float* oh = p.out + O_H_S + (size_t)l * NS * DRNN;
      for (int idx = bid * 512 + tid; idx < NS * DRNN; idx += G * 512) { const size_t off = (size_t)MPR * DRNN + idx;
          const float a = __expf(bf2f(LA[off])), h = a * hin[idx] + bf2f(BV[off]); oh[idx] = h; Y0[off] = f2bf(bf2f(GB[off]) * h); } }
}

__device__ __forceinline__ void phase_merge(const Params& p, int bid, int NG, const int wvid) {
    const bf16_t* G = (const bf16_t*)(p.ws + WS_Z); bf16_t* XN = (bf16_t*)(p.ws + WS_XN);
    int tid = TIDX; asm volatile("" : "+v"(tid));
    for (int idx = bid * 512 + tid; idx < MPAD * 128; idx += NG * 512) { const int row = idx >> 7, c = (idx & 127) * 8;
        const bf16_t* gr = G + (size_t)row * 3072 + c; const F8 a = unpack8(*(const u32x4*)gr), b = unpack8(*(const u32x4*)(gr + 1024)), d = unpack8(*(const u32x4*)(gr + 2048));
        *(u32x4*)(XN + (size_t)row * DM + c) = pack8(a.a + b.a + d.a, a.b + b.b + d.b); }
}

__device__ __forceinline__ void phase_final(const Params& p, int bid, int G, const int wvid) {
    int tid = TIDX; asm volatile("" : "+v"(tid));
    const int wave = tid >> 6, lane = tid & 63; const float* g = p.in[30];
    for (int row = bid * 8 + wave; row < MROWS; row += G * 8) {
        f32x4* xr = (f32x4*)(p.out + (size_t)row * DM) + lane; f32x4 v[4]; float s = 0.f;
#pragma unroll
        for (int j = 0; j < 4; ++j) { v[j] = xr[64 * j]; s += (v[j][0] * v[j][0] + v[j][1] * v[j][1]) + (v[j][2] * v[j][2] + v[j][3] * v[j][3]); }
        const float rstd = rsqrtf(wave_sum(s) * (1.f / DM) + 1e-6f); const f32x4* gr = (const f32x4*)g + lane;
#pragma unroll
        for (int j = 0; j < 4; ++j) xr[64 * j] = v[j] * rstd * gr[64 * j];
    }
}


#define XB_TMO      128
#define XB_XCNT(j)  (256  + 64 * (j))
#define XB_XSUB(j)  (1280 + 64 * (j))
#define XB_XGEN(j)  (2304 + 64 * (j))
#define XB_TOP      3328
#define XB_TOPGEN   3392
#define XCD_BAR_WORDS 3456
#define XB_SPIN_CAP (1u << 18)
__device__ __forceinline__ unsigned xb_ld(unsigned* p)              { return __hip_atomic_load(p, __ATOMIC_RELAXED, __HIP_MEMORY_SCOPE_AGENT); }
__device__ __forceinline__ unsigned xb_add(unsigned* p, unsigned v) { return __hip_atomic_fetch_add(p, v, __ATOMIC_RELAXED, __HIP_MEMORY_SCOPE_AGENT); }
__device__ __forceinline__ unsigned xb_xcc_id() { return (unsigned)__builtin_amdgcn_s_getreg((3 << 11) | 20) & 0xFu; }
#define XB_SPIN(cond, bar) do { unsigned _sp = 0; while (cond) { __builtin_amdgcn_s_sleep(1); \
    if ((++_sp & 255u) == 0u) { if (xb_ld(&(bar)[XB_TMO])) break; if (_sp > XB_SPIN_CAP) { atomicAdd(&(bar)[XB_TMO], 1u); break; } } } } while (0)
__device__ __forceinline__ void xcd_barrier_complete(unsigned* bar, unsigned x, unsigned G, unsigned& nloc, unsigned& nx) {
    unsigned sum, cnt, mine, sp = 0u;
    for (;;) {
        sum = 0u; cnt = 0u; mine = 0u;
#pragma unroll
        for (unsigned j = 0; j < 16; ++j) { const unsigned c = xb_ld(&bar[XB_XCNT(j)]); sum += c; cnt += (c > 0u) ? 1u : 0u; mine = (j == x) ? c : mine; }
        if (sum == G) break;
        __builtin_amdgcn_s_sleep(1);
        if ((++sp & 255u) == 0u) { if (xb_ld(&bar[XB_TMO])) break; if (sp > XB_SPIN_CAP) { atomicAdd(&bar[XB_TMO], 1u); break; } }
    }
    nloc = mine > 0u ? mine : 1u; nx = cnt > 0u ? cnt : 1u;
}
__device__ __forceinline__ void xcd_barrier(unsigned* bar, volatile LAS unsigned* st, unsigned G, const int wvid) {
    asm volatile("s_waitcnt vmcnt(0)" ::: "memory");
    __syncthreads();
    if (TIDX == 0) {
        const unsigned x = xb_xcc_id();
        __builtin_amdgcn_s_waitcnt(0);
        unsigned nloc = st[0], nx = st[1];
        if (nloc == 0u) { xcd_barrier_complete(bar, x, G, nloc, nx); st[0] = nloc; st[1] = nx; }
        const unsigned old = xb_add(&bar[XB_XSUB(x)], 1u);
        const unsigned gen = old / nloc;
        if (old + 1u == (gen + 1u) * nloc) {
            __builtin_amdgcn_fence(__ATOMIC_RELEASE, "agent");
            asm volatile("s_waitcnt vmcnt(0)" ::: "memory");
            const unsigned og = xb_add(&bar[XB_TOP], 1u);
            const unsigned tg = og / nx;
            if (og + 1u == (tg + 1u) * nx) xb_add(&bar[XB_TOPGEN], 1u);
            else XB_SPIN(xb_ld(&bar[XB_TOPGEN]) == tg, bar);
            __builtin_amdgcn_fence(__ATOMIC_ACQUIRE, "agent");
            xb_add(&bar[XB_XGEN(x)], 1u);
            asm volatile("s_waitcnt vmcnt(0)" ::: "memory");
        } else {
            XB_SPIN(xb_ld(&bar[XB_XGEN(x)]) == gen, bar);
            __builtin_amdgcn_fence(__ATOMIC_ACQUIRE, "agent");
            asm volatile("s_waitcnt vmcnt(0)" ::: "memory");
        }
    }
    __syncthreads();
}

__global__ void __launch_bounds__(512, 2) mega(Params pk) {
    extern __shared__ __attribute__((aligned(16))) unsigned char shm[];
    LAS unsigned char* lds = (LAS unsigned char*)shm;
    cg::grid_group grid = cg::this_grid();
    const int wvid = __builtin_amdgcn_readfirstlane((int)threadIdx.x >> 6);
    volatile LAS unsigned* bst = (volatile LAS unsigned*)(lds + 131072 + 1024);
    if (TIDX < 2) bst[TIDX] = 0u;
    if (blockIdx.x == 0) for (int i = TIDX; i < XCD_BAR_WORDS; i += 512) ((unsigned*)(pk.ws + WS_BAR))[i] = 0u;
    __syncthreads();
    bool posted = false;
    for (int ph = pk.ph_lo; ph < pk.ph_hi; ++ph) {
        Params p = pk; int G = gridDim.x, bid = blockIdx.x;
        asm volatile("" : "+s"(p.ws), "+s"(p.out), "+s"(G), "+s"(bid));
        bf16_t* XN = (bf16_t*)(p.ws + WS_XN); bf16_t* Z = (bf16_t*)(p.ws + WS_Z); bf16_t* Y0 = (bf16_t*)(p.ws + WS_Y); bf16_t* W = (bf16_t*)(p.ws + WS_W); bf16_t* H = (bf16_t*)(p.ws + WS_H);
        if (ph == NPH - 1) { phase_final(p, bid, G, wvid); }
        else {
            const int l = ph / PH_PER_LAYER, k = ph % PH_PER_LAYER;
            const float* xp = l == 0 ? p.in[0] : p.out; const float* xs = l == 0 ? p.in[1] : p.out + (size_t)MPR * DM;
            pg8::Order S; pg8::Gemm g;
            for (int rep = ((REPMASK >> k) & 1u) ? 2 : 1; rep > 0; --rep)
            switch (k) {
            case 0: phase_prep(p, l, lds, xp, xs, bid, G, wvid); break;
            case 1: { S.init(NTM, ZC / 256, G, bid, 0); g = {XN, W + W_IN, DM, DM, DM}; EpiZ E{Z, p.out, l}; pg8::gemm_phase(lds, g, S, E, wvid); } break;
            case 2: phase_mix(p, l, lds, bid, G, wvid); break;
            case 3: { S.init(64, 8, G, bid, 1); g = {Y0, W + W_RI, DRNN, 256, 256};
                      EpiRI E{Y0, Z + UE, Z + 5 * UE, p.in[13] + (size_t)l * DRNN, p.in[15] + (size_t)l * DRNN, (const float*)(p.ws + WS_SP)}; pg8::gemm_phase(lds, g, S, E, wvid);
                      sample_gemm<true>(lds, Y0 + (size_t)MPR * DRNN, DRNN, W + W_RI, 256, 256, 64, bid, G, E, wvid); } break;
            case 4: phase_scan(p, l, lds, bid, G, wvid); break;
            case 5: { S.init(64, 12, G, bid, 0); g = {XN, W + W_IN + (size_t)ZC * DM, DM, DM, DM}; EpiG E{Z}; pg8::gemm_phase(lds, g, S, E, wvid);
                      sample_gemm<false>(lds, XN + (size_t)MPR * DM, DM, W + W_IN + (size_t)ZC * DM, DM, DM, 3072 / 16, bid, G, E, wvid); } break;
            case 6: { { S.init(64, 4, G, bid, 0); g = {Y0 + 2 * UE, W + W_PA, DPOOL, DPOOL, DPOOL}; EpiP E{Z, XN, 0, 1}; pg8::gemm_phase(lds, g, S, E, wvid);
                        sample_gemm<false>(lds, Y0 + 2 * UE + (size_t)MPR * DPOOL, DPOOL, W + W_PA, DPOOL, DPOOL, 64, bid, G, E, wvid); }
                      { S.init(64, 4, G, bid, 0); g = {Y0, W + W_PB, DRNN, DRNN, DRNN}; EpiP E{Z, XN, 1024, 0}; pg8::gemm_phase(lds, g, S, E, wvid);
                        sample_gemm<false>(lds, Y0 + (size_t)MPR * DRNN, DRNN, W + W_PB, DRNN, DRNN, 64, bid, G, E, wvid); }
                      { S.init(64, 4, G, bid, 0); g = {Y0 + 3 * UE, W + W_PC, DCH, DCH, DCH}; EpiP E{Z, XN, 2048, 0}; pg8::gemm_phase(lds, g, S, E, wvid);
                        sample_gemm<false>(lds, Y0 + 3 * UE + (size_t)MPR * DCH, DCH, W + W_PC, DCH, DCH, 64, bid, G, E, wvid); } } break;
            case 7: break;
            case 8: { S.init(64, 4, G, bid, 0); g = {XN, W + W_O, DM, DM, DM}; EpiX E{xp, xs, p.out}; pg8::gemm_phase(lds, g, S, E, wvid);
                      sample_gemm<false>(lds, XN + (size_t)MPR * DM, DM, W + W_O, DM, DM, 64, bid, G, E, wvid); } break;
            case 9: { int tid = TIDX; asm volatile("" : "+v"(tid)); const int wave = tid >> 6, lane = tid & 63; rms_rows(p.out, p.out + (size_t)MPR * DM, p.in[24] + (size_t)l * DM, XN, bid * 8 + wave, G * 8, lane); } break;
            case 10: { S.init(64, 12, G, bid, 0); g = {XN, W + W_G, DM, DM, DM}; EpiGpre E{Z, p.out, l}; pg8::gemm_phase(lds, g, S, E, wvid);
                       sample_gemm<false>(lds, XN + (size_t)MPR * DM, DM, W + W_G, DM, DM, 192, bid, G, E, wvid); } break;
            case 11: { S.init(64, 12, G, bid, 0); g = {XN, W + W_U, DM, DM, DM};
                       EpiH E{Z, H, p.in[27] + (size_t)l * 3 * DFF, p.in[28] + (size_t)l * DFF, p.in[5] + (size_t)l * NS * 2 * DFF}; pg8::gemm_phase(lds, g, S, E, wvid);
                       sample_gemm<false>(lds, XN + (size_t)MPR * DM, DM, W + W_U, DM, DM, 192, bid, G, E, wvid); } break;
            default: { S.init(64, 4, G, bid, 0); g = {H, W + W_D, DFF, DFF, DFF}; EpiX E{p.out, p.out + (size_t)MPR * DM, p.out}; pg8::gemm_phase(lds, g, S, E, wvid);
                       sample_gemm<false>(lds, H + (size_t)MPR * DFF, DFF, W + W_D, DFF, DFF, 64, bid, G, E, wvid); } break;
            }
        }
        if (ph + 1 < pk.ph_hi && (ph % PH_PER_LAYER) != 7) {
            if (!posted) {
                grid.sync(); posted = true;
                if (TIDX == 0) (void)xb_add(&((unsigned*)(pk.ws + WS_BAR))[XB_XCNT(xb_xcc_id())], 1u);
            } else xcd_barrier((unsigned*)(pk.ws + WS_BAR), bst, (unsigned)gridDim.x, wvid);
            for (int e = 0; e < EXTRA_SYNCS; ++e) xcd_barrier((unsigned*)(pk.ws + WS_BAR), bst, (unsigned)gridDim.x, wvid);
        }
    }
}

extern "C" void kernel_launch(void* const* d_in, const int* in_sizes, int n_in, void* d_out, int out_size, void* d_ws, size_t ws_size, hipStream_t stream) {
    static int grid = 0;
    if (grid == 0) {
        int dev = 0, cus = 0, per_cu = 0;
        hipGetDevice(&dev);
        hipDeviceGetAttribute(&cus, hipDeviceAttributeMultiprocessorCount, dev);
        if (hipFuncSetAttribute((const void*)mega, hipFuncAttributeMaxDynamicSharedMemorySize, LDS_BYTES) != hipSuccess) fprintf(stderr, "kernel_launch: hipFuncSetAttribute failed\n");
        if (hipOccupancyMaxActiveBlocksPerMultiprocessor(&per_cu, (const void*)mega, 512, LDS_BYTES) != hipSuccess || per_cu < 1) { fprintf(stderr, "kernel_launch: occupancy query says %d blocks per CU\n", per_cu); per_cu = 1; }
        (void)hipGetLastError();
        grid = cus;
        if (n_in != 31 || ws_size < WS_END) fprintf(stderr, "kernel_launch: unexpected n_in %d / ws_size %zu (need %zu)\n", n_in, ws_size, (size_t)WS_END);
    }
    Params p{};
    for (int i = 0; i < 31; ++i) p.in[i] = (const float*)d_in[i];
    p.out = (float*)d_out; p.ws = (unsigned char*)d_ws; p.ph_lo = 0; p.ph_hi = NPH;
    void* args[] = {&p};
    hipError_t e = hipLaunchCooperativeKernel((const void*)mega, dim3(grid), dim3(512), args, LDS_BYTES, stream);
    if (e != hipSuccess) fprintf(stderr, "cooperative launch failed: %s (grid %d)\n", hipGetErrorString(e), grid);
}
```

```cpp
#include <hip/hip_runtime.h>
#include <hip/hip_cooperative_groups.h>
#include <cstdio>
#include <cstdint>
namespace cg = cooperative_groups;

#define LAS __attribute__((address_space(3)))
typedef unsigned short bf16_t;
typedef short bf16x8 __attribute__((ext_vector_type(8)));
typedef float f32x4 __attribute__((ext_vector_type(4)));
typedef float f32x2 __attribute__((ext_vector_type(2)));
typedef unsigned u32x4 __attribute__((ext_vector_type(4)));
typedef unsigned u32x2 __attribute__((ext_vector_type(2)));

constexpr int DM = 1024, NB = 8, SEQ = 2048, MPR = NB * SEQ, NS = 128, MROWS = MPR + NS, MPAD = 16640, NTM = MPAD / 256;
constexpr int DPOOL = 512, DRNN = 1024, DCH = 512, DFF = 3072, INCOLS = 6656, ZC = 3584;
constexpr int NLAYER = 2, PH_PER_LAYER = 13, NPH = NLAYER * PH_PER_LAYER + 1;
constexpr size_t O_Y = 0;
constexpr size_t O_POOL_P = (size_t)MROWS * DM;
constexpr size_t O_POOL_S = O_POOL_P + (size_t)2 * NB * 15 * DPOOL;
constexpr size_t O_RC_P = O_POOL_S + (size_t)2 * NS * 15 * DPOOL;
constexpr size_t O_RC_S = O_RC_P + (size_t)2 * NB * 3 * DRNN;
constexpr size_t O_H_P = O_RC_S + (size_t)2 * NS * 3 * DRNN;
constexpr size_t O_H_S = O_H_P + (size_t)2 * NB * DRNN;
constexpr size_t O_FF_P = O_H_S + (size_t)2 * NS * DRNN;
constexpr size_t O_FF_S = O_FF_P + (size_t)2 * NB * 2 * DFF;
constexpr size_t O_CV_S = O_FF_S + (size_t)2 * NS * 2 * DFF;
constexpr size_t UE = (size_t)MPAD * 512, UB = UE * 2;
constexpr size_t WS_BAR = 16384;
constexpr size_t WS_SP = 4096;
constexpr size_t WS_XN = 1u << 20;
constexpr size_t WS_Z = WS_XN + 2 * UB;
constexpr size_t WS_Y = WS_Z + 7 * UB;
constexpr size_t WS_W = WS_Y + 4 * UB;
constexpr size_t WS_H = WS_Z + 6 * UB;
constexpr size_t W_IN = 0;
constexpr size_t W_PA = W_IN + (size_t)INCOLS * DM;
constexpr size_t W_PB = W_PA + (size_t)DM * DPOOL;
constexpr size_t W_PC = W_PB + (size_t)DM * DRNN;
constexpr size_t W_O = W_PC + (size_t)DM * DCH;
constexpr size_t W_G = W_O + (size_t)DM * DM;
constexpr size_t W_U = W_G + (size_t)DFF * DM;
constexpr size_t W_D = W_U + (size_t)DFF * DM;
constexpr size_t W_RI = W_D + (size_t)DM * DFF;
constexpr size_t W_END = W_RI + (size_t)8 * 256 * 256;
constexpr size_t WS_END = WS_W + W_END * 2;
static_assert(WS_END <= (256u << 20), "workspace");
static_assert(WS_H + 6 * UB <= WS_W + (W_G)*2, "h overlay must not reach wg/wu/wd");
constexpr int LDS_BYTES = 131072 + 2048;
#ifndef REPMASK
#define REPMASK 0u
#endif
#ifndef EXTRA_SYNCS
#define EXTRA_SYNCS 0
#endif

struct Params { const float* in[31]; float* out; unsigned char* ws; int ph_lo, ph_hi; };

__device__ __forceinline__ int tidx_of(int wvid) { unsigned z = 0u; asm volatile("" : "+v"(z));
    return wvid * 64 + (int)__builtin_amdgcn_mbcnt_hi(~0u, __builtin_amdgcn_mbcnt_lo(~0u, z)); }
#define TIDX tidx_of(wvid)
__device__ __forceinline__ float bf_lo(unsigned w) { return __builtin_bit_cast(float, w << 16); }
__device__ __forceinline__ float bf_hi(unsigned w) { return __builtin_bit_cast(float, w & 0xffff0000u); }
__device__ __forceinline__ float bf2f(bf16_t b) { return __builtin_bit_cast(float, (unsigned)b << 16); }
typedef __bf16 bf16x2_t __attribute__((ext_vector_type(2)));
__device__ __forceinline__ unsigned pk2(float lo, float hi) { f32x2 v = {lo, hi}; bf16x2_t b = __builtin_convertvector(v, bf16x2_t); return __builtin_bit_cast(unsigned, b); }
__device__ __forceinline__ bf16_t f2bf(float f) { return (bf16_t)(pk2(f, 0.f) & 0xffffu); }
struct F8 { f32x4 a, b; };
__device__ __forceinline__ F8 unpack8(u32x4 w) { F8 r; r.a[0] = bf_lo(w.x); r.a[1] = bf_hi(w.x); r.a[2] = bf_lo(w.y); r.a[3] = bf_hi(w.y); r.b[0] = bf_lo(w.z); r.b[1] = bf_hi(w.z); r.b[2] = bf_lo(w.w); r.b[3] = bf_hi(w.w); return r; }
__device__ __forceinline__ u32x4 pack8(f32x4 a, f32x4 b) { u32x4 w; w.x = pk2(a[0], a[1]); w.y = pk2(a[2], a[3]); w.z = pk2(b[0], b[1]); w.w = pk2(b[2], b[3]); return w; }
__device__ __forceinline__ float gelu_t(float x) {
    const float u = 0.7978845608f * (x + 0.044715f * x * x * x);
    const float e = __builtin_amdgcn_exp2f(-2.885390082f * u);
    return x * __builtin_amdgcn_rcpf(1.f + e);
}
__device__ __forceinline__ f32x4 gelu4(f32x4 v) { f32x4 r; r[0] = gelu_t(v[0]); r[1] = gelu_t(v[1]); r[2] = gelu_t(v[2]); r[3] = gelu_t(v[3]); return r; }
__device__ __forceinline__ float sigm(float x) { return __builtin_amdgcn_rcpf(1.f + __builtin_amdgcn_exp2f(-1.442695041f * x)); }
__device__ __forceinline__ f32x4 sigm4(f32x4 v) { f32x4 r; r[0] = sigm(v[0]); r[1] = sigm(v[1]); r[2] = sigm(v[2]); r[3] = sigm(v[3]); return r; }
__device__ __forceinline__ float wave_sum(float v) {
#pragma unroll
    for (int o = 1; o < 64; o <<= 1) v += __shfl_xor(v, o);
    return v;
}

__device__ __forceinline__ unsigned dpp_shr1(unsigned old, unsigned src) { return (unsigned)__builtin_amdgcn_update_dpp((int)old, (int)src, 0x111, 0xf, 0xf, false); }
__device__ __forceinline__ unsigned dpp_shr2(unsigned old, unsigned src) { return (unsigned)__builtin_amdgcn_update_dpp((int)old, (int)src, 0x112, 0xf, 0xf, false); }
__device__ __forceinline__ unsigned dpp_ror1(unsigned src) { return (unsigned)__builtin_amdgcn_update_dpp(0, (int)src, 0x121, 0xf, 0xf, false); }
__device__ __forceinline__ unsigned dpp_ror2(unsigned src) { return (unsigned)__builtin_amdgcn_update_dpp(0, (int)src, 0x122, 0xf, 0xf, false); }

namespace pg8 {
constexpr int BM = 256, BK = 64, HALF = 128, HTB = HALF * BK * 2, STAGE_BYTES = 8 * HTB, NXCD = 8, WGM = 4;
__device__ __forceinline__ int lds_byte(int r, int c) { const int st = (r >> 4) * 2 + (c >> 5), rr = r & 15, cc = c & 31, ob = rr * 64 + cc * 2; return st * 1024 + (ob ^ (((ob >> 9) & 1) << 5)); }
__device__ __forceinline__ void stage_rc(int b, int& R, int& C) { const int st = b / 1024, sb = b % 1024, swz = sb ^ (((sb >> 9) & 1) << 5); R = (st >> 1) * 16 + swz / 64; C = (st & 1) * 32 + (swz % 64) / 2; }
__device__ __forceinline__ int perm32(int rho) { const int n = rho >> 4, i = rho & 15; return 8 * (i >> 2) + 4 * n + (i & 3); }

struct Unit { int pm, pn, ka; };
struct Gemm { const bf16_t* A; const bf16_t* Bt; int lda, ldb, K; };

struct Order {
    int nM, nN, nwg, G, c, mode;
    __device__ __forceinline__ void init(int nM_, int nN_, int G_, int c_, int mode_) { nM = nM_; nN = nN_; nwg = nM * nN; G = G_; c = c_; mode = mode_; }
    __device__ __forceinline__ bool next(int i, Unit& u) const {
        const long L = (long)i * G + c; if (L >= nwg) return false;
        int wgid = (int)L; { const int q = nwg / NXCD, r = nwg % NXCD, xcd = wgid % NXCD, off = wgid / NXCD; wgid = (xcd < r ? xcd * (q + 1) : r * (q + 1) + (xcd - r) * q) + off; }
        const int nig = WGM * nN, gid = wgid / nig, fm = gid * WGM, gsz = (nM - fm) < WGM ? (nM - fm) : WGM;
        u.pm = fm + ((wgid % nig) % gsz); u.pn = (wgid % nig) / gsz; u.ka = mode ? ((u.pn & ~1) * 128) : 0; return true;
    }
};

template <class Epi>
__device__ __forceinline__ void gemm_phase(LAS unsigned char* lds, const Gemm g, const Order& S, const Epi& E, const int wvid) {
    int tid = TIDX; asm volatile("" : "+v"(tid));
    const int wid = __builtin_amdgcn_readfirstlane(tid >> 6), lane = tid & 63, wr = wid >> 2, wc = wid & 3, fr = lane & 15, fq = lane >> 4;
    const int K = g.K, nt = K / BK;
    unsigned voffA[2], voffB[2];
#pragma unroll
    for (int i = 0; i < 2; ++i) { int R, C; stage_rc(tid * 16 + i * 8192, R, C); const int Rb = Epi::PERM ? ((R & ~31) + perm32(R & 31)) : R;
        voffA[i] = (unsigned)(R * g.lda + C) * 2u; voffB[i] = (unsigned)(Rb * g.ldb + C) * 2u; }
    const size_t kstep = (size_t)(BK * 2);
    const size_t hstepA = (size_t)HALF * g.lda * 2, tstepA = 2 * hstepA;
    const size_t hstepB = (size_t)HALF * g.ldb * 2, tstepB = 2 * hstepB;
    const unsigned ldsw = (unsigned)wid * 1024u;
    const int aoff = lds_byte(wr * 64 + fr, fq * 8), boff = lds_byte(wc * 32 + fr, fq * 8);
#define PG8_SA(b, h) (((b) * 2 + (h)) * HTB)
#define PG8_SB(b, h) ((4 + (b) * 2 + (h)) * HTB)
#define PG8_STAGE(bufoff, gbase, voff) do { _Pragma("unroll") for (int _i = 0; _i < 2; ++_i) \
        __builtin_amdgcn_global_load_lds((const unsigned*)((const char*)(gbase) + (voff)[_i]), (LAS unsigned*)(lds + (bufoff) + ldsw + _i * 8192), 16, 0, 0); } while (0)
#define PG8_LDA(dst, b, h) do { _Pragma("unroll") for (int m = 0; m < 4; ++m) _Pragma("unroll") for (int k = 0; k < 2; ++k) dst[m][k] = *(const LAS bf16x8*)(lds + PG8_SA(b, h) + aoff + m * 2048 + k * 1024); } while (0)
#define PG8_LDB(dst, b, h) do { _Pragma("unroll") for (int n = 0; n < 2; ++n) _Pragma("unroll") for (int k = 0; k < 2; ++k) dst[n][k] = *(const LAS bf16x8*)(lds + PG8_SB(b, h) + boff + n * 2048 + k * 1024); } while (0)
#define PG8_MMA(ai, bj, At, Bt) do { __builtin_amdgcn_s_setprio(1); _Pragma("unroll") for (int m = 0; m < 4; ++m) _Pragma("unroll") for (int n = 0; n < 2; ++n) _Pragma("unroll") for (int k = 0; k < 2; ++k) \
        acc[ai][bj][m][n] = __builtin_amdgcn_mfma_f32_16x16x32_bf16(Bt[n][k], At[m][k], acc[ai][bj][m][n], 0, 0, 0); __builtin_amdgcn_s_setprio(0); } while (0)
#define PG8_WAIT_V(n) asm volatile("s_waitcnt vmcnt(" #n ")" ::: "memory")
#define PG8_WAIT_L(n) asm volatile("s_waitcnt lgkmcnt(" #n ")" ::: "memory")
#define PG8_BAR __builtin_amdgcn_s_barrier()
#define PG8_SCHED __builtin_amdgcn_sched_barrier(0)
    Unit cur, nxt; int ui = 0;
    if (!S.next(0, cur)) return;
    f32x4 acc[2][2][4][2];
#pragma unroll
    for (int a = 0; a < 2; ++a)
#pragma unroll
        for (int b = 0; b < 2; ++b)
#pragma unroll
            for (int m = 0; m < 4; ++m)
#pragma unroll
                for (int n = 0; n < 2; ++n) acc[a][b][m][n] = (f32x4){0.f, 0.f, 0.f, 0.f};
    bf16x8 At[4][2], B0[2][2], B1[2][2];
    const char* cA = (const char*)g.A + (size_t)cur.pm * tstepA + (size_t)cur.ka * 2; const char* cB = (const char*)g.Bt + (size_t)cur.pn * tstepB;
    PG8_STAGE(PG8_SB(0, 0), cB, voffB); PG8_STAGE(PG8_SB(0, 1), cB + hstepB, voffB); PG8_STAGE(PG8_SA(0, 0), cA, voffA); PG8_STAGE(PG8_SA(0, 1), cA + hstepA, voffA);
    if (wr == 1) PG8_BAR;
    PG8_WAIT_V(2); PG8_BAR;
    PG8_STAGE(PG8_SB(1, 0), cB + kstep, voffB); PG8_STAGE(PG8_SA(1, 0), cA + kstep, voffA); PG8_STAGE(PG8_SB(1, 1), cB + hstepB + kstep, voffB);
    PG8_WAIT_V(6); PG8_BAR;
    for (;;) {
        const bool has_next = S.next(ui + 1, nxt);
        const char* nA = has_next ? (const char*)g.A + (size_t)nxt.pm * tstepA + (size_t)nxt.ka * 2 : cA; const char* nB = has_next ? (const char*)g.Bt + (size_t)nxt.pn * tstepB : cB;
#pragma unroll 1
        for (int t = 0; t < nt; t += 2) {
            const bool last = (t == nt - 2);
            const char* a1 = cA + (size_t)(t + 1) * kstep;
            const char* a2 = last ? nA : cA + (size_t)(t + 2) * kstep; const char* b2 = last ? nB : cB + (size_t)(t + 2) * kstep;
            const char* a3 = a2 + kstep; const char* b3 = b2 + kstep;
            PG8_LDB(B0, 0, 0); PG8_LDB(B1, 0, 1); PG8_SCHED; PG8_LDA(At, 0, 0); PG8_STAGE(PG8_SA(1, 1), a1 + hstepA, voffA);
            PG8_WAIT_V(8); PG8_WAIT_L(0); PG8_BAR; PG8_MMA(0, 0, At, B0); PG8_MMA(0, 1, At, B1); PG8_BAR; PG8_SCHED;
            PG8_LDA(At, 0, 1); PG8_STAGE(PG8_SB(0, 0), b2, voffB); PG8_STAGE(PG8_SB(0, 1), b2 + hstepB, voffB); PG8_STAGE(PG8_SA(0, 0), a2, voffA);
            PG8_WAIT_V(8); PG8_WAIT_L(0); PG8_BAR; PG8_MMA(1, 0, At, B0); PG8_MMA(1, 1, At, B1); PG8_BAR; PG8_SCHED;
            PG8_LDB(B0, 1, 0); PG8_LDB(B1, 1, 1); PG8_SCHED; PG8_LDA(At, 1, 0); PG8_STAGE(PG8_SA(0, 1), a2 + hstepA, voffA);
            PG8_WAIT_V(8); PG8_WAIT_L(0); PG8_BAR; PG8_MMA(0, 0, At, B0); PG8_MMA(0, 1, At, B1); PG8_BAR; PG8_SCHED;
            PG8_LDA(At, 1, 1); PG8_STAGE(PG8_SB(1, 0), b3, voffB); PG8_STAGE(PG8_SB(1, 1), b3 + hstepB, voffB); PG8_STAGE(PG8_SA(1, 0), a3, voffA);
            PG8_WAIT_V(8); PG8_WAIT_L(0); PG8_BAR; PG8_MMA(1, 0, At, B0); PG8_MMA(1, 1, At, B1); PG8_BAR; PG8_SCHED;
        }
        if (wr == 0) PG8_BAR;
        { int fr2 = fr, fq2 = fq; asm volatile("" : "+v"(fr2), "+v"(fq2));
          E(acc, cur, wr, wc, fr2, fq2); }
        if (!has_next) break;
#pragma unroll
        for (int a = 0; a < 2; ++a)
#pragma unroll
            for (int b = 0; b < 2; ++b)
#pragma unroll
                for (int m = 0; m < 4; ++m)
#pragma unroll
                    for (int n = 0; n < 2; ++n) acc[a][b][m][n] = (f32x4){0.f, 0.f, 0.f, 0.f};
        cur = nxt; cA = nA; cB = nB; ++ui;
        if (wr == 1) PG8_BAR;
    }
    PG8_WAIT_V(0);
    PG8_BAR;
#undef PG8_SA
#undef PG8_SB
#undef PG8_STAGE
#undef PG8_LDA
#undef PG8_LDB
#undef PG8_MMA
#undef PG8_WAIT_V
#undef PG8_WAIT_L
#undef PG8_BAR
#undef PG8_SCHED
}
}
using pg8::Unit;

#define EPI_ARGS const f32x4 (&acc)[2][2][4][2], const Unit& u, int wr, int wc, int fr, int fq
struct EpiZ {
    static constexpr bool PERM = true;
    bf16_t* Z; float* out; int l;
    __device__ __forceinline__ void operator()(EPI_ARGS) const {
        const int pn = u.pn; bf16_t* base; int ld, ct; bool act;
        if (pn < 2) { base = Z; ld = 512; ct = pn * 256; act = false; }
        else if (pn < 6) { base = Z + UE; ld = 1024; ct = (pn - 2) * 256; act = false; }
        else if (pn < 10) { base = Z + 3 * UE; ld = 1024; ct = (pn - 6) * 256; act = true; }
        else if (pn < 12) { base = Z + 5 * UE; ld = 512; ct = (pn - 10) * 256; act = true; }
        else { base = Z + 6 * UE; ld = 512; ct = (pn - 12) * 256; act = true; }
        const bool st = (pn < 6) && (((u.pm & 7) == 7) || u.pm == 64);
#pragma unroll
        for (int ai = 0; ai < 2; ++ai)
#pragma unroll
            for (int m = 0; m < 4; ++m) {
                const int row = u.pm * 256 + ai * 128 + wr * 64 + m * 16 + fr;
#pragma unroll
                for (int bj = 0; bj < 2; ++bj) {
                    f32x4 v0 = acc[ai][bj][m][0], v1 = acc[ai][bj][m][1];
                    const int c = ct + bj * 128 + wc * 32 + 8 * fq;
                    if (st) {
                        float* o = nullptr;
                        if (row < MPR) { const int t = row & 2047, b = row >> 11;
                            if (pn < 2) { if (t >= 2033) o = out + O_POOL_P + ((size_t)(l * NB + b) * 15 + (t - 2033)) * DPOOL + c; }
                            else { if (t >= 2045) o = out + O_RC_P + ((size_t)(l * NB + b) * 3 + (t - 2045)) * DRNN + c; } }
                        else if (row < MROWS) { const int s = row - MPR;
                            if (pn < 2) o = out + O_POOL_S + ((size_t)(l * NS + s) * 15 + 14) * DPOOL + c;
                            else o = out + O_RC_S + ((size_t)(l * NS + s) * 3 + 2) * DRNN + c; }
                        if (o) { *(f32x4*)o = v0; *(f32x4*)(o + 4) = v1; }
                    }
                    if (act) { v0 = gelu4(v0); v1 = gelu4(v1); }
                    *(u32x4*)(base + (size_t)row * ld + c) = pack8(v0, v1);
                    asm volatile("" ::: "memory");
                }
            }
    }
    __device__ __forceinline__ void sample(int row, int col, f32x4 v) const {
        const int s = row - MPR; bf16_t* dst;
        if (col < 512) { dst = Z + (size_t)row * 512 + col; *(f32x4*)(out + O_POOL_S + ((size_t)(l * NS + s) * 15 + 14) * DPOOL + col) = v; }
        else if (col < 1536) { dst = Z + UE + (size_t)row * 1024 + (col - 512); *(f32x4*)(out + O_RC_S + ((size_t)(l * NS + s) * 3 + 2) * DRNN + (col - 512)) = v; }
        else if (col < 2560) { dst = Z + 3 * UE + (size_t)row * 1024 + (col - 1536); v = gelu4(v); }
        else if (col < 3072) { dst = Z + 5 * UE + (size_t)row * 512 + (col - 2560); v = gelu4(v); }
        else { dst = Z + 6 * UE + (size_t)row * 512 + (col - 3072); v = gelu4(v); }
        u32x2 w; w.x = pk2(v[0], v[1]); w.y = pk2(v[2], v[3]); *(u32x2*)dst = w;
    }
};
struct EpiRI {
    static constexpr bool PERM = true;
    const bf16_t* BC; bf16_t* LA; bf16_t* BV; const float* ba; const float* bx; const float* sp;
    __device__ __forceinline__ void operator()(EPI_ARGS) const {
        const int ch = u.pn * 128 + wc * 32 + 8 * fq;
        f32x4 bav[2], bxv[2], spv[2];
#pragma unroll
        for (int n = 0; n < 2; ++n) { bav[n] = *(const f32x4*)(ba + ch + 4 * n); bxv[n] = *(const f32x4*)(bx + ch + 4 * n); spv[n] = *(const f32x4*)(sp + ch + 4 * n); }
#pragma unroll
        for (int ai = 0; ai < 2; ++ai) {
            u32x4 xw[4];
#pragma unroll
            for (int m = 0; m < 4; ++m) xw[m] = *(const u32x4*)(BC + (size_t)(u.pm * 256 + ai * 128 + wr * 64 + m * 16 + fr) * DRNN + ch);
#pragma unroll
            for (int m = 0; m < 4; ++m) {
                const int row = u.pm * 256 + ai * 128 + wr * 64 + m * 16 + fr;
                const F8 xc8 = unpack8(xw[m]); f32x4 lav[2], bv[2];
#pragma unroll
                for (int n = 0; n < 2; ++n) {
                    const f32x4 xc = n ? xc8.b : xc8.a;
                    const f32x4 r0 = sigm4(acc[ai][0][m][n] + bav[n]), i0 = sigm4(acc[ai][1][m][n] + bxv[n]);
                    lav[n] = r0 * spv[n];
#pragma unroll
                    for (int j = 0; j < 4; ++j) { const float x = -2.f * lav[n][j];
                        const float em = x < 0.03f ? x * (1.f - x * (0.5f - x * (0.16666667f - x * 0.041666668f))) : 1.f - __expf(-x);
                        bv[n][j] = __builtin_sqrtf(em) * i0[j] * xc[j]; }
                }
                *(u32x4*)(LA + (size_t)row * DRNN + ch) = pack8(lav[0], lav[1]);
                *(u32x4*)(BV + (size_t)row * DRNN + ch) = pack8(bv[0], bv[1]);
            }
            asm volatile("" ::: "memory");
        }
    }
    __device__ __forceinline__ void sample2(int row, int ch, f32x4 vr, f32x4 vi) const {
        const f32x4 ba0 = *(const f32x4*)(ba + ch), bx0 = *(const f32x4*)(bx + ch), sp0 = *(const f32x4*)(sp + ch);
        const u32x2 xw = *(const u32x2*)(BC + (size_t)row * DRNN + ch);
        const f32x4 xc = (f32x4){bf_lo(xw.x), bf_hi(xw.x), bf_lo(xw.y), bf_hi(xw.y)};
        const f32x4 r0 = sigm4(vr + ba0), i0 = sigm4(vi + bx0), la0 = r0 * sp0; f32x4 b0;
#pragma unroll
        for (int j = 0; j < 4; ++j) { const float x = -2.f * la0[j];
            const float em = x < 0.03f ? x * (1.f - x * (0.5f - x * (0.16666667f - x * 0.041666668f))) : 1.f - __expf(-x);
            b0[j] = __builtin_sqrtf(em) * i0[j] * xc[j]; }
        u32x2 wl, wb; wl.x = pk2(la0[0], la0[1]); wl.y = pk2(la0[2], la0[3]); wb.x = pk2(b0[0], b0[1]); wb.y = pk2(b0[2], b0[3]);
        *(u32x2*)(LA + (size_t)row * DRNN + ch) = wl; *(u32x2*)(BV + (size_t)row * DRNN + ch) = wb;
    }
};
struct EpiG {
    static constexpr bool PERM = true;
    bf16_t* G;
    __device__ __forceinline__ void operator()(EPI_ARGS) const {
#pragma unroll
        for (int ai = 0; ai < 2; ++ai)
#pragma unroll
            for (int m = 0; m < 4; ++m) {
                const int row = u.pm * 256 + ai * 128 + wr * 64 + m * 16 + fr;
#pragma unroll
                for (int bj = 0; bj < 2; ++bj) {
                    const int c = u.pn * 256 + bj * 128 + wc * 32 + 8 * fq;
                    *(u32x4*)(G + (size_t)row * 3072 + c) = pack8(sigm4(acc[ai][bj][m][0]), sigm4(acc[ai][bj][m][1]));
                    asm volatile("" ::: "memory");
                }
            }
    }
    __device__ __forceinline__ void sample(int row, int col, f32x4 v) const {
        v = sigm4(v); u32x2 w; w.x = pk2(v[0], v[1]); w.y = pk2(v[2], v[3]); *(u32x2*)(G + (size_t)row * 3072 + col) = w;
    }
};
struct EpiP {
    static constexpr bool PERM = true;
    const bf16_t* G; bf16_t* M; int goff; int first;
    __device__ __forceinline__ void operator()(EPI_ARGS) const {
#pragma unroll
        for (int ai = 0; ai < 2; ++ai)
#pragma unroll
            for (int bj = 0; bj < 2; ++bj) {
                const int c = u.pn * 256 + bj * 128 + wc * 32 + 8 * fq;
                u32x4 gw[4], ow[4];
#pragma unroll
                for (int m = 0; m < 4; ++m) { const int row = u.pm * 256 + ai * 128 + wr * 64 + m * 16 + fr;
                    gw[m] = *(const u32x4*)(G + (size_t)row * 3072 + goff + c);
                    if (!first) ow[m] = *(const u32x4*)(M + (size_t)row * DM + c); }
#pragma unroll
                for (int m = 0; m < 4; ++m) { const int row = u.pm * 256 + ai * 128 + wr * 64 + m * 16 + fr;
                    const F8 gt = unpack8(gw[m]);
                    f32x4 o0 = gt.a * acc[ai][bj][m][0], o1 = gt.b * acc[ai][bj][m][1];
                    if (!first) { const F8 old = unpack8(ow[m]); o0 += old.a; o1 += old.b; }
                    *(u32x4*)(M + (size_t)row * DM + c) = pack8(o0, o1); }
                asm volatile("" ::: "memory");
            }
    }
    __device__ __forceinline__ void sample(int row, int col, f32x4 v) const {
        const u32x2 g = *(const u32x2*)(G + (size_t)row * 3072 + goff + col); u32x2* mp = (u32x2*)(M + (size_t)row * DM + col);
        f32x4 o = (f32x4){bf_lo(g.x) * v[0], bf_hi(g.x) * v[1], bf_lo(g.y) * v[2], bf_hi(g.y) * v[3]};
        if (!first) { const u32x2 old = *mp; o += (f32x4){bf_lo(old.x), bf_hi(old.x), bf_lo(old.y), bf_hi(old.y)}; }
        u32x2 w; w.x = pk2(o[0], o[1]); w.y = pk2(o[2], o[3]); *mp = w;
    }
};
struct EpiX {
    static constexpr bool PERM = false;
    const float* xin_p; const float* xin_s; float* xout;
    __device__ __forceinline__ void operator()(EPI_ARGS) const {
#pragma unroll
        for (int ai = 0; ai < 2; ++ai)
#pragma unroll
            for (int mp = 0; mp < 2; ++mp) {
                f32x4 xv[2][2][2];
#pragma unroll
                for (int mm = 0; mm < 2; ++mm) { const int row = u.pm * 256 + ai * 128 + wr * 64 + (2 * mp + mm) * 16 + fr; const float* src = xin_p + (size_t)row * DM;
#pragma unroll
                    for (int bj = 0; bj < 2; ++bj)
#pragma unroll
                        for (int n = 0; n < 2; ++n) xv[mm][bj][n] = *(const f32x4*)(src + u.pn * 256 + bj * 128 + wc * 32 + 16 * n + 4 * fq); }
#pragma unroll
                for (int mm = 0; mm < 2; ++mm) { const int row = u.pm * 256 + ai * 128 + wr * 64 + (2 * mp + mm) * 16 + fr; float* dst = xout + (size_t)row * DM;
#pragma unroll
                    for (int bj = 0; bj < 2; ++bj)
#pragma unroll
                        for (int n = 0; n < 2; ++n) *(f32x4*)(dst + u.pn * 256 + bj * 128 + wc * 32 + 16 * n + 4 * fq) = xv[mm][bj][n] + acc[ai][bj][2 * mp + mm][n]; }
                asm volatile("" ::: "memory");
            }
    }
    __device__ __forceinline__ void sample(int row, int col, f32x4 v) const {
        *(f32x4*)(xout + (size_t)row * DM + col) = *(const f32x4*)(xin_s + (size_t)(row - MPR) * DM + col) + v;
    }
};
struct EpiGpre {
    static constexpr bool PERM = true;
    bf16_t* GP; float* out; int l;
    __device__ __forceinline__ void operator()(EPI_ARGS) const {
        const bool st = ((u.pm & 7) == 7) || u.pm == 64;
#pragma unroll
        for (int ai = 0; ai < 2; ++ai)
#pragma unroll
            for (int m = 0; m < 4; ++m) {
                const int row = u.pm * 256 + ai * 128 + wr * 64 + m * 16 + fr;
#pragma unroll
                for (int bj = 0; bj < 2; ++bj) {
                    const f32x4 v0 = acc[ai][bj][m][0], v1 = acc[ai][bj][m][1];
                    const int c = u.pn * 256 + bj * 128 + wc * 32 + 8 * fq;
                    if (st) {
                        float* o = nullptr;
                        if (row < MPR) { const int t = row & 2047, b = row >> 11; if (t >= 2046) o = out + O_FF_P + ((size_t)(l * NB + b) * 2 + (t - 2046)) * DFF + c; }
                        else if (row < MROWS) { const int s = row - MPR; o = out + O_FF_S + ((size_t)(l * NS + s) * 2 + 1) * DFF + c; }
                        if (o) { *(f32x4*)o = v0; *(f32x4*)(o + 4) = v1; }
                    }
                    *(u32x4*)(GP + (size_t)row * 3072 + c) = pack8(v0, v1);
                    asm volatile("" ::: "memory");
                }
            }
    }
    __device__ __forceinline__ void sample(int row, int col, f32x4 v) const {
        *(f32x4*)(out + O_FF_S + ((size_t)(l * NS + (row - MPR)) * 2 + 1) * DFF + col) = v;
        u32x2 w; w.x = pk2(v[0], v[1]); w.y = pk2(v[2], v[3]); *(u32x2*)(GP + (size_t)row * 3072 + col) = w;
    }
};
struct EpiH {
    static constexpr bool PERM = true;
    const bf16_t* GP; bf16_t* H; const float* cw; const float* cb; const float* st;
    __device__ __forceinline__ void operator()(EPI_ARGS) const {
#pragma unroll
        for (int bj = 0; bj < 2; ++bj) {
            const int c = u.pn * 256 + bj * 128 + wc * 32 + 8 * fq;
            const f32x4 w00 = *(const f32x4*)(cw + c), w01 = *(const f32x4*)(cw + c + 4);
            const f32x4 w10 = *(const f32x4*)(cw + DFF + c), w11 = *(const f32x4*)(cw + DFF + c + 4);
            const f32x4 w20 = *(const f32x4*)(cw + 2 * DFF + c), w21 = *(const f32x4*)(cw + 2 * DFF + c + 4);
            const f32x4 cb0 = *(const f32x4*)(cb + c), cb1 = *(const f32x4*)(cb + c + 4);
#pragma unroll
            for (int ai = 0; ai < 2; ++ai) {
                const int base = u.pm * 256 + ai * 128 + wr * 64, t0 = base & 2047;
                u32x4 q0[4], E = (u32x4){0u, 0u, 0u, 0u};
#pragma unroll
                for (int m = 0; m < 4; ++m) q0[m] = *(const u32x4*)(GP + (size_t)(base + 16 * m + fr) * 3072 + c);
                if (fr >= 14 && t0 != 0) E = *(const u32x4*)(GP + (size_t)(base - 16 + fr) * 3072 + c);
#pragma unroll
                for (int m = 0; m < 4; ++m) { const int row = base + 16 * m + fr, t = row & 2047;
                    const u32x4 P = m ? q0[m > 0 ? m - 1 : 0] : E; u32x4 r1, r2;
                    r1.x = dpp_shr1(dpp_ror1(P.x), q0[m].x); r1.y = dpp_shr1(dpp_ror1(P.y), q0[m].y); r1.z = dpp_shr1(dpp_ror1(P.z), q0[m].z); r1.w = dpp_shr1(dpp_ror1(P.w), q0[m].w);
                    r2.x = dpp_shr2(dpp_ror2(P.x), q0[m].x); r2.y = dpp_shr2(dpp_ror2(P.y), q0[m].y); r2.z = dpp_shr2(dpp_ror2(P.z), q0[m].z); r2.w = dpp_shr2(dpp_ror2(P.w), q0[m].w);
                    const F8 g0 = unpack8(q0[m]), g1 = unpack8(r1), g2 = unpack8(r2);
                    const float k1 = t >= 1 ? 1.f : 0.f, k2 = t >= 2 ? 1.f : 0.f;
                    const f32x4 s0 = cb0 + w20 * g0.a + (w10 * g1.a) * k1 + (w00 * g2.a) * k2, s1 = cb1 + w21 * g0.b + (w11 * g1.b) * k1 + (w01 * g2.b) * k2;
                    *(u32x4*)(H + (size_t)row * 3072 + c) = pack8(gelu4(s0) * acc[ai][bj][m][0], gelu4(s1) * acc[ai][bj][m][1]); }
                asm volatile("" ::: "memory");
            }
        }
    }
    __device__ __forceinline__ void sample(int row, int col, f32x4 v) const {
        const u32x2 gw = *(const u32x2*)(GP + (size_t)row * 3072 + col); const f32x4 g0 = (f32x4){bf_lo(gw.x), bf_hi(gw.x), bf_lo(gw.y), bf_hi(gw.y)};
        const float* sp = st + (size_t)(row - MPR) * 2 * DFF + col;
        const f32x4 s0 = *(const f32x4*)(cb + col) + *(const f32x4*)(cw + 2 * DFF + col) * g0 + *(const f32x4*)(cw + col) * *(const f32x4*)sp + *(const f32x4*)(cw + DFF + col) * *(const f32x4*)(sp + DFF);
        const f32x4 h = gelu4(s0) * v; u32x2 w; w.x = pk2(h[0], h[1]); w.y = pk2(h[2], h[3]); *(u32x2*)(H + (size_t)row * 3072 + col) = w;
    }
};

template <bool DUAL, class Epi>
__device__ __forceinline__ void sample_gemm(LAS unsigned char* lds, const bf16_t* A, int lda, const bf16_t* Bt, int ldb, int K, int nstrips, int bid, int G, const Epi& E, const int wvid) {
    int tid = TIDX; asm volatile("" : "+v"(tid));
    const int kw = __builtin_amdgcn_readfirstlane(tid >> 6), lane = tid & 63, fr = lane & 15, fq = lane >> 4;
    const int kslice = K >> 3, nks = kslice >> 5;
    LAS f32x4* part = (LAS f32x4*)lds;
    for (int strip = G - 1 - bid; strip < nstrips; strip += G) {
        int n0 = strip * 16, acol = 0, h = 0, cc = 0;
        if (DUAL) { h = strip >> 3; cc = (strip & 7) * 16; n0 = h * 256 + cc; acol = (h & ~1) * 128; }
        f32x4 acc[8], acc2[8];
#pragma unroll
        for (int m = 0; m < 8; ++m) { acc[m] = (f32x4){0.f, 0.f, 0.f, 0.f}; acc2[m] = acc[m]; }
        typedef const __attribute__((address_space(1))) bf16x8* gfrag;
        const bf16_t* bp = Bt + (size_t)(n0 + fr) * ldb + kw * kslice + 8 * fq;
        const bf16_t* ap = A + (size_t)fr * lda + acol + kw * kslice + 8 * fq;
#pragma unroll 1
        for (int ks0 = 0; ks0 < nks; ks0 += 2) {
            bf16x8 bb[2], bb2[2], aa[2][8];
#pragma unroll
            for (int u = 0; u < 2; ++u) if (ks0 + u < nks) {
                bb[u] = *(gfrag)(bp + (ks0 + u) * 32);
                if (DUAL) bb2[u] = *(gfrag)(bp + (size_t)128 * ldb + (ks0 + u) * 32);
#pragma unroll
                for (int m = 0; m < 8; ++m) aa[u][m] = *(gfrag)(ap + (size_t)(16 * m) * lda + (ks0 + u) * 32);
            }
            __builtin_amdgcn_sched_barrier(0);
#pragma unroll
            for (int u = 0; u < 2; ++u) if (ks0 + u < nks) {
#pragma unroll
                for (int m = 0; m < 8; ++m) { acc[m] = __builtin_amdgcn_mfma_f32_16x16x32_bf16(bb[u], aa[u][m], acc[m], 0, 0, 0);
                    if (DUAL) acc2[m] = __builtin_amdgcn_mfma_f32_16x16x32_bf16(bb2[u], aa[u][m], acc2[m], 0, 0, 0); }
            }
            __builtin_amdgcn_sched_barrier(0);
        }
#pragma unroll
        for (int m = 0; m < 8; ++m) part[(kw * 8 + m) * 64 + lane] = acc[m];
        __syncthreads();
        f32x4 v = part[kw * 64 + lane];
#pragma unroll
        for (int k2 = 1; k2 < 8; ++k2) v += part[(k2 * 8 + kw) * 64 + lane];
        const int row = MPR + 16 * kw + fr;
        if constexpr (DUAL) {
            __syncthreads();
#pragma unroll
            for (int m = 0; m < 8; ++m) part[(kw * 8 + m) * 64 + lane] = acc2[m];
            __syncthreads();
            f32x4 v2 = part[kw * 64 + lane];
#pragma unroll
            for (int k2 = 1; k2 < 8; ++k2) v2 += part[(k2 * 8 + kw) * 64 + lane];
            E.sample2(row, h * 128 + cc + 4 * fq, v, v2);
        } else E.sample(row, n0 + 4 * fq, v);
        __syncthreads();
    }
}


__device__ __forceinline__ void transpose_item(const float* W, int K, int N, bf16_t* WT, LAS float* scr, int item, int lane) {
    const int nblk = N / 32, kb = item / nblk, nb = item % nblk, k0 = 64 * kb, n0 = 32 * nb;
    float tv[32];
#pragma unroll
    for (int i = 0; i < 32; ++i) tv[i] = W[(size_t)(k0 + 2 * i + (lane >> 5)) * N + n0 + (lane & 31)];
#pragma unroll
    for (int i = 0; i < 32; ++i) scr[(2 * i + (lane >> 5)) * 33 + (lane & 31)] = tv[i];
    asm volatile("s_waitcnt lgkmcnt(0)" ::: "memory");
    const int c = lane & 7;
#pragma unroll
    for (int j = 0; j < 4; ++j) { const int n = (lane >> 3) + 8 * j; const LAS float* s = scr + (8 * c) * 33 + n;
        u32x4 o; o.x = pk2(s[0 * 33], s[1 * 33]); o.y = pk2(s[2 * 33], s[3 * 33]); o.z = pk2(s[4 * 33], s[5 * 33]); o.w = pk2(s[6 * 33], s[7 * 33]);
        *(u32x4*)(WT + (size_t)(n0 + n) * K + k0 + 8 * c) = o; }
    asm volatile("s_waitcnt lgkmcnt(0)" ::: "memory");
}
__device__ __forceinline__ void rms_row_bf16(const float* xrow, const float* g, bf16_t* orow, int lane) {
    const f32x4* xr = (const f32x4*)xrow + lane; f32x4 v[4]; float s = 0.f;
#pragma unroll
    for (int j = 0; j < 4; ++j) { v[j] = xr[64 * j]; s += (v[j][0] * v[j][0] + v[j][1] * v[j][1]) + (v[j][2] * v[j][2] + v[j][3] * v[j][3]); }
    const float rstd = rsqrtf(wave_sum(s) * (1.f / DM) + 1e-6f);
    const f32x4* gr = (const f32x4*)g + lane; u32x2* o8 = (u32x2*)orow + lane;
#pragma unroll
    for (int j = 0; j < 4; ++j) { const f32x4 o = v[j] * rstd * gr[64 * j]; u32x2 w; w.x = pk2(o[0], o[1]); w.y = pk2(o[2], o[3]); o8[64 * j] = w; }
}
__device__ __forceinline__ void rms_rows(const float* xp, const float* xs, const float* g, bf16_t* XN, int gw, int ngw, int lane) {
    for (int row = gw; row < MPAD; row += ngw) {
        if (row < MROWS) rms_row_bf16(row < MPR ? xp + (size_t)row * DM : xs + (size_t)(row - MPR) * DM, g, XN + (size_t)row * DM, lane);
        else { u32x2* o8 = (u32x2*)(XN + (size_t)row * DM) + lane; u32x2 z; z.x = 0u; z.y = 0u;
#pragma unroll
            for (int j = 0; j < 4; ++j) o8[64 * j] = z; }
    }
}

__device__ __forceinline__ void phase_prep(const Params& p, int l, LAS unsigned char* lds, const float* xp, const float* xs, int bid, int G, const int wvid) {
    int tid = TIDX; asm volatile("" : "+v"(tid));
    const int wave = tid >> 6, lane = tid & 63;
    const int gw = bid * 8 + wave, ngw = G * 8;
    bf16_t* W = (bf16_t*)(p.ws + WS_W);
    LAS float* scr = (LAS float*)(lds + wave * 8448);
    const float* w_in = p.in[7] + (size_t)l * DM * INCOLS; const float* w_pb = p.in[21] + (size_t)l * DRNN * DM; const float* w_pc = p.in[22] + (size_t)l * DCH * DM;
    const float* w_o = p.in[23] + (size_t)l * DM * DM; const float* wg = p.in[25] + (size_t)l * DM * DFF; const float* wu = p.in[26] + (size_t)l * DM * DFF; const float* wd = p.in[29] + (size_t)l * DFF * DM;
    constexpr int I_IN = (DM / 64) * (INCOLS / 32), I_PB = (DRNN / 64) * (DM / 32), I_PC = (DCH / 64) * (DM / 32), I_O = (DM / 64) * (DM / 32), I_G = (DM / 64) * (DFF / 32), I_D = (DFF / 64) * (DM / 32);
    constexpr int NITEMS = I_IN + I_PB + I_PC + I_O + 2 * I_G + I_D;
    for (int it = gw; it < NITEMS; it += ngw) {
        int r = it;
        if (r < I_IN) { transpose_item(w_in, DM, INCOLS, W + W_IN, scr, r, lane); continue; } r -= I_IN;
        if (r < I_PB) { transpose_item(w_pb, DRNN, DM, W + W_PB, scr, r, lane); continue; } r -= I_PB;
        if (r < I_PC) { transpose_item(w_pc, DCH, DM, W + W_PC, scr, r, lane); continue; } r -= I_PC;
        if (r < I_O) { transpose_item(w_o, DM, DM, W + W_O, scr, r, lane); continue; } r -= I_O;
        if (r < I_G) { transpose_item(wg, DM, DFF, W + W_G, scr, r, lane); continue; } r -= I_G;
        if (r < I_G) { transpose_item(wu, DM, DFF, W + W_U, scr, r, lane); continue; } r -= I_G;
        transpose_item(wd, DFF, DM, W + W_D, scr, r, lane);
    }
    const int gt = bid * 512 + tid, ngt = G * 512;
    { const float* pw = p.in[8] + (size_t)l * 4 * 128 * 128; const float* ps = p.in[9] + (size_t)l * DPOOL; const float* w_pa = p.in[20] + (size_t)l * DPOOL * DM;
      for (int idx = gt; idx < DPOOL * (DM / 4); idx += ngt) { const int n = (idx & 255) * 4, kp = idx >> 8, g = kp >> 7;
          const float* pr = pw + (size_t)kp * 128; const float* sr = ps + g * 128; const float* wr_ = w_pa + (size_t)g * 128 * DM + n; f32x4 s4 = (f32x4){0.f, 0.f, 0.f, 0.f};
#pragma unroll 16
          for (int j = 0; j < 128; ++j) s4 += (pr[j] * sr[j]) * *(const f32x4*)(wr_ + (size_t)j * DM);
          W[W_PA + (size_t)n * DPOOL + kp] = f2bf(s4[0]); W[W_PA + (size_t)(n + 1) * DPOOL + kp] = f2bf(s4[1]);
          W[W_PA + (size_t)(n + 2) * DPOOL + kp] = f2bf(s4[2]); W[W_PA + (size_t)(n + 3) * DPOOL + kp] = f2bf(s4[3]); } }
    { const float* wa = p.in[12] + (size_t)l * 8 * 128 * 128; const float* wx = p.in[14] + (size_t)l * 8 * 128 * 128;
      for (int idx = gt; idx < 8 * 256 * 256; idx += ngt) { const int k = idx & 255, n = (idx >> 8) & 255, h = idx >> 16; float v = 0.f;
          if ((k >> 7) == (h & 1)) v = (n < 128 ? wa : wx)[((size_t)h * 128 + (k & 127)) * 128 + (n & 127)];
          W[W_RI + idx] = f2bf(v); } }
    if (gt < DRNN) { const float y = __expf(-p.in[16][(size_t)l * DRNN + gt]);
        const float lp = y < 0.05f ? y * (1.f - y * (0.5f - y * (0.33333334f - y * (0.25f - y * 0.2f)))) : __logf(1.f + y);
        ((float*)(p.ws + WS_SP))[gt] = -8.f * lp; }
    rms_rows(xp, xs, p.in[6] + (size_t)l * DM, (bf16_t*)(p.ws + WS_XN), gw, ngw, lane);
}

__device__ __forceinline__ void phase_mix(const Params& p, int l, LAS unsigned char* lds, int bid, int G, const int wvid) {
    int tid = TIDX; asm volatile("" : "+v"(tid));
    const int wave = tid >> 6, lane = tid & 63;
    const bf16_t* Za = (const bf16_t*)(p.ws + WS_Z); const bf16_t* Zbx = Za + UE; const bf16_t* Zgu = Za + 5 * UE; const bf16_t* Zgv = Za + 6 * UE;
    bf16_t* Y0 = (bf16_t*)(p.ws + WS_Y); bf16_t* Yd = Y0 + 2 * UE; bf16_t* Yc = Y0 + 3 * UE;
    const float* vg = p.in[17] + (size_t)l * DCH; const float* cws = p.in[18] + (size_t)l * 4 * 128 * 128; const float* cbs = p.in[19] + (size_t)l * 4 * 128;
    if (bid < 128) {
        const int r0 = bid * 128;
        LAS float* rstd = (LAS float*)lds; LAS bf16_t* VT = (LAS bf16_t*)(lds + 1024);
        { const int j = tid >> 2, q = tid & 3; const u32x4* src = (const u32x4*)(Zgv + (size_t)(r0 + j) * DCH + q * 128); float s = 0.f;
#pragma unroll
          for (int i = 0; i < 16; ++i) { const F8 v = unpack8(src[i]); s += (v.a[0] * v.a[0] + v.a[1] * v.a[1]) + (v.a[2] * v.a[2] + v.a[3] * v.a[3]) + (v.b[0] * v.b[0] + v.b[1] * v.b[1]) + (v.b[2] * v.b[2] + v.b[3] * v.b[3]); }
          s += __shfl_xor(s, 1); s += __shfl_xor(s, 2);
          if (q == 0) rstd[j] = rsqrtf(s * (1.f / DCH) + 1e-6f); }
        __syncthreads();
        const int fr = lane & 15, fq = lane >> 4;
        for (int g = 0; g < 4; ++g) {
            { const int j = tid >> 2, q = tid & 3; const float rs = rstd[j];
              const u32x4* src = (const u32x4*)(Zgv + (size_t)(r0 + j) * DCH + g * 128 + q * 32); const float* gg = vg + g * 128 + q * 32;
#pragma unroll
              for (int i = 0; i < 4; ++i) { const F8 v = unpack8(src[i]); const f32x4 g0 = *(const f32x4*)(gg + 8 * i), g1 = *(const f32x4*)(gg + 8 * i + 4);
                  const int d = q * 32 + 8 * i;
#pragma unroll
                  for (int e = 0; e < 4; ++e) { VT[(d + e) * 136 + j] = f2bf(v.a[e] * rs * g0[e]); VT[(d + 4 + e) * 136 + j] = f2bf(v.b[e] * rs * g1[e]); } } }
            __syncthreads();
            const int i = 16 * wave + fr; bf16x8 af[4];
#pragma unroll
            for (int ks = 0; ks < 4; ++ks) { const int k0 = 32 * ks + 8 * fq; const float* wrow = cws + ((size_t)g * 128 + i) * 128 + k0;
                const f32x4 a0 = *(const f32x4*)wrow, a1 = *(const f32x4*)(wrow + 4); u32x4 w;
                w.x = pk2(k0 + 0 <= i ? a0[0] : 0.f, k0 + 1 <= i ? a0[1] : 0.f); w.y = pk2(k0 + 2 <= i ? a0[2] : 0.f, k0 + 3 <= i ? a0[3] : 0.f);
                w.z = pk2(k0 + 4 <= i ? a1[0] : 0.f, k0 + 5 <= i ? a1[1] : 0.f); w.w = pk2(k0 + 6 <= i ? a1[2] : 0.f, k0 + 7 <= i ? a1[3] : 0.f);
                af[ks] = __builtin_bit_cast(bf16x8, w); }
            const float bsv = cbs[g * 128 + i];
#pragma unroll
            for (int dt = 0; dt < 8; ++dt) {
                f32x4 c4 = (f32x4){0.f, 0.f, 0.f, 0.f};
#pragma unroll
                for (int ks = 0; ks < 4; ++ks) { const bf16x8 vf = *(const LAS bf16x8*)(VT + (16 * dt + fr) * 136 + 32 * ks + 8 * fq);
                    c4 = __builtin_amdgcn_mfma_f32_16x16x32_bf16(vf, af[ks], c4, 0, 0, 0); }
                const size_t off = (size_t)(r0 + i) * DCH + g * 128 + 16 * dt + 4 * fq;
                const u32x2 uu = *(const u32x2*)(Zgu + off); u32x2 o;
                o.x = pk2(bf_lo(uu.x) * (c4[0] + bsv), bf_hi(uu.x) * (c4[1] + bsv)); o.y = pk2(bf_lo(uu.y) * (c4[2] + bsv), bf_hi(uu.y) * (c4[3] + bsv));
                *(u32x2*)(Yc + off) = o;
            }
            __syncthreads();
        }
    } else if (bid < 144) {
        const int s = (bid - 128) * 8 + wave, row = MPR + s, c = lane * 8, g = lane >> 4;
        const F8 v = unpack8(*(const u32x4*)(Zgv + (size_t)row * DCH + c));
        float ss = (v.a[0] * v.a[0] + v.a[1] * v.a[1]) + (v.a[2] * v.a[2] + v.a[3] * v.a[3]) + (v.b[0] * v.b[0] + v.b[1] * v.b[1]) + (v.b[2] * v.b[2] + v.b[3] * v.b[3]);
        const float rs = rsqrtf(wave_sum(ss) * (1.f / DCH) + 1e-6f);
        const f32x4 vn0 = v.a * rs * *(const f32x4*)(vg + c), vn1 = v.b * rs * *(const f32x4*)(vg + c + 4);
        float* ov = p.out + O_CV_S + ((size_t)l * NS + s) * DCH + c; *(f32x4*)ov = vn0; *(f32x4*)(ov + 4) = vn1;
        const float w00 = cws[(size_t)g * 128 * 128], b0 = cbs[g * 128];
        const F8 uu = unpack8(*(const u32x4*)(Zgu + (size_t)row * DCH + c));
        *(u32x4*)(Yc + (size_t)row * DCH + c) = pack8(uu.a * (vn0 * w00 + b0), uu.b * (vn1 * w00 + b0));
    }
    if (bid >= 128) {
    const int et = (bid - 128) * 512 + tid, net = (G - 128) * 512;
    { const float* cw = p.in[10] + (size_t)l * 4 * DRNN; const float* cb = p.in[11] + (size_t)l * DRNN; const float* st = p.in[3] + (size_t)l * NS * 3 * DRNN;
      for (int idx = et; idx < (MPR / 8) * 128; idx += net) { const int r0 = (idx >> 7) * 8, c = (idx & 127) * 8, t0 = r0 & 2047;
          const f32x4 w00 = *(const f32x4*)(cw + c), w01 = *(const f32x4*)(cw + c + 4), w10 = *(const f32x4*)(cw + DRNN + c), w11 = *(const f32x4*)(cw + DRNN + c + 4);
          const f32x4 w20 = *(const f32x4*)(cw + 2 * DRNN + c), w21 = *(const f32x4*)(cw + 2 * DRNN + c + 4), w30 = *(const f32x4*)(cw + 3 * DRNN + c), w31 = *(const f32x4*)(cw + 3 * DRNN + c + 4);
          const f32x4 b0 = *(const f32x4*)(cb + c), b1 = *(const f32x4*)(cb + c + 4);
          F8 x1, x2, x3; const u32x4 zz = (u32x4){0u, 0u, 0u, 0u};
          x3 = unpack8(t0 >= 3 ? *(const u32x4*)(Zbx + (size_t)(r0 - 3) * DRNN + c) : zz); x2 = unpack8(t0 >= 2 ? *(const u32x4*)(Zbx + (size_t)(r0 - 2) * DRNN + c) : zz); x1 = unpack8(t0 >= 1 ? *(const u32x4*)(Zbx + (size_t)(r0 - 1) * DRNN + c) : zz);
#pragma unroll
          for (int i = 0; i < 8; ++i) { const F8 x0 = unpack8(*(const u32x4*)(Zbx + (size_t)(r0 + i) * DRNN + c));
              *(u32x4*)(Y0 + (size_t)(r0 + i) * DRNN + c) = pack8(b0 + w30 * x0.a + w20 * x1.a + w10 * x2.a + w00 * x3.a, b1 + w31 * x0.b + w21 * x1.b + w11 * x2.b + w01 * x3.b);
              x3 = x2; x2 = x1; x1 = x0; } }
      for (int idx = et; idx < NS * 128; idx += net) { const int row = MPR + (idx >> 7), c = (idx & 127) * 8;
          f32x4 s0 = *(const f32x4*)(cb + c), s1 = *(const f32x4*)(cb + c + 4);
          { const F8 x = unpack8(*(const u32x4*)(Zbx + (size_t)row * DRNN + c)); s0 += *(const f32x4*)(cw + 3 * DRNN + c) * x.a; s1 += *(const f32x4*)(cw + 3 * DRNN + c + 4) * x.b; }
          const float* sp = st + (size_t)(row - MPR) * 3 * DRNN + c;
#pragma unroll
          for (int k = 0; k < 3; ++k) { s0 += *(const f32x4*)(cw + k * DRNN + c) * *(const f32x4*)(sp + k * DRNN); s1 += *(const f32x4*)(cw + k * DRNN + c + 4) * *(const f32x4*)(sp + k * DRNN + 4); }
          *(u32x4*)(Y0 + (size_t)row * DRNN + c) = pack8(s0, s1); } }
    { const float* st = p.in[2] + (size_t)l * NS * 15 * DPOOL;
      for (int idx = et; idx < (MPR / 8) * 64; idx += net) { const int g = (idx >> 6) & 3, rb = ((idx >> 8) << 2) + ((idx >> 4) & 3), c = g * 128 + (idx & 15) * 8, w = 2 << g, r0 = rb * 8, t0 = r0 & 2047;
          f32x4 s0 = (f32x4){0.f, 0.f, 0.f, 0.f}, s1 = s0;
#pragma unroll
          for (int j = 1; j < 16; ++j) if (j < w && t0 >= j) { const F8 x = unpack8(*(const u32x4*)(Za + (size_t)(r0 - j) * DPOOL + c)); s0 += x.a; s1 += x.b; }
#pragma unroll
          for (int i = 0; i < 8; ++i) { const F8 cur = unpack8(*(const u32x4*)(Za + (size_t)(r0 + i) * DPOOL + c)); s0 += cur.a; s1 += cur.b;
              const int t = t0 + i; const float ic = 1.f / (float)(t + 1 < w ? t + 1 : w);
              *(u32x4*)(Yd + (size_t)(r0 + i) * DPOOL + c) = pack8(s0 * ic - cur.a, s1 * ic - cur.b);
              if (t >= w - 1) { const F8 old = unpack8(*(const u32x4*)(Za + (size_t)(r0 + i - (w - 1)) * DPOOL + c)); s0 -= old.a; s1 -= old.b; } } }
      for (int idx = et; idx < NS * 64; idx += net) { const int row = MPR + (idx >> 6), c = (idx & 63) * 8, w = 2 << (c >> 7);
          const F8 cur = unpack8(*(const u32x4*)(Za + (size_t)row * DPOOL + c)); f32x4 s0 = cur.a, s1 = cur.b;
          const float* sp = st + (size_t)(row - MPR) * 15 * DPOOL + c;
          for (int j = 1; j < w; ++j) { s0 += *(const f32x4*)(sp + (15 - j) * DPOOL); s1 += *(const f32x4*)(sp + (15 - j) * DPOOL + 4); }
          const float ic = 1.f / (float)w;
          *(u32x4*)(Yd + (size_t)row * DPOOL + c) = pack8(s0 * ic - cur.a, s1 * ic - cur.b); } }
    }
    const int gt = bid * 512 + tid, ngt = G * 512;
    { const float* sp = p.in[2] + (size_t)l * NS * 15 * DPOOL; float* o = p.out + O_POOL_S + (size_t)l * NS * 15 * DPOOL;
      for (int idx = gt; idx < NS * 14 * (DPOOL / 4); idx += ngt) { const int c = (idx & 127) * 4, r = (idx >> 7) % 14, s = (idx >> 7) / 14;
          *(f32x4*)(o + ((size_t)s * 15 + r) * DPOOL + c) = *(const f32x4*)(sp + ((size_t)s * 15 + r + 1) * DPOOL + c); } }
    { const float* sp = p.in[3] + (size_t)l * NS * 3 * DRNN; float* o = p.out + O_RC_S + (size_t)l * NS * 3 * DRNN;
      for (int idx = gt; idx < NS * 2 * (DRNN / 4); idx += ngt) { const int c = (idx & 255) * 4, r = (idx >> 8) & 1, s = idx >> 9;
          *(f32x4*)(o + ((size_t)s * 3 + r) * DRNN + c) = *(const f32x4*)(sp + ((size_t)s * 3 + r + 1) * DRNN + c); } }
    { const float* sp = p.in[5] + (size_t)l * NS * 2 * DFF; float* o = p.out + O_FF_S + (size_t)l * NS * 2 * DFF;
      for (int idx = gt; idx < NS * (DFF / 4); idx += ngt) { const int c = (idx % 768) * 4, s = idx / 768;
          *(f32x4*)(o + ((size_t)s * 2) * DFF + c) = *(const f32x4*)(sp + ((size_t)s * 2 + 1) * DFF + c); } }
}

__device__ __forceinline__ void phase_scan(const Params& p, int l, LAS unsigned char* lds, int bid, int G, const int wvid) {
    int tid = TIDX; asm volatile("" : "+v"(tid));
    const bf16_t* LA = (const bf16_t*)(p.ws + WS_Z) + UE; const bf16_t* BV = (const bf16_t*)(p.ws + WS_Z) + 5 * UE; const bf16_t* GB = (const bf16_t*)(p.ws + WS_Z) + 3 * UE;
    bf16_t* Y0 = (bf16_t*)(p.ws + WS_Y);
    LAS float* sP = (LAS float*)lds; LAS float* sH = sP + 4096; LAS float* sC = sH + 4096; LAS float* sPg = sC + 4096; LAS float* sHg = sPg + 512;
    for (int item = bid; item < 256; item += G) {
        const int b = item >> 5, c0 = (item & 31) * 32, seg = tid >> 2, lg = tid & 3;
        const size_t base = ((size_t)b * SEQ + seg * 16) * DRNN + c0 + lg * 8;
        f32x4 P0 = (f32x4){1.f, 1.f, 1.f, 1.f}, P1 = P0, h0 = (f32x4){0.f, 0.f, 0.f, 0.f}, h1 = h0;
#pragma unroll
        for (int t = 0; t < 16; ++t) { const F8 la = unpack8(*(const u32x4*)(LA + base + (size_t)t * DRNN)), bv = unpack8(*(const u32x4*)(BV + base + (size_t)t * DRNN));
            f32x4 a0, a1;
#pragma unroll
            for (int e = 0; e < 4; ++e) { a0[e] = __builtin_amdgcn_exp2f(1.442695041f * la.a[e]); a1[e] = __builtin_amdgcn_exp2f(1.442695041f * la.b[e]); }
            h0 = a0 * h0 + bv.a; h1 = a1 * h1 + bv.b; P0 *= a0; P1 *= a1; }
        { const int o = seg * 32 + lg * 8; *(LAS f32x4*)(sP + o) = P0; *(LAS f32x4*)(sP + o + 4) = P1; *(LAS f32x4*)(sH + o) = h0; *(LAS f32x4*)(sH + o + 4) = h1; }
        __syncthreads();
        const int ch = tid & 31, sg = tid >> 5;
        { float Pg = 1.f, hg = 0.f;
#pragma unroll
          for (int k = 0; k < 8; ++k) { const float pp = sP[(sg * 8 + k) * 32 + ch], hh = sH[(sg * 8 + k) * 32 + ch]; hg = pp * hg + hh; Pg *= pp; }
          sPg[sg * 32 + ch] = Pg; sHg[sg * 32 + ch] = hg; }
        __syncthreads();
        { float carry = 0.f;
          for (int k = 0; k < sg; ++k) carry = sPg[k * 32 + ch] * carry + sHg[k * 32 + ch];
#pragma unroll
          for (int k = 0; k < 8; ++k) { const int o = (sg * 8 + k) * 32 + ch; sC[o] = carry; carry = sP[o] * carry + sH[o]; }
          if (sg == 15) p.out[O_H_P + ((size_t)l * NB + b) * DRNN + c0 + ch] = carry; }
        __syncthreads();
        { const int o = seg * 32 + lg * 8; h0 = *(LAS f32x4*)(sC + o); h1 = *(LAS f32x4*)(sC + o + 4); }
#pragma unroll
        for (int t = 0; t < 16; ++t) { const F8 la = unpack8(*(const u32x4*)(LA + base + (size_t)t * DRNN)), bv = unpack8(*(const u32x4*)(BV + base + (size_t)t * DRNN)), gt = unpack8(*(const u32x4*)(GB + base + (size_t)t * DRNN));
            f32x4 a0, a1;
#pragma unroll
            for (int e = 0; e < 4; ++e) { a0[e] = __builtin_amdgcn_exp2f(1.442695041f * la.a[e]); a1[e] = __builtin_amdgcn_exp2f(1.442695041f * la.b[e]); }
            h0 = a0 * h0 + bv.a; h1 = a1 * h1 + bv.b;
            *(u32x4*)(Y0 + base + (size_t)t * DRNN) = pack8(gt.a * h0, gt.b * h1); }
        __syncthreads();
    }
    { const float* hin = p.in[4] + (size_t)l * NS * DRNN; float* oh = p.out + O_H_S + (size_t)l * NS * DRNN;
      for (int idx = bid * 512 + tid; idx < NS * DRNN; idx += G * 512) { const size_t off = (size_t)MPR * DRNN + idx;
          const float a = __expf(bf2f(LA[off])), h = a * hin[idx] + bf2f(BV[off]); oh[idx] = h; Y0[off] = f2bf(bf2f(GB[off]) * h); } }
}

__device__ __forceinline__ void phase_merge(const Params& p, int bid, int NG, const int wvid) {
    const bf16_t* G = (const bf16_t*)(p.ws + WS_Z); bf16_t* XN = (bf16_t*)(p.ws + WS_XN);
    int tid = TIDX; asm volatile("" : "+v"(tid));
    for (int idx = bid * 512 + tid; idx < MPAD * 128; idx += NG * 512) { const int row = idx >> 7, c = (idx & 127) * 8;
        const bf16_t* gr = G + (size_t)row * 3072 + c; const F8 a = unpack8(*(const u32x4*)gr), b = unpack8(*(const u32x4*)(gr + 1024)), d = unpack8(*(const u32x4*)(gr + 2048));
        *(u32x4*)(XN + (size_t)row * DM + c) = pack8(a.a + b.a + d.a, a.b + b.b + d.b); }
}

__device__ __forceinline__ void phase_final(const Params& p, int bid, int G, const int wvid) {
    int tid = TIDX; asm volatile("" : "+v"(tid));
    const int wave = tid >> 6, lane = tid & 63; const float* g = p.in[30];
    for (int row = bid * 8 + wave; row < MROWS; row += G * 8) {
        f32x4* xr = (f32x4*)(p.out + (size_t)row * DM) + lane; f32x4 v[4]; float s = 0.f;
#pragma unroll
        for (int j = 0; j < 4; ++j) { v[j] = xr[64 * j]; s += (v[j][0] * v[j][0] + v[j][1] * v[j][1]) + (v[j][2] * v[j][2] + v[j][3] * v[j][3]); }
        const float rstd = rsqrtf(wave_sum(s) * (1.f / DM) + 1e-6f); const f32x4* gr = (const f32x4*)g + lane;
#pragma unroll
        for (int j = 0; j < 4; ++j) xr[64 * j] = v[j] * rstd * gr[64 * j];
    }
}


#define XB_TMO      128
#define XB_XCNT(j)  (256  + 64 * (j))
#define XB_XSUB(j)  (1280 + 64 * (j))
#define XB_XGEN(j)  (2304 + 64 * (j))
#define XB_TOP      3328
#define XB_TOPGEN   3392
#define XCD_BAR_WORDS 3456
#define XB_SPIN_CAP (1u << 18)
__device__ __forceinline__ unsigned xb_ld(unsigned* p)              { return __hip_atomic_load(p, __ATOMIC_RELAXED, __HIP_MEMORY_SCOPE_AGENT); }
__device__ __forceinline__ unsigned xb_add(unsigned* p, unsigned v) { return __hip_atomic_fetch_add(p, v, __ATOMIC_RELAXED, __HIP_MEMORY_SCOPE_AGENT); }
__device__ __forceinline__ unsigned xb_xcc_id() { return (unsigned)__builtin_amdgcn_s_getreg((3 << 11) | 20) & 0xFu; }
#define XB_SPIN(cond, bar) do { unsigned _sp = 0; while (cond) { __builtin_amdgcn_s_sleep(1); \
    if ((++_sp & 255u) == 0u) { if (xb_ld(&(bar)[XB_TMO])) break; if (_sp > XB_SPIN_CAP) { atomicAdd(&(bar)[XB_TMO], 1u); break; } } } } while (0)
__device__ __forceinline__ void xcd_barrier_complete(unsigned* bar, unsigned x, unsigned G, unsigned& nloc, unsigned& nx) {
    unsigned sum, cnt, mine, sp = 0u;
    for (;;) {
        sum = 0u; cnt = 0u; mine = 0u;
#pragma unroll
        for (unsigned j = 0; j < 16; ++j) { const unsigned c = xb_ld(&bar[XB_XCNT(j)]); sum += c; cnt += (c > 0u) ? 1u : 0u; mine = (j == x) ? c : mine; }
        if (sum == G) break;
        __builtin_amdgcn_s_sleep(1);
        if ((++sp & 255u) == 0u) { if (xb_ld(&bar[XB_TMO])) break; if (sp > XB_SPIN_CAP) { atomicAdd(&bar[XB_TMO], 1u); break; } }
    }
    nloc = mine > 0u ? mine : 1u; nx = cnt > 0u ? cnt : 1u;
}
__device__ __forceinline__ void xcd_barrier(unsigned* bar, volatile LAS unsigned* st, unsigned G, const int wvid) {
    asm volatile("s_waitcnt vmcnt(0)" ::: "memory");
    __syncthreads();
    if (TIDX == 0) {
        const unsigned x = xb_xcc_id();
        __builtin_amdgcn_s_waitcnt(0);
        unsigned nloc = st[0], nx = st[1];
        if (nloc == 0u) { xcd_barrier_complete(bar, x, G, nloc, nx); st[0] = nloc; st[1] = nx; }
        const unsigned old = xb_add(&bar[XB_XSUB(x)], 1u);
        const unsigned gen = old / nloc;
        if (old + 1u == (gen + 1u) * nloc) {
            __builtin_amdgcn_fence(__ATOMIC_RELEASE, "agent");
            asm volatile("s_waitcnt vmcnt(0)" ::: "memory");
            const unsigned og = xb_add(&bar[XB_TOP], 1u);
            const unsigned tg = og / nx;
            if (og + 1u == (tg + 1u) * nx) xb_add(&bar[XB_TOPGEN], 1u);
            else XB_SPIN(xb_ld(&bar[XB_TOPGEN]) == tg, bar);
            __builtin_amdgcn_fence(__ATOMIC_ACQUIRE, "agent");
            xb_add(&bar[XB_XGEN(x)], 1u);
            asm volatile("s_waitcnt vmcnt(0)" ::: "memory");
        } else {
            XB_SPIN(xb_ld(&bar[XB_XGEN(x)]) == gen, bar);
            __builtin_amdgcn_fence(__ATOMIC_ACQUIRE, "agent");
            asm volatile("s_waitcnt vmcnt(0)" ::: "memory");
        }
    }
    __syncthreads();
}

__global__ void __launch_bounds__(512, 2) mega(Params pk) {
    extern __shared__ __attribute__((aligned(16))) unsigned char shm[];
    LAS unsigned char* lds = (LAS unsigned char*)shm;
    cg::grid_group grid = cg::this_grid();
    const int wvid = __builtin_amdgcn_readfirstlane((int)threadIdx.x >> 6);
    volatile LAS unsigned* bst = (volatile LAS unsigned*)(lds + 131072 + 1024);
    if (TIDX < 2) bst[TIDX] = 0u;
    if (blockIdx.x == 0) for (int i = TIDX; i < XCD_BAR_WORDS; i += 512) ((unsigned*)(pk.ws + WS_BAR))[i] = 0u;
    __syncthreads();
    bool posted = false;
    for (int ph = pk.ph_lo; ph < pk.ph_hi; ++ph) {
        Params p = pk; int G = gridDim.x, bid = blockIdx.x;
        asm volatile("" : "+s"(p.ws), "+s"(p.out), "+s"(G), "+s"(bid));
        bf16_t* XN = (bf16_t*)(p.ws + WS_XN); bf16_t* Z = (bf16_t*)(p.ws + WS_Z); bf16_t* Y0 = (bf16_t*)(p.ws + WS_Y); bf16_t* W = (bf16_t*)(p.ws + WS_W); bf16_t* H = (bf16_t*)(p.ws + WS_H);
        if (ph == NPH - 1) { phase_final(p, bid, G, wvid); }
        else {
            const int l = ph / PH_PER_LAYER, k = ph % PH_PER_LAYER;
            const float* xp = l == 0 ? p.in[0] : p.out; const float* xs = l == 0 ? p.in[1] : p.out + (size_t)MPR * DM;
            pg8::Order S; pg8::Gemm g;
            for (int rep = ((REPMASK >> k) & 1u) ? 2 : 1; rep > 0; --rep)
            switch (k) {
            case 0: phase_prep(p, l, lds, xp, xs, bid, G, wvid); break;
            case 1: { S.init(NTM, ZC / 256, G, bid, 0); g = {XN, W + W_IN, DM, DM, DM}; EpiZ E{Z, p.out, l}; pg8::gemm_phase(lds, g, S, E, wvid); } break;
            case 2: phase_mix(p, l, lds, bid, G, wvid); break;
            case 3: { S.init(64, 8, G, bid, 1); g = {Y0, W + W_RI, DRNN, 256, 256};
                      EpiRI E{Y0, Z + UE, Z + 5 * UE, p.in[13] + (size_t)l * DRNN, p.in[15] + (size_t)l * DRNN, (const float*)(p.ws + WS_SP)}; pg8::gemm_phase(lds, g, S, E, wvid);
                      sample_gemm<true>(lds, Y0 + (size_t)MPR * DRNN, DRNN, W + W_RI, 256, 256, 64, bid, G, E, wvid); } break;
            case 4: phase_scan(p, l, lds, bid, G, wvid); break;
            case 5: { S.init(64, 12, G, bid, 0); g = {XN, W + W_IN + (size_t)ZC * DM, DM, DM, DM}; EpiG E{Z}; pg8::gemm_phase(lds, g, S, E, wvid);
                      sample_gemm<false>(lds, XN + (size_t)MPR * DM, DM, W + W_IN + (size_t)ZC * DM, DM, DM, 3072 / 16, bid, G, E, wvid); } break;
            case 6: { { S.init(64, 4, G, bid, 0); g = {Y0 + 2 * UE, W + W_PA, DPOOL, DPOOL, DPOOL}; EpiP E{Z, XN, 0, 1}; pg8::gemm_phase(lds, g, S, E, wvid);
                        sample_gemm<false>(lds, Y0 + 2 * UE + (size_t)MPR * DPOOL, DPOOL, W + W_PA, DPOOL, DPOOL, 64, bid, G, E, wvid); }
                      { S.init(64, 4, G, bid, 0); g = {Y0, W + W_PB, DRNN, DRNN, DRNN}; EpiP E{Z, XN, 1024, 0}; pg8::gemm_phase(lds, g, S, E, wvid);
                        sample_gemm<false>(lds, Y0 + (size_t)MPR * DRNN, DRNN, W + W_PB, DRNN, DRNN, 64, bid, G, E, wvid); }
                      { S.init(64, 4, G, bid, 0); g = {Y0 + 3 * UE, W + W_PC, DCH, DCH, DCH}; EpiP E{Z, XN, 2048, 0}; pg8::gemm_phase(lds, g, S, E, wvid);
                        sample_gemm<false>(lds, Y0 + 3 * UE + (size_t)MPR * DCH, DCH, W + W_PC, DCH, DCH, 64, bid, G, E, wvid); } } break;
            case 7: break;
            case 8: { S.init(64, 4, G, bid, 0); g = {XN, W + W_O, DM, DM, DM}; EpiX E{xp, xs, p.out}; pg8::gemm_phase(lds, g, S, E, wvid);
                      sample_gemm<false>(lds, XN + (size_t)MPR * DM, DM, W + W_O, DM, DM, 64, bid, G, E, wvid); } break;
            case 9: { int tid = TIDX; asm volatile("" : "+v"(tid)); const int wave = tid >> 6, lane = tid & 63; rms_rows(p.out, p.out + (size_t)MPR * DM, p.in[24] + (size_t)l * DM, XN, bid * 8 + wave, G * 8, lane); } break;
            case 10: { S.init(64, 12, G, bid, 0); g = {XN, W + W_G, DM, DM, DM}; EpiGpre E{Z, p.out, l}; pg8::gemm_phase(lds, g, S, E, wvid);
                       sample_gemm<false>(lds, XN + (size_t)MPR * DM, DM, W + W_G, DM, DM, 192, bid, G, E, wvid); } break;
            case 11: { S.init(64, 12, G, bid, 0); g = {XN, W + W_U, DM, DM, DM};
                       EpiH E{Z, H, p.in[27] + (size_t)l * 3 * DFF, p.in[28] + (size_t)l * DFF, p.in[5] + (size_t)l * NS * 2 * DFF}; pg8::gemm_phase(lds, g, S, E, wvid);
                       sample_gemm<false>(lds, XN + (size_t)MPR * DM, DM, W + W_U, DM, DM, 192, bid, G, E, wvid); } break;
            default: { S.init(64, 4, G, bid, 0); g = {H, W + W_D, DFF, DFF, DFF}; EpiX E{p.out, p.out + (size_t)MPR * DM, p.out}; pg8::gemm_phase(lds, g, S, E, wvid);
                       sample_gemm<false>(lds, H + (size_t)MPR * DFF, DFF, W + W_D, DFF, DFF, 64, bid, G, E, wvid); } break;
            }
        }
        if (ph + 1 < pk.ph_hi && (ph % PH_PER_LAYER) != 7) {
            if (!posted) {
                grid.sync(); posted = true;
                if (TIDX == 0) (void)xb_add(&((unsigned*)(pk.ws + WS_BAR))[XB_XCNT(xb_xcc_id())], 1u);
            } else xcd_barrier((unsigned*)(pk.ws + WS_BAR), bst, (unsigned)gridDim.x, wvid);
            for (int e = 0; e < EXTRA_SYNCS; ++e) xcd_barrier((unsigned*)(pk.ws + WS_BAR), bst, (unsigned)gridDim.x, wvid);
        }
    }
}

extern "C" void kernel_launch(void* const* d_in, const int* in_sizes, int n_in, void* d_out, int out_size, void* d_ws, size_t ws_size, hipStream_t stream) {
    static int grid = 0;
    if (grid == 0) {
        int dev = 0, cus = 0, per_cu = 0;
        hipGetDevice(&dev);
        hipDeviceGetAttribute(&cus, hipDeviceAttributeMultiprocessorCount, dev);
        if (hipFuncSetAttribute((const void*)mega, hipFuncAttributeMaxDynamicSharedMemorySize, LDS_BYTES) != hipSuccess) fprintf(stderr, "kernel_launch: hipFuncSetAttribute failed\n");
        if (hipOccupancyMaxActiveBlocksPerMultiprocessor(&per_cu, (const void*)mega, 512, LDS_BYTES) != hipSuccess || per_cu < 1) { fprintf(stderr, "kernel_launch: occupancy query says %d blocks per CU\n", per_cu); per_cu = 1; }
        (void)hipGetLastError();
        grid = cus;
        if (n_in != 31 || ws_size < WS_END) fprintf(stderr, "kernel_launch: unexpected n_in %d / ws_size %zu (need %zu)\n", n_in, ws_size, (size_t)WS_END);
    }
    Params p{};
    for (int i = 0; i < 31; ++i) p.in[i] = (const float*)d_in[i];
    p.out = (float*)d_out; p.ws = (unsigned char*)d_ws; p.ph_lo = 0; p.ph_hi = NPH;
    void* args[] = {&p};
    hipError_t e = hipLaunchCooperativeKernel((const void*)mega, dim3(grid), dim3(512), args, LDS_BYTES, stream);
    if (e != hipSuccess) fprintf(stderr, "cooperative launch failed: %s (grid %d)\n", hipGetErrorString(e), grid);
}
```

```cpp
#include <hip/hip_runtime.h>
#include <hip/hip_cooperative_groups.h>
#include <cstdio>
#include <cstdint>
namespace cg = cooperative_groups;

#define LAS __attribute__((address_space(3)))
typedef unsigned short bf16_t;
typedef short bf16x8 __attribute__((ext_vector_type(8)));
typedef float f32x4 __attribute__((ext_vector_type(4)));
typedef float f32x2 __attribute__((ext_vector_type(2)));
typedef unsigned u32x4 __attribute__((ext_vector_type(4)));
typedef unsigned u32x2 __attribute__((ext_vector_type(2)));

constexpr int DM = 1024, NB = 8, SEQ = 2048, MPR = NB * SEQ, NS = 128, MROWS = MPR + NS, MPAD = 16640, NTM = MPAD / 256;
constexpr int DPOOL = 512, DRNN = 1024, DCH = 512, DFF = 3072, INCOLS = 6656, ZC = 3584;
constexpr int NLAYER = 2, PH_PER_LAYER = 13, NPH = NLAYER * PH_PER_LAYER + 1;
constexpr size_t O_Y = 0;
constexpr size_t O_POOL_P = (size_t)MROWS * DM;
constexpr size_t O_POOL_S = O_POOL_P + (size_t)2 * NB * 15 * DPOOL;
constexpr size_t O_RC_P = O_POOL_S + (size_t)2 * NS * 15 * DPOOL;
constexpr size_t O_RC_S = O_RC_P + (size_t)2 * NB * 3 * DRNN;
constexpr size_t O_H_P = O_RC_S + (size_t)2 * NS * 3 * DRNN;
constexpr size_t O_H_S = O_H_P + (size_t)2 * NB * DRNN;
constexpr size_t O_FF_P = O_H_S + (size_t)2 * NS * DRNN;
constexpr size_t O_FF_S = O_FF_P + (size_t)2 * NB * 2 * DFF;
constexpr size_t O_CV_S = O_FF_S + (size_t)2 * NS * 2 * DFF;
constexpr size_t UE = (size_t)MPAD * 512, UB = UE * 2;
constexpr size_t WS_BAR = 16384;
constexpr size_t WS_SSP = 65536;
constexpr size_t WS_CNT = 524288;
constexpr int CNT_WORDS = 4 * 64 * 16;
constexpr size_t WS_SP = 4096;
constexpr size_t WS_XN = 1u << 20;
constexpr size_t WS_Z = WS_XN + 2 * UB;
constexpr size_t WS_Y = WS_Z + 7 * UB;
constexpr size_t WS_W = WS_Y + 4 * UB;
constexpr size_t WS_H = WS_Z + 6 * UB;
constexpr size_t W_IN = 0;
constexpr size_t W_PA = W_IN + (size_t)INCOLS * DM;
constexpr size_t W_PB = W_PA + (size_t)DM * DPOOL;
constexpr size_t W_PC = W_PB + (size_t)DM * DRNN;
constexpr size_t W_O = W_PC + (size_t)DM * DCH;
constexpr size_t W_G = W_O + (size_t)DM * DM;
constexpr size_t W_U = W_G + (size_t)DFF * DM;
constexpr size_t W_D = W_U + (size_t)DFF * DM;
constexpr size_t W_RI = W_D + (size_t)DM * DFF;
constexpr size_t W_END = W_RI + (size_t)8 * 256 * 256;
constexpr size_t WS_END = WS_W + W_END * 2;
static_assert(WS_END <= (256u << 20), "workspace");
static_assert(WS_H + 6 * UB <= WS_W + (W_G)*2, "h overlay must not reach wg/wu/wd");
constexpr int LDS_BYTES = 131072 + 2048 + 4096;
constexpr int LDS_PART = 131072 + 2048;
#ifndef REPMASK
#define REPMASK 0u
#endif
#ifndef EXTRA_SYNCS
#define EXTRA_SYNCS 0
#endif

struct Params { const float* in[31]; float* out; unsigned char* ws; int ph_lo, ph_hi; };

__device__ __forceinline__ int tidx_of(int wvid) { unsigned z = 0u; asm volatile("" : "+v"(z));
    return wvid * 64 + (int)__builtin_amdgcn_mbcnt_hi(~0u, __builtin_amdgcn_mbcnt_lo(~0u, z)); }
#define TIDX tidx_of(wvid)
__device__ __forceinline__ float bf_lo(unsigned w) { return __builtin_bit_cast(float, w << 16); }
__device__ __forceinline__ float bf_hi(unsigned w) { return __builtin_bit_cast(float, w & 0xffff0000u); }
__device__ __forceinline__ float bf2f(bf16_t b) { return __builtin_bit_cast(float, (unsigned)b << 16); }
typedef __bf16 bf16x2_t __attribute__((ext_vector_type(2)));
__device__ __forceinline__ unsigned pk2(float lo, float hi) { f32x2 v = {lo, hi}; bf16x2_t b = __builtin_convertvector(v, bf16x2_t); return __builtin_bit_cast(unsigned, b); }
__device__ __forceinline__ bf16_t f2bf(float f) { return (bf16_t)(pk2(f, 0.f) & 0xffffu); }
struct F8 { f32x4 a, b; };
__device__ __forceinline__ F8 unpack8(u32x4 w) { F8 r; r.a[0] = bf_lo(w.x); r.a[1] = bf_hi(w.x); r.a[2] = bf_lo(w.y); r.a[3] = bf_hi(w.y); r.b[0] = bf_lo(w.z); r.b[1] = bf_hi(w.z); r.b[2] = bf_lo(w.w); r.b[3] = bf_hi(w.w); return r; }
__device__ __forceinline__ u32x4 pack8(f32x4 a, f32x4 b) { u32x4 w; w.x = pk2(a[0], a[1]); w.y = pk2(a[2], a[3]); w.z = pk2(b[0], b[1]); w.w = pk2(b[2], b[3]); return w; }
__device__ __forceinline__ float gelu_t(float x) {
    const float u = 0.7978845608f * (x + 0.044715f * x * x * x);
    const float e = __builtin_amdgcn_exp2f(-2.885390082f * u);
    return x * __builtin_amdgcn_rcpf(1.f + e);
}
__device__ __forceinline__ f32x4 gelu4(f32x4 v) { f32x4 r; r[0] = gelu_t(v[0]); r[1] = gelu_t(v[1]); r[2] = gelu_t(v[2]); r[3] = gelu_t(v[3]); return r; }
__device__ __forceinline__ float sigm(float x) { return __builtin_amdgcn_rcpf(1.f + __builtin_amdgcn_exp2f(-1.442695041f * x)); }
__device__ __forceinline__ f32x4 sigm4(f32x4 v) { f32x4 r; r[0] = sigm(v[0]); r[1] = sigm(v[1]); r[2] = sigm(v[2]); r[3] = sigm(v[3]); return r; }
__device__ __forceinline__ float wave_sum(float v) {
#pragma unroll
    for (int o = 1; o < 64; o <<= 1) v += __shfl_xor(v, o);
    return v;
}

__device__ __forceinline__ unsigned dpp_shr1(unsigned old, unsigned src) { return (unsigned)__builtin_amdgcn_update_dpp((int)old, (int)src, 0x111, 0xf, 0xf, false); }
__device__ __forceinline__ unsigned dpp_shr2(unsigned old, unsigned src) { return (unsigned)__builtin_amdgcn_update_dpp((int)old, (int)src, 0x112, 0xf, 0xf, false); }
__device__ __forceinline__ unsigned dpp_ror1(unsigned src) { return (unsigned)__builtin_amdgcn_update_dpp(0, (int)src, 0x121, 0xf, 0xf, false); }
__device__ __forceinline__ unsigned dpp_ror2(unsigned src) { return (unsigned)__builtin_amdgcn_update_dpp(0, (int)src, 0x122, 0xf, 0xf, false); }

namespace pg8 {
constexpr int BM = 256, BK = 64, HALF = 128, HTB = HALF * BK * 2, STAGE_BYTES = 8 * HTB, NXCD = 8, WGM = 4;
__device__ __forceinline__ int lds_byte(int r, int c) { const int st = (r >> 4) * 2 + (c >> 5), rr = r & 15, cc = c & 31, ob = rr * 64 + cc * 2; return st * 1024 + (ob ^ (((ob >> 9) & 1) << 5)); }
__device__ __forceinline__ void stage_rc(int b, int& R, int& C) { const int st = b / 1024, sb = b % 1024, swz = sb ^ (((sb >> 9) & 1) << 5); R = (st >> 1) * 16 + swz / 64; C = (st & 1) * 32 + (swz % 64) / 2; }
__device__ __forceinline__ int perm32(int rho) { const int n = rho >> 4, i = rho & 15; return 8 * (i >> 2) + 4 * n + (i & 3); }

struct Unit { int pm, pn, ka; };
struct Gemm { const bf16_t* A; const bf16_t* Bt; int lda, ldb, K; };

struct Order {
    int nM, nN, nwg, G, c, mode;
    __device__ __forceinline__ void init(int nM_, int nN_, int G_, int c_, int mode_) { nM = nM_; nN = nN_; nwg = nM * nN; G = G_; c = c_; mode = mode_; }
    __device__ __forceinline__ bool next(int i, Unit& u) const {
        const long L = (long)i * G + c; if (L >= nwg) return false;
        int wgid = (int)L; { const int q = nwg / NXCD, r = nwg % NXCD, xcd = wgid % NXCD, off = wgid / NXCD; wgid = (xcd < r ? xcd * (q + 1) : r * (q + 1) + (xcd - r) * q) + off; }
        const int nig = WGM * nN, gid = wgid / nig, fm = gid * WGM, gsz = (nM - fm) < WGM ? (nM - fm) : WGM;
        u.pm = fm + ((wgid % nig) % gsz); u.pn = (wgid % nig) / gsz; u.ka = mode ? ((u.pn & ~1) * 128) : 0; return true;
    }
};

template <class Epi>
__device__ __forceinline__ void gemm_phase(LAS unsigned char* lds, const Gemm g, const Order& S, const Epi& E, const int wvid) {
    int tid = TIDX; asm volatile("" : "+v"(tid));
    const int wid = __builtin_amdgcn_readfirstlane(tid >> 6), lane = tid & 63, wr = wid >> 2, wc = wid & 3, fr = lane & 15, fq = lane >> 4;
    const int K = g.K, nt = K / BK;
    unsigned voffA[2], voffB[2];
#pragma unroll
    for (int i = 0; i < 2; ++i) { int R, C; stage_rc(tid * 16 + i * 8192, R, C); const int Rb = Epi::PERM ? ((R & ~31) + perm32(R & 31)) : R;
        voffA[i] = (unsigned)(R * g.lda + C) * 2u; voffB[i] = (unsigned)(Rb * g.ldb + C) * 2u; }
    const size_t kstep = (size_t)(BK * 2);
    const size_t hstepA = (size_t)HALF * g.lda * 2, tstepA = 2 * hstepA;
    const size_t hstepB = (size_t)HALF * g.ldb * 2, tstepB = 2 * hstepB;
    const unsigned ldsw = (unsigned)wid * 1024u;
    const int aoff = lds_byte(wr * 64 + fr, fq * 8), boff = lds_byte(wc * 32 + fr, fq * 8);
#define PG8_SA(b, h) (((b) * 2 + (h)) * HTB)
#define PG8_SB(b, h) ((4 + (b) * 2 + (h)) * HTB)
#define PG8_STAGE(bufoff, gbase, voff) do { _Pragma("unroll") for (int _i = 0; _i < 2; ++_i) \
        __builtin_amdgcn_global_load_lds((const unsigned*)((const char*)(gbase) + (voff)[_i]), (LAS unsigned*)(lds + (bufoff) + ldsw + _i * 8192), 16, 0, 0); } while (0)
#define PG8_LDA(dst, b, h) do { _Pragma("unroll") for (int m = 0; m < 4; ++m) _Pragma("unroll") for (int k = 0; k < 2; ++k) dst[m][k] = *(const LAS bf16x8*)(lds + PG8_SA(b, h) + aoff + m * 2048 + k * 1024); } while (0)
#define PG8_LDB(dst, b, h) do { _Pragma("unroll") for (int n = 0; n < 2; ++n) _Pragma("unroll") for (int k = 0; k < 2; ++k) dst[n][k] = *(const LAS bf16x8*)(lds + PG8_SB(b, h) + boff + n * 2048 + k * 1024); } while (0)
#define PG8_MMA(ai, bj, At, Bt) do { __builtin_amdgcn_s_setprio(1); _Pragma("unroll") for (int m = 0; m < 4; ++m) _Pragma("unroll") for (int n = 0; n < 2; ++n) _Pragma("unroll") for (int k = 0; k < 2; ++k) \
        acc[ai][bj][m][n] = __builtin_amdgcn_mfma_f32_16x16x32_bf16(Bt[n][k], At[m][k], acc[ai][bj][m][n], 0, 0, 0); __builtin_amdgcn_s_setprio(0); } while (0)
#define PG8_WAIT_V(n) asm volatile("s_waitcnt vmcnt(" #n ")" ::: "memory")
#define PG8_WAIT_L(n) asm volatile("s_waitcnt lgkmcnt(" #n ")" ::: "memory")
#define PG8_BAR __builtin_amdgcn_s_barrier()
#define PG8_SCHED __builtin_amdgcn_sched_barrier(0)
    Unit cur, nxt; int ui = 0;
    if (!S.next(0, cur)) return;
    f32x4 acc[2][2][4][2];
#pragma unroll
    for (int a = 0; a < 2; ++a)
#pragma unroll
        for (int b = 0; b < 2; ++b)
#pragma unroll
            for (int m = 0; m < 4; ++m)
#pragma unroll
                for (int n = 0; n < 2; ++n) acc[a][b][m][n] = (f32x4){0.f, 0.f, 0.f, 0.f};
    bf16x8 At[4][2], B0[2][2], B1[2][2];
    const char* cA = (const char*)g.A + (size_t)cur.pm * tstepA + (size_t)cur.ka * 2; const char* cB = (const char*)g.Bt + (size_t)cur.pn * tstepB;
    PG8_STAGE(PG8_SB(0, 0), cB, voffB); PG8_STAGE(PG8_SB(0, 1), cB + hstepB, voffB); PG8_STAGE(PG8_SA(0, 0), cA, voffA); PG8_STAGE(PG8_SA(0, 1), cA + hstepA, voffA);
    if (wr == 1) PG8_BAR;
    PG8_WAIT_V(2); PG8_BAR;
    PG8_STAGE(PG8_SB(1, 0), cB + kstep, voffB); PG8_STAGE(PG8_SA(1, 0), cA + kstep, voffA); PG8_STAGE(PG8_SB(1, 1), cB + hstepB + kstep, voffB);
    PG8_WAIT_V(6); PG8_BAR;
    for (;;) {
        const bool has_next = S.next(ui + 1, nxt);
        const char* nA = has_next ? (const char*)g.A + (size_t)nxt.pm * tstepA + (size_t)nxt.ka * 2 : cA; const char* nB = has_next ? (const char*)g.Bt + (size_t)nxt.pn * tstepB : cB;
#pragma unroll 1
        for (int t = 0; t < nt; t += 2) {
            const bool last = (t == nt - 2);
            const char* a1 = cA + (size_t)(t + 1) * kstep;
            const char* a2 = last ? nA : cA + (size_t)(t + 2) * kstep; const char* b2 = last ? nB : cB + (size_t)(t + 2) * kstep;
            const char* a3 = a2 + kstep; const char* b3 = b2 + kstep;
            PG8_LDB(B0, 0, 0); PG8_LDB(B1, 0, 1); PG8_SCHED; PG8_LDA(At, 0, 0); PG8_STAGE(PG8_SA(1, 1), a1 + hstepA, voffA);
            PG8_WAIT_V(8); PG8_WAIT_L(0); PG8_BAR; PG8_MMA(0, 0, At, B0); PG8_MMA(0, 1, At, B1); PG8_BAR; PG8_SCHED;
            PG8_LDA(At, 0, 1); PG8_STAGE(PG8_SB(0, 0), b2, voffB); PG8_STAGE(PG8_SB(0, 1), b2 + hstepB, voffB); PG8_STAGE(PG8_SA(0, 0), a2, voffA);
            PG8_WAIT_V(8); PG8_WAIT_L(0); PG8_BAR; PG8_MMA(1, 0, At, B0); PG8_MMA(1, 1, At, B1); PG8_BAR; PG8_SCHED;
            PG8_LDB(B0, 1, 0); PG8_LDB(B1, 1, 1); PG8_SCHED; PG8_LDA(At, 1, 0); PG8_STAGE(PG8_SA(0, 1), a2 + hstepA, voffA);
            PG8_WAIT_V(8); PG8_WAIT_L(0); PG8_BAR; PG8_MMA(0, 0, At, B0); PG8_MMA(0, 1, At, B1); PG8_BAR; PG8_SCHED;
            PG8_LDA(At, 1, 1); PG8_STAGE(PG8_SB(1, 0), b3, voffB); PG8_STAGE(PG8_SB(1, 1), b3 + hstepB, voffB); PG8_STAGE(PG8_SA(1, 0), a3, voffA);
            PG8_WAIT_V(8); PG8_WAIT_L(0); PG8_BAR; PG8_MMA(1, 0, At, B0); PG8_MMA(1, 1, At, B1); PG8_BAR; PG8_SCHED;
        }
        if (wr == 0) PG8_BAR;
        { int fr2 = fr, fq2 = fq; asm volatile("" : "+v"(fr2), "+v"(fq2));
          E(acc, cur, wr, wc, fr2, fq2); }
        if (!has_next) break;
#pragma unroll
        for (int a = 0; a < 2; ++a)
#pragma unroll
            for (int b = 0; b < 2; ++b)
#pragma unroll
                for (int m = 0; m < 4; ++m)
#pragma unroll
                    for (int n = 0; n < 2; ++n) acc[a][b][m][n] = (f32x4){0.f, 0.f, 0.f, 0.f};
        cur = nxt; cA = nA; cB = nB; ++ui;
        if (wr == 1) PG8_BAR;
    }
    PG8_WAIT_V(0);
    PG8_BAR;
#undef PG8_SA
#undef PG8_SB
#undef PG8_STAGE
#undef PG8_LDA
#undef PG8_LDB
#undef PG8_MMA
#undef PG8_WAIT_V
#undef PG8_WAIT_L
#undef PG8_BAR
#undef PG8_SCHED
}
}
using pg8::Unit;

#define EPI_ARGS const f32x4 (&acc)[2][2][4][2], const Unit& u, int wr, int wc, int fr, int fq
struct EpiZ {
    static constexpr bool PERM = true;
    bf16_t* Z; float* out; int l;
    __device__ __forceinline__ void operator()(EPI_ARGS) const {
        const int pn = u.pn; bf16_t* base; int ld, ct; bool act;
        if (pn < 2) { base = Z; ld = 512; ct = pn * 256; act = false; }
        else if (pn < 6) { base = Z + UE; ld = 1024; ct = (pn - 2) * 256; act = false; }
        else if (pn < 10) { base = Z + 3 * UE; ld = 1024; ct = (pn - 6) * 256; act = true; }
        else if (pn < 12) { base = Z + 5 * UE; ld = 512; ct = (pn - 10) * 256; act = true; }
        else { base = Z + 6 * UE; ld = 512; ct = (pn - 12) * 256; act = true; }
        const bool st = (pn < 6) && (((u.pm & 7) == 7) || u.pm == 64);
#pragma unroll
        for (int ai = 0; ai < 2; ++ai)
#pragma unroll
            for (int m = 0; m < 4; ++m) {
                const int row = u.pm * 256 + ai * 128 + wr * 64 + m * 16 + fr;
#pragma unroll
                for (int bj = 0; bj < 2; ++bj) {
                    f32x4 v0 = acc[ai][bj][m][0], v1 = acc[ai][bj][m][1];
                    const int c = ct + bj * 128 + wc * 32 + 8 * fq;
                    if (st) {
                        float* o = nullptr;
                        if (row < MPR) { const int t = row & 2047, b = row >> 11;
                            if (pn < 2) { if (t >= 2033) o = out + O_POOL_P + ((size_t)(l * NB + b) * 15 + (t - 2033)) * DPOOL + c; }
                            else { if (t >= 2045) o = out + O_RC_P + ((size_t)(l * NB + b) * 3 + (t - 2045)) * DRNN + c; } }
                        else if (row < MROWS) { const int s = row - MPR;
                            if (pn < 2) o = out + O_POOL_S + ((size_t)(l * NS + s) * 15 + 14) * DPOOL + c;
                            else o = out + O_RC_S + ((size_t)(l * NS + s) * 3 + 2) * DRNN + c; }
                        if (o) { *(f32x4*)o = v0; *(f32x4*)(o + 4) = v1; }
                    }
                    if (act) { v0 = gelu4(v0); v1 = gelu4(v1); }
                    *(u32x4*)(base + (size_t)row * ld + c) = pack8(v0, v1);
                    asm volatile("" ::: "memory");
                }
            }
    }
    __device__ __forceinline__ void sample(int row, int col, f32x4 v) const {
        const int s = row - MPR; bf16_t* dst;
        if (col < 512) { dst = Z + (size_t)row * 512 + col; *(f32x4*)(out + O_POOL_S + ((size_t)(l * NS + s) * 15 + 14) * DPOOL + col) = v; }
        else if (col < 1536) { dst = Z + UE + (size_t)row * 1024 + (col - 512); *(f32x4*)(out + O_RC_S + ((size_t)(l * NS + s) * 3 + 2) * DRNN + (col - 512)) = v; }
        else if (col < 2560) { dst = Z + 3 * UE + (size_t)row * 1024 + (col - 1536); v = gelu4(v); }
        else if (col < 3072) { dst = Z + 5 * UE + (size_t)row * 512 + (col - 2560); v = gelu4(v); }
        else { dst = Z + 6 * UE + (size_t)row * 512 + (col - 3072); v = gelu4(v); }
        u32x2 w; w.x = pk2(v[0], v[1]); w.y = pk2(v[2], v[3]); *(u32x2*)dst = w;
    }
};
struct EpiRI {
    static constexpr bool PERM = true;
    const bf16_t* BC; bf16_t* LA; bf16_t* BV; const float* ba; const float* bx; const float* sp;
    __device__ __forceinline__ void operator()(EPI_ARGS) const {
        const int ch = u.pn * 128 + wc * 32 + 8 * fq;
        f32x4 bav[2], bxv[2], spv[2];
#pragma unroll
        for (int n = 0; n < 2; ++n) { bav[n] = *(const f32x4*)(ba + ch + 4 * n); bxv[n] = *(const f32x4*)(bx + ch + 4 * n); spv[n] = *(const f32x4*)(sp + ch + 4 * n); }
#pragma unroll
        for (int ai = 0; ai < 2; ++ai) {
            u32x4 xw[4];
#pragma unroll
            for (int m = 0; m < 4; ++m) xw[m] = *(const u32x4*)(BC + (size_t)(u.pm * 256 + ai * 128 + wr * 64 + m * 16 + fr) * DRNN + ch);
#pragma unroll
            for (int m = 0; m < 4; ++m) {
                const int row = u.pm * 256 + ai * 128 + wr * 64 + m * 16 + fr;
                const F8 xc8 = unpack8(xw[m]); f32x4 lav[2], bv[2];
#pragma unroll
                for (int n = 0; n < 2; ++n) {
                    const f32x4 xc = n ? xc8.b : xc8.a;
                    const f32x4 r0 = sigm4(acc[ai][0][m][n] + bav[n]), i0 = sigm4(acc[ai][1][m][n] + bxv[n]);
                    lav[n] = r0 * spv[n];
#pragma unroll
                    for (int j = 0; j < 4; ++j) { const float x = -2.f * lav[n][j];
                        const float em = x < 0.03f ? x * (1.f - x * (0.5f - x * (0.16666667f - x * 0.041666668f))) : 1.f - __expf(-x);
                        bv[n][j] = __builtin_sqrtf(em) * i0[j] * xc[j]; }
                }
                *(u32x4*)(LA + (size_t)row * DRNN + ch) = pack8(lav[0], lav[1]);
                *(u32x4*)(BV + (size_t)row * DRNN + ch) = pack8(bv[0], bv[1]);
            }
            asm volatile("" ::: "memory");
        }
    }
    __device__ __forceinline__ void sample2(int row, int ch, f32x4 vr, f32x4 vi) const {
        const f32x4 ba0 = *(const f32x4*)(ba + ch), bx0 = *(const f32x4*)(bx + ch), sp0 = *(const f32x4*)(sp + ch);
        const u32x2 xw = *(const u32x2*)(BC + (size_t)row * DRNN + ch);
        const f32x4 xc = (f32x4){bf_lo(xw.x), bf_hi(xw.x), bf_lo(xw.y), bf_hi(xw.y)};
        const f32x4 r0 = sigm4(vr + ba0), i0 = sigm4(vi + bx0), la0 = r0 * sp0; f32x4 b0;
#pragma unroll
        for (int j = 0; j < 4; ++j) { const float x = -2.f * la0[j];
            const float em = x < 0.03f ? x * (1.f - x * (0.5f - x * (0.16666667f - x * 0.041666668f))) : 1.f - __expf(-x);
            b0[j] = __builtin_sqrtf(em) * i0[j] * xc[j]; }
        u32x2 wl, wb; wl.x = pk2(la0[0], la0[1]); wl.y = pk2(la0[2], la0[3]); wb.x = pk2(b0[0], b0[1]); wb.y = pk2(b0[2], b0[3]);
        *(u32x2*)(LA + (size_t)row * DRNN + ch) = wl; *(u32x2*)(BV + (size_t)row * DRNN + ch) = wb;
    }
};
struct EpiG {
    static constexpr bool PERM = true;
    bf16_t* G;
    __device__ __forceinline__ void operator()(EPI_ARGS) const {
#pragma unroll
        for (int ai = 0; ai < 2; ++ai)
#pragma unroll
            for (int m = 0; m < 4; ++m) {
                const int row = u.pm * 256 + ai * 128 + wr * 64 + m * 16 + fr;
#pragma unroll
                for (int bj = 0; bj < 2; ++bj) {
                    const int c = u.pn * 256 + bj * 128 + wc * 32 + 8 * fq;
                    *(u32x4*)(G + (size_t)row * 3072 + c) = pack8(sigm4(acc[ai][bj][m][0]), sigm4(acc[ai][bj][m][1]));
                    asm volatile("" ::: "memory");
                }
            }
    }
    __device__ __forceinline__ void sample(int row, int col, f32x4 v) const {
        v = sigm4(v); u32x2 w; w.x = pk2(v[0], v[1]); w.y = pk2(v[2], v[3]); *(u32x2*)(G + (size_t)row * 3072 + col) = w;
    }
};
struct EpiP {
    static constexpr bool PERM = true;
    const bf16_t* G; bf16_t* M; int goff; int first;
    __device__ __forceinline__ void operator()(EPI_ARGS) const {
#pragma unroll
        for (int ai = 0; ai < 2; ++ai)
#pragma unroll
            for (int bj = 0; bj < 2; ++bj) {
                const int c = u.pn * 256 + bj * 128 + wc * 32 + 8 * fq;
                u32x4 gw[4], ow[4];
#pragma unroll
                for (int m = 0; m < 4; ++m) { const int row = u.pm * 256 + ai * 128 + wr * 64 + m * 16 + fr;
                    gw[m] = *(const u32x4*)(G + (size_t)row * 3072 + goff + c);
                    if (!first) ow[m] = *(const u32x4*)(M + (size_t)row * DM + c); }
#pragma unroll
                for (int m = 0; m < 4; ++m) { const int row = u.pm * 256 + ai * 128 + wr * 64 + m * 16 + fr;
                    const F8 gt = unpack8(gw[m]);
                    f32x4 o0 = gt.a * acc[ai][bj][m][0], o1 = gt.b * acc[ai][bj][m][1];
                    if (!first) { const F8 old = unpack8(ow[m]); o0 += old.a; o1 += old.b; }
                    *(u32x4*)(M + (size_t)row * DM + c) = pack8(o0, o1); }
                asm volatile("" ::: "memory");
            }
    }
    __device__ __forceinline__ void sample(int row, int col, f32x4 v) const {
        const u32x2 g = *(const u32x2*)(G + (size_t)row * 3072 + goff + col); u32x2* mp = (u32x2*)(M + (size_t)row * DM + col);
        f32x4 o = (f32x4){bf_lo(g.x) * v[0], bf_hi(g.x) * v[1], bf_lo(g.y) * v[2], bf_hi(g.y) * v[3]};
        if (!first) { const u32x2 old = *mp; o += (f32x4){bf_lo(old.x), bf_hi(old.x), bf_lo(old.y), bf_hi(old.y)}; }
        u32x2 w; w.x = pk2(o[0], o[1]); w.y = pk2(o[2], o[3]); *mp = w;
    }
};
struct EpiX {
    static constexpr bool PERM = true;
    const float* xin_p; const float* xin_s; float* xout;
    int mode; float* SSP; unsigned* cnt; const float* gn; bf16_t* XNo; LAS unsigned char* lds;
    __device__ __forceinline__ void operator()(f32x4 (&acc)[2][2][4][2], const Unit& u, int wr, int wc, int fr, int fq) const {
#pragma unroll
        for (int ai = 0; ai < 2; ++ai)
#pragma unroll
            for (int mp = 0; mp < 2; ++mp) {
                f32x4 xv[2][2][2];
#pragma unroll
                for (int mm = 0; mm < 2; ++mm) { const int row = u.pm * 256 + ai * 128 + wr * 64 + (2 * mp + mm) * 16 + fr; const float* src = xin_p + (size_t)row * DM;
#pragma unroll
                    for (int bj = 0; bj < 2; ++bj)
#pragma unroll
                        for (int n = 0; n < 2; ++n) xv[mm][bj][n] = *(const f32x4*)(src + u.pn * 256 + bj * 128 + wc * 32 + 8 * fq + 4 * n); }
#pragma unroll
                for (int mm = 0; mm < 2; ++mm) { const int row = u.pm * 256 + ai * 128 + wr * 64 + (2 * mp + mm) * 16 + fr; float* dst = xout + (size_t)row * DM;
#pragma unroll
                    for (int bj = 0; bj < 2; ++bj)
#pragma unroll
                        for (int n = 0; n < 2; ++n) { acc[ai][bj][2 * mp + mm][n] += xv[mm][bj][n];
                            if (mode != 2) *(f32x4*)(dst + u.pn * 256 + bj * 128 + wc * 32 + 8 * fq + 4 * n) = acc[ai][bj][2 * mp + mm][n]; } }
                asm volatile("" ::: "memory");
            }
        if (mode == 0) return;
        LAS float* part = (LAS float*)(lds + LDS_PART);
#pragma unroll
        for (int ai = 0; ai < 2; ++ai)
#pragma unroll
            for (int m = 0; m < 4; ++m) { float ss = 0.f;
#pragma unroll
                for (int bj = 0; bj < 2; ++bj)
#pragma unroll
                    for (int n = 0; n < 2; ++n) { const f32x4 v = acc[ai][bj][m][n]; ss += (v[0] * v[0] + v[1] * v[1]) + (v[2] * v[2] + v[3] * v[3]); }
                ss += __shfl_xor(ss, 16); ss += __shfl_xor(ss, 32);
                if (fq == 0) part[wc * 256 + ai * 128 + wr * 64 + m * 16 + fr] = ss; }
        asm volatile("s_waitcnt vmcnt(0) lgkmcnt(0)" ::: "memory"); __builtin_amdgcn_s_barrier(); asm volatile("" ::: "memory");
        const int tl = (wr * 4 + wc) * 64 + fq * 16 + fr;
        if (tl < 256) __hip_atomic_store(SSP + (size_t)(u.pm * 256 + tl) * 4 + u.pn, (part[tl] + part[256 + tl]) + (part[512 + tl] + part[768 + tl]), __ATOMIC_RELAXED, __HIP_MEMORY_SCOPE_AGENT);
        asm volatile("s_waitcnt vmcnt(0) lgkmcnt(0)" ::: "memory"); __builtin_amdgcn_s_barrier(); asm volatile("" ::: "memory");
        if (tl == 0) {
            unsigned* c = cnt + u.pm * 16;
            (void)__hip_atomic_fetch_add(c, 1u, __ATOMIC_RELAXED, __HIP_MEMORY_SCOPE_AGENT);
            unsigned sp = 0u;
            while (__hip_atomic_load(c, __ATOMIC_RELAXED, __HIP_MEMORY_SCOPE_AGENT) < 4u) { __builtin_amdgcn_s_sleep(1); if (++sp > (1u << 20)) break; }
        }
        asm volatile("" ::: "memory"); __builtin_amdgcn_s_barrier(); asm volatile("" ::: "memory");
        if (tl < 256) { float* q = SSP + (size_t)(u.pm * 256 + tl) * 4;
            const float t = (__hip_atomic_load(q, __ATOMIC_RELAXED, __HIP_MEMORY_SCOPE_AGENT) + __hip_atomic_load(q + 1, __ATOMIC_RELAXED, __HIP_MEMORY_SCOPE_AGENT))
                          + (__hip_atomic_load(q + 2, __ATOMIC_RELAXED, __HIP_MEMORY_SCOPE_AGENT) + __hip_atomic_load(q + 3, __ATOMIC_RELAXED, __HIP_MEMORY_SCOPE_AGENT));
            part[tl] = rsqrtf(t * (1.f / DM) + 1e-6f); }
        asm volatile("s_waitcnt vmcnt(0) lgkmcnt(0)" ::: "memory"); __builtin_amdgcn_s_barrier(); asm volatile("" ::: "memory");
        f32x4 g4[2][2];
#pragma unroll
        for (int bj = 0; bj < 2; ++bj)
#pragma unroll
            for (int n = 0; n < 2; ++n) g4[bj][n] = *(const f32x4*)(gn + u.pn * 256 + bj * 128 + wc * 32 + 8 * fq + 4 * n);
#pragma unroll
        for (int ai = 0; ai < 2; ++ai) {
            float rs[4];
#pragma unroll
            for (int m = 0; m < 4; ++m) rs[m] = part[ai * 128 + wr * 64 + m * 16 + fr];
#pragma unroll
            for (int m = 0; m < 4; ++m) { const int row = u.pm * 256 + ai * 128 + wr * 64 + m * 16 + fr;
#pragma unroll
                for (int bj = 0; bj < 2; ++bj) { const int c = u.pn * 256 + bj * 128 + wc * 32 + 8 * fq;
                    const f32x4 o0 = acc[ai][bj][m][0] * rs[m] * g4[bj][0], o1 = acc[ai][bj][m][1] * rs[m] * g4[bj][1];
                    if (mode == 2) { *(f32x4*)(xout + (size_t)row * DM + c) = o0; *(f32x4*)(xout + (size_t)row * DM + c + 4) = o1; }
                    else *(u32x4*)(XNo + (size_t)row * DM + c) = pack8(o0, o1); } }
            asm volatile("" ::: "memory");
        }
    }
    __device__ __forceinline__ void sample(int row, int col, f32x4 v) const {
        *(f32x4*)(xout + (size_t)row * DM + col) = *(const f32x4*)(xin_s + (size_t)(row - MPR) * DM + col) + v;
    }
};
struct EpiGpre {
    static constexpr bool PERM = true;
    bf16_t* GP; float* out; int l;
    __device__ __forceinline__ void operator()(EPI_ARGS) const {
        const bool st = ((u.pm & 7) == 7) || u.pm == 64;
#pragma unroll
        for (int ai = 0; ai < 2; ++ai)
#pragma unroll
            for (int m = 0; m < 4; ++m) {
                const int row = u.pm * 256 + ai * 128 + wr * 64 + m * 16 + fr;
#pragma unroll
                for (int bj = 0; bj < 2; ++bj) {
                    const f32x4 v0 = acc[ai][bj][m][0], v1 = acc[ai][bj][m][1];
                    const int c = u.pn * 256 + bj * 128 + wc * 32 + 8 * fq;
                    if (st) {
                        float* o = nullptr;
                        if (row < MPR) { const int t = row & 2047, b = row >> 11; if (t >= 2046) o = out + O_FF_P + ((size_t)(l * NB + b) * 2 + (t - 2046)) * DFF + c; }
                        else if (row < MROWS) { const int s = row - MPR; o = out + O_FF_S + ((size_t)(l * NS + s) * 2 + 1) * DFF + c; }
                        if (o) { *(f32x4*)o = v0; *(f32x4*)(o + 4) = v1; }
                    }
                    *(u32x4*)(GP + (size_t)row * 3072 + c) = pack8(v0, v1);
                    asm volatile("" ::: "memory");
                }
            }
    }
    __device__ __forceinline__ void sample(int row, int col, f32x4 v) const {
        *(f32x4*)(out + O_FF_S + ((size_t)(l * NS + (row - MPR)) * 2 + 1) * DFF + col) = v;
        u32x2 w; w.x = pk2(v[0], v[1]); w.y = pk2(v[2], v[3]); *(u32x2*)(GP + (size_t)row * 3072 + col) = w;
    }
};
struct EpiH {
    static constexpr bool PERM = true;
    const bf16_t* GP; bf16_t* H; const float* cw; const float* cb; const float* st;
    __device__ __forceinline__ void operator()(EPI_ARGS) const {
#pragma unroll
        for (int bj = 0; bj < 2; ++bj) {
            const int c = u.pn * 256 + bj * 128 + wc * 32 + 8 * fq;
            const f32x4 w00 = *(const f32x4*)(cw + c), w01 = *(const f32x4*)(cw + c + 4);
            const f32x4 w10 = *(const f32x4*)(cw + DFF + c), w11 = *(const f32x4*)(cw + DFF + c + 4);
            const f32x4 w20 = *(const f32x4*)(cw + 2 * DFF + c), w21 = *(const f32x4*)(cw + 2 * DFF + c + 4);
            const f32x4 cb0 = *(const f32x4*)(cb + c), cb1 = *(const f32x4*)(cb + c + 4);
#pragma unroll
            for (int ai = 0; ai < 2; ++ai) {
                const int base = u.pm * 256 + ai * 128 + wr * 64, t0 = base & 2047;
                u32x4 q0[4], E = (u32x4){0u, 0u, 0u, 0u};
#pragma unroll
                for (int m = 0; m < 4; ++m) q0[m] = *(const u32x4*)(GP + (size_t)(base + 16 * m + fr) * 3072 + c);
                if (fr >= 14 && t0 != 0) E = *(const u32x4*)(GP + (size_t)(base - 16 + fr) * 3072 + c);
#pragma unroll
                for (int m = 0; m < 4; ++m) { const int row = base + 16 * m + fr, t = row & 2047;
                    const u32x4 P = m ? q0[m > 0 ? m - 1 : 0] : E; u32x4 r1, r2;
                    r1.x = dpp_shr1(dpp_ror1(P.x), q0[m].x); r1.y = dpp_shr1(dpp_ror1(P.y), q0[m].y); r1.z = dpp_shr1(dpp_ror1(P.z), q0[m].z); r1.w = dpp_shr1(dpp_ror1(P.w), q0[m].w);
                    r2.x = dpp_shr2(dpp_ror2(P.x), q0[m].x); r2.y = dpp_shr2(dpp_ror2(P.y), q0[m].y); r2.z = dpp_shr2(dpp_ror2(P.z), q0[m].z); r2.w = dpp_shr2(dpp_ror2(P.w), q0[m].w);
                    const F8 g0 = unpack8(q0[m]), g1 = unpack8(r1), g2 = unpack8(r2);
                    const float k1 = t >= 1 ? 1.f : 0.f, k2 = t >= 2 ? 1.f : 0.f;
                    const f32x4 s0 = cb0 + w20 * g0.a + (w10 * g1.a) * k1 + (w00 * g2.a) * k2, s1 = cb1 + w21 * g0.b + (w11 * g1.b) * k1 + (w01 * g2.b) * k2;
                    *(u32x4*)(H + (size_t)row * 3072 + c) = pack8(gelu4(s0) * acc[ai][bj][m][0], gelu4(s1) * acc[ai][bj][m][1]); }
                asm volatile("" ::: "memory");
            }
        }
    }
    __device__ __forceinline__ void sample(int row, int col, f32x4 v) const {
        const u32x2 gw = *(const u32x2*)(GP + (size_t)row * 3072 + col); const f32x4 g0 = (f32x4){bf_lo(gw.x), bf_hi(gw.x), bf_lo(gw.y), bf_hi(gw.y)};
        const float* sp = st + (size_t)(row - MPR) * 2 * DFF + col;
        const f32x4 s0 = *(const f32x4*)(cb + col) + *(const f32x4*)(cw + 2 * DFF + col) * g0 + *(const f32x4*)(cw + col) * *(const f32x4*)sp + *(const f32x4*)(cw + DFF + col) * *(const f32x4*)(sp + DFF);
        const f32x4 h = gelu4(s0) * v; u32x2 w; w.x = pk2(h[0], h[1]); w.y = pk2(h[2], h[3]); *(u32x2*)(H + (size_t)row * 3072 + col) = w;
    }
};

template <bool DUAL, class Epi>
__device__ __forceinline__ void sample_gemm(LAS unsigned char* lds, const bf16_t* A, int lda, const bf16_t* Bt, int ldb, int K, int nstrips, int bid, int G, const Epi& E, const int wvid) {
    int tid = TIDX; asm volatile("" : "+v"(tid));
    const int kw = __builtin_amdgcn_readfirstlane(tid >> 6), lane = tid & 63, fr = lane & 15, fq = lane >> 4;
    const int kslice = K >> 3, nks = kslice >> 5;
    LAS f32x4* part = (LAS f32x4*)lds;
    for (int strip = G - 1 - bid; strip < nstrips; strip += G) {
        int n0 = strip * 16, acol = 0, h = 0, cc = 0;
        if (DUAL) { h = strip >> 3; cc = (strip & 7) * 16; n0 = h * 256 + cc; acol = (h & ~1) * 128; }
        f32x4 acc[8], acc2[8];
#pragma unroll
        for (int m = 0; m < 8; ++m) { acc[m] = (f32x4){0.f, 0.f, 0.f, 0.f}; acc2[m] = acc[m]; }
        typedef const __attribute__((address_space(1))) bf16x8* gfrag;
        const bf16_t* bp = Bt + (size_t)(n0 + fr) * ldb + kw * kslice + 8 * fq;
        const bf16_t* ap = A + (size_t)fr * lda + acol + kw * kslice + 8 * fq;
#pragma unroll 1
        for (int ks0 = 0; ks0 < nks; ks0 += 2) {
            bf16x8 bb[2], bb2[2], aa[2][8];
#pragma unroll
            for (int u = 0; u < 2; ++u) if (ks0 + u < nks) {
                bb[u] = *(gfrag)(bp + (ks0 + u) * 32);
                if (DUAL) bb2[u] = *(gfrag)(bp + (size_t)128 * ldb + (ks0 + u) * 32);
#pragma unroll
                for (int m = 0; m < 8; ++m) aa[u][m] = *(gfrag)(ap + (size_t)(16 * m) * lda + (ks0 + u) * 32);
            }
            __builtin_amdgcn_sched_barrier(0);
#pragma unroll
            for (int u = 0; u < 2; ++u) if (ks0 + u < nks) {
#pragma unroll
                for (int m = 0; m < 8; ++m) { acc[m] = __builtin_amdgcn_mfma_f32_16x16x32_bf16(bb[u], aa[u][m], acc[m], 0, 0, 0);
                    if (DUAL) acc2[m] = __builtin_amdgcn_mfma_f32_16x16x32_bf16(bb2[u], aa[u][m], acc2[m], 0, 0, 0); }
            }
            __builtin_amdgcn_sched_barrier(0);
        }
#pragma unroll
        for (int m = 0; m < 8; ++m) part[(kw * 8 + m) * 64 + lane] = acc[m];
        __syncthreads();
        f32x4 v = part[kw * 64 + lane];
#pragma unroll
        for (int k2 = 1; k2 < 8; ++k2) v += part[(k2 * 8 + kw) * 64 + lane];
        const int row = MPR + 16 * kw + fr;
        if constexpr (DUAL) {
            __syncthreads();
#pragma unroll
            for (int m = 0; m < 8; ++m) part[(kw * 8 + m) * 64 + lane] = acc2[m];
            __syncthreads();
            f32x4 v2 = part[kw * 64 + lane];
#pragma unroll
            for (int k2 = 1; k2 < 8; ++k2) v2 += part[(k2 * 8 + kw) * 64 + lane];
            E.sample2(row, h * 128 + cc + 4 * fq, v, v2);
        } else E.sample(row, n0 + 4 * fq, v);
        __syncthreads();
    }
}


__device__ __forceinline__ void transpose_item(const float* W, int K, int N, bf16_t* WT, LAS float* scr, int item, int lane) {
    const int nblk = N / 32, kb = item / nblk, nb = item % nblk, k0 = 64 * kb, n0 = 32 * nb;
    float tv[32];
#pragma unroll
    for (int i = 0; i < 32; ++i) tv[i] = W[(size_t)(k0 + 2 * i + (lane >> 5)) * N + n0 + (lane & 31)];
#pragma unroll
    for (int i = 0; i < 32; ++i) scr[(2 * i + (lane >> 5)) * 33 + (lane & 31)] = tv[i];
    asm volatile("s_waitcnt lgkmcnt(0)" ::: "memory");
    const int c = lane & 7;
#pragma unroll
    for (int j = 0; j < 4; ++j) { const int n = (lane >> 3) + 8 * j; const LAS float* s = scr + (8 * c) * 33 + n;
        u32x4 o; o.x = pk2(s[0 * 33], s[1 * 33]); o.y = pk2(s[2 * 33], s[3 * 33]); o.z = pk2(s[4 * 33], s[5 * 33]); o.w = pk2(s[6 * 33], s[7 * 33]);
        *(u32x4*)(WT + (size_t)(n0 + n) * K + k0 + 8 * c) = o; }
    asm volatile("s_waitcnt lgkmcnt(0)" ::: "memory");
}
__device__ __forceinline__ void rms_row_bf16(const float* xrow, const float* g, bf16_t* orow, int lane) {
    const f32x4* xr = (const f32x4*)xrow + lane; f32x4 v[4]; float s = 0.f;
#pragma unroll
    for (int j = 0; j < 4; ++j) { v[j] = xr[64 * j]; s += (v[j][0] * v[j][0] + v[j][1] * v[j][1]) + (v[j][2] * v[j][2] + v[j][3] * v[j][3]); }
    const float rstd = rsqrtf(wave_sum(s) * (1.f / DM) + 1e-6f);
    const f32x4* gr = (const f32x4*)g + lane; u32x2* o8 = (u32x2*)orow + lane;
#pragma unroll
    for (int j = 0; j < 4; ++j) { const f32x4 o = v[j] * rstd * gr[64 * j]; u32x2 w; w.x = pk2(o[0], o[1]); w.y = pk2(o[2], o[3]); o8[64 * j] = w; }
}
__device__ __forceinline__ void rms_rows(const float* xp, const float* xs, const float* g, bf16_t* XN, int gw, int ngw, int lane, int row0) {
    for (int row = row0 + gw; row < MPAD; row += ngw) {
        if (row < MROWS) rms_row_bf16(row < MPR ? xp + (size_t)row * DM : xs + (size_t)(row - MPR) * DM, g, XN + (size_t)row * DM, lane);
        else { u32x2* o8 = (u32x2*)(XN + (size_t)row * DM) + lane; u32x2 z; z.x = 0u; z.y = 0u;
#pragma unroll
            for (int j = 0; j < 4; ++j) o8[64 * j] = z; }
    }
}

__device__ __forceinline__ void phase_prep(const Params& p, int l, LAS unsigned char* lds, const float* xp, const float* xs, int bid, int G, const int wvid) {
    int tid = TIDX; asm volatile("" : "+v"(tid));
    const int wave = tid >> 6, lane = tid & 63;
    const int gw = bid * 8 + wave, ngw = G * 8;
    bf16_t* W = (bf16_t*)(p.ws + WS_W);
    LAS float* scr = (LAS float*)(lds + wave * 8448);
    const float* w_in = p.in[7] + (size_t)l * DM * INCOLS; const float* w_pb = p.in[21] + (size_t)l * DRNN * DM; const float* w_pc = p.in[22] + (size_t)l * DCH * DM;
    const float* w_o = p.in[23] + (size_t)l * DM * DM; const float* wg = p.in[25] + (size_t)l * DM * DFF; const float* wu = p.in[26] + (size_t)l * DM * DFF; const float* wd = p.in[29] + (size_t)l * DFF * DM;
    constexpr int I_IN = (DM / 64) * (INCOLS / 32), I_PB = (DRNN / 64) * (DM / 32), I_PC = (DCH / 64) * (DM / 32), I_O = (DM / 64) * (DM / 32), I_G = (DM / 64) * (DFF / 32), I_D = (DFF / 64) * (DM / 32);
    constexpr int NITEMS = I_IN + I_PB + I_PC + I_O + 2 * I_G + I_D;
    for (int it = gw; it < NITEMS; it += ngw) {
        int r = it;
        if (r < I_IN) { transpose_item(w_in, DM, INCOLS, W + W_IN, scr, r, lane); continue; } r -= I_IN;
        if (r < I_PB) { transpose_item(w_pb, DRNN, DM, W + W_PB, scr, r, lane); continue; } r -= I_PB;
        if (r < I_PC) { transpose_item(w_pc, DCH, DM, W + W_PC, scr, r, lane); continue; } r -= I_PC;
        if (r < I_O) { transpose_item(w_o, DM, DM, W + W_O, scr, r, lane); continue; } r -= I_O;
        if (r < I_G) { transpose_item(wg, DM, DFF, W + W_G, scr, r, lane); continue; } r -= I_G;
        if (r < I_G) { transpose_item(wu, DM, DFF, W + W_U, scr, r, lane); continue; } r -= I_G;
        transpose_item(wd, DFF, DM, W + W_D, scr, r, lane);
    }
    const int gt = bid * 512 + tid, ngt = G * 512;
    { const float* pw = p.in[8] + (size_t)l * 4 * 128 * 128; const float* ps = p.in[9] + (size_t)l * DPOOL; const float* w_pa = p.in[20] + (size_t)l * DPOOL * DM;
      for (int idx = gt; idx < DPOOL * (DM / 4); idx += ngt) { const int n = (idx & 255) * 4, kp = idx >> 8, g = kp >> 7;
          const float* pr = pw + (size_t)kp * 128; const float* sr = ps + g * 128; const float* wr_ = w_pa + (size_t)g * 128 * DM + n; f32x4 s4 = (f32x4){0.f, 0.f, 0.f, 0.f};
#pragma unroll 16
          for (int j = 0; j < 128; ++j) s4 += (pr[j] * sr[j]) * *(const f32x4*)(wr_ + (size_t)j * DM);
          W[W_PA + (size_t)n * DPOOL + kp] = f2bf(s4[0]); W[W_PA + (size_t)(n + 1) * DPOOL + kp] = f2bf(s4[1]);
          W[W_PA + (size_t)(n + 2) * DPOOL + kp] = f2bf(s4[2]); W[W_PA + (size_t)(n + 3) * DPOOL + kp] = f2bf(s4[3]); } }
    { const float* wa = p.in[12] + (size_t)l * 8 * 128 * 128; const float* wx = p.in[14] + (size_t)l * 8 * 128 * 128;
      for (int idx = gt; idx < 8 * 256 * 256; idx += ngt) { const int k = idx & 255, n = (idx >> 8) & 255, h = idx >> 16; float v = 0.f;
          if ((k >> 7) == (h & 1)) v = (n < 128 ? wa : wx)[((size_t)h * 128 + (k & 127)) * 128 + (n & 127)];
          W[W_RI + idx] = f2bf(v); } }
    if (gt < DRNN) { const float y = __expf(-p.in[16][(size_t)l * DRNN + gt]);
        const float lp = y < 0.05f ? y * (1.f - y * (0.5f - y * (0.33333334f - y * (0.25f - y * 0.2f)))) : __logf(1.f + y);
        ((float*)(p.ws + WS_SP))[gt] = -8.f * lp; }
    rms_rows(xp, xs, p.in[6] + (size_t)l * DM, (bf16_t*)(p.ws + WS_XN), gw, ngw, lane, l == 0 ? 0 : MPR);
}

__device__ __forceinline__ void phase_mix(const Params& p, int l, LAS unsigned char* lds, int bid, int G, const int wvid) {
    int tid = TIDX; asm volatile("" : "+v"(tid));
    const int wave = tid >> 6, lane = tid & 63;
    const bf16_t* Za = (const bf16_t*)(p.ws + WS_Z); const bf16_t* Zbx = Za + UE; const bf16_t* Zgu = Za + 5 * UE; const bf16_t* Zgv = Za + 6 * UE;
    bf16_t* Y0 = (bf16_t*)(p.ws + WS_Y); bf16_t* Yd = Y0 + 2 * UE; bf16_t* Yc = Y0 + 3 * UE;
    const float* vg = p.in[17] + (size_t)l * DCH; const float* cws = p.in[18] + (size_t)l * 4 * 128 * 128; const float* cbs = p.in[19] + (size_t)l * 4 * 128;
    if (bid < 128) {
        const int r0 = bid * 128;
        LAS float* rstd = (LAS float*)lds; LAS bf16_t* VT = (LAS bf16_t*)(lds + 1024);
        { const int j = tid >> 2, q = tid & 3; const u32x4* src = (const u32x4*)(Zgv + (size_t)(r0 + j) * DCH + q * 128); float s = 0.f;
#pragma unroll
          for (int i = 0; i < 16; ++i) { const F8 v = unpack8(src[i]); s += (v.a[0] * v.a[0] + v.a[1] * v.a[1]) + (v.a[2] * v.a[2] + v.a[3] * v.a[3]) + (v.b[0] * v.b[0] + v.b[1] * v.b[1]) + (v.b[2] * v.b[2] + v.b[3] * v.b[3]); }
          s += __shfl_xor(s, 1); s += __shfl_xor(s, 2);
          if (q == 0) rstd[j] = rsqrtf(s * (1.f / DCH) + 1e-6f); }
        __syncthreads();
        const int fr = lane & 15, fq = lane >> 4;
        for (int g = 0; g < 4; ++g) {
            { const int j = tid >> 2, q = tid & 3; const float rs = rstd[j];
              const u32x4* src = (const u32x4*)(Zgv + (size_t)(r0 + j) * DCH + g * 128 + q * 32); const float* gg = vg + g * 128 + q * 32;
#pragma unroll
              for (int i = 0; i < 4; ++i) { const F8 v = unpack8(src[i]); const f32x4 g0 = *(const f32x4*)(gg + 8 * i), g1 = *(const f32x4*)(gg + 8 * i + 4);
                  const int d = q * 32 + 8 * i;
#pragma unroll
                  for (int e = 0; e < 4; ++e) { VT[(d + e) * 136 + j] = f2bf(v.a[e] * rs * g0[e]); VT[(d + 4 + e) * 136 + j] = f2bf(v.b[e] * rs * g1[e]); } } }
            __syncthreads();
            const int i = 16 * wave + fr; bf16x8 af[4];
#pragma unroll
            for (int ks = 0; ks < 4; ++ks) { const int k0 = 32 * ks + 8 * fq; const float* wrow = cws + ((size_t)g * 128 + i) * 128 + k0;
                const f32x4 a0 = *(const f32x4*)wrow, a1 = *(const f32x4*)(wrow + 4); u32x4 w;
                w.x = pk2(k0 + 0 <= i ? a0[0] : 0.f, k0 + 1 <= i ? a0[1] : 0.f); w.y = pk2(k0 + 2 <= i ? a0[2] : 0.f, k0 + 3 <= i ? a0[3] : 0.f);
                w.z = pk2(k0 + 4 <= i ? a1[0] : 0.f, k0 + 5 <= i ? a1[1] : 0.f); w.w = pk2(k0 + 6 <= i ? a1[2] : 0.f, k0 + 7 <= i ? a1[3] : 0.f);
                af[ks] = __builtin_bit_cast(bf16x8, w); }
            const float bsv = cbs[g * 128 + i];
#pragma unroll
            for (int dt = 0; dt < 8; ++dt) {
                f32x4 c4 = (f32x4){0.f, 0.f, 0.f, 0.f};
#pragma unroll
                for (int ks = 0; ks < 4; ++ks) { const bf16x8 vf = *(const LAS bf16x8*)(VT + (16 * dt + fr) * 136 + 32 * ks + 8 * fq);
                    c4 = __builtin_amdgcn_mfma_f32_16x16x32_bf16(vf, af[ks], c4, 0, 0, 0); }
                const size_t off = (size_t)(r0 + i) * DCH + g * 128 + 16 * dt + 4 * fq;
                const u32x2 uu = *(const u32x2*)(Zgu + off); u32x2 o;
                o.x = pk2(bf_lo(uu.x) * (c4[0] + bsv), bf_hi(uu.x) * (c4[1] + bsv)); o.y = pk2(bf_lo(uu.y) * (c4[2] + bsv), bf_hi(uu.y) * (c4[3] + bsv));
                *(u32x2*)(Yc + off) = o;
            }
            __syncthreads();
        }
    } else if (bid < 144) {
        const int s = (bid - 128) * 8 + wave, row = MPR + s, c = lane * 8, g = lane >> 4;
        const F8 v = unpack8(*(const u32x4*)(Zgv + (size_t)row * DCH + c));
        float ss = (v.a[0] * v.a[0] + v.a[1] * v.a[1]) + (v.a[2] * v.a[2] + v.a[3] * v.a[3]) + (v.b[0] * v.b[0] + v.b[1] * v.b[1]) + (v.b[2] * v.b[2] + v.b[3] * v.b[3]);
        const float rs = rsqrtf(wave_sum(ss) * (1.f / DCH) + 1e-6f);
        const f32x4 vn0 = v.a * rs * *(const f32x4*)(vg + c), vn1 = v.b * rs * *(const f32x4*)(vg + c + 4);
        float* ov = p.out + O_CV_S + ((size_t)l * NS + s) * DCH + c; *(f32x4*)ov = vn0; *(f32x4*)(ov + 4) = vn1;
        const float w00 = cws[(size_t)g * 128 * 128], b0 = cbs[g * 128];
        const F8 uu = unpack8(*(const u32x4*)(Zgu + (size_t)row * DCH + c));
        *(u32x4*)(Yc + (size_t)row * DCH + c) = pack8(uu.a * (vn0 * w00 + b0), uu.b * (vn1 * w00 + b0));
    }
    if (bid >= 128) {
    const int et = (bid - 128) * 512 + tid, net = (G - 128) * 512;
    { const float* cw = p.in[10] + (size_t)l * 4 * DRNN; const float* cb = p.in[11] + (size_t)l * DRNN; const float* st = p.in[3] + (size_t)l * NS * 3 * DRNN;
      for (int idx = et; idx < (MPR / 8) * 128; idx += net) { const int r0 = (idx >> 7) * 8, c = (idx & 127) * 8, t0 = r0 & 2047;
          const f32x4 w00 = *(const f32x4*)(cw + c), w01 = *(const f32x4*)(cw + c + 4), w10 = *(const f32x4*)(cw + DRNN + c), w11 = *(const f32x4*)(cw + DRNN + c + 4);
          const f32x4 w20 = *(const f32x4*)(cw + 2 * DRNN + c), w21 = *(const f32x4*)(cw + 2 * DRNN + c + 4), w30 = *(const f32x4*)(cw + 3 * DRNN + c), w31 = *(const f32x4*)(cw + 3 * DRNN + c + 4);
          const f32x4 b0 = *(const f32x4*)(cb + c), b1 = *(const f32x4*)(cb + c + 4);
          F8 x1, x2, x3; const u32x4 zz = (u32x4){0u, 0u, 0u, 0u};
          x3 = unpack8(t0 >= 3 ? *(const u32x4*)(Zbx + (size_t)(r0 - 3) * DRNN + c) : zz); x2 = unpack8(t0 >= 2 ? *(const u32x4*)(Zbx + (size_t)(r0 - 2) * DRNN + c) : zz); x1 = unpack8(t0 >= 1 ? *(const u32x4*)(Zbx + (size_t)(r0 - 1) * DRNN + c) : zz);
#pragma unroll
          for (int i = 0; i < 8; ++i) { const F8 x0 = unpack8(*(const u32x4*)(Zbx + (size_t)(r0 + i) * DRNN + c));
              *(u32x4*)(Y0 + (size_t)(r0 + i) * DRNN + c) = pack8(b0 + w30 * x0.a + w20 * x1.a + w10 * x2.a + w00 * x3.a, b1 + w31 * x0.b + w21 * x1.b + w11 * x2.b + w01 * x3.b);
              x3 = x2; x2 = x1; x1 = x0; } }
      for (int idx = et; idx < NS * 128; idx += net) { const int row = MPR + (idx >> 7), c = (idx & 127) * 8;
          f32x4 s0 = *(const f32x4*)(cb + c), s1 = *(const f32x4*)(cb + c + 4);
          { const F8 x = unpack8(*(const u32x4*)(Zbx + (size_t)row * DRNN + c)); s0 += *(const f32x4*)(cw + 3 * DRNN + c) * x.a; s1 += *(const f32x4*)(cw + 3 * DRNN + c + 4) * x.b; }
          const float* sp = st + (size_t)(row - MPR) * 3 * DRNN + c;
#pragma unroll
          for (int k = 0; k < 3; ++k) { s0 += *(const f32x4*)(cw + k * DRNN + c) * *(const f32x4*)(sp + k * DRNN); s1 += *(const f32x4*)(cw + k * DRNN + c + 4) * *(const f32x4*)(sp + k * DRNN + 4); }
          *(u32x4*)(Y0 + (size_t)row * DRNN + c) = pack8(s0, s1); } }
    { const float* st = p.in[2] + (size_t)l * NS * 15 * DPOOL;
      for (int idx = et; idx < (MPR / 8) * 64; idx += net) { const int g = (idx >> 6) & 3, rb = ((idx >> 8) << 2) + ((idx >> 4) & 3), c = g * 128 + (idx & 15) * 8, w = 2 << g, r0 = rb * 8, t0 = r0 & 2047;
          f32x4 s0 = (f32x4){0.f, 0.f, 0.f, 0.f}, s1 = s0;
#pragma unroll
          for (int j = 1; j < 16; ++j) if (j < w && t0 >= j) { const F8 x = unpack8(*(const u32x4*)(Za + (size_t)(r0 - j) * DPOOL + c)); s0 += x.a; s1 += x.b; }
#pragma unroll
          for (int i = 0; i < 8; ++i) { const F8 cur = unpack8(*(const u32x4*)(Za + (size_t)(r0 + i) * DPOOL + c)); s0 += cur.a; s1 += cur.b;
              const int t = t0 + i; const float ic = 1.f / (float)(t + 1 < w ? t + 1 : w);
              *(u32x4*)(Yd + (size_t)(r0 + i) * DPOOL + c) = pack8(s0 * ic - cur.a, s1 * ic - cur.b);
              if (t >= w - 1) { const F8 old = unpack8(*(const u32x4*)(Za + (size_t)(r0 + i - (w - 1)) * DPOOL + c)); s0 -= old.a; s1 -= old.b; } } }
      for (int idx = et; idx < NS * 64; idx += net) { const int row = MPR + (idx >> 6), c = (idx & 63) * 8, w = 2 << (c >> 7);
          const F8 cur = unpack8(*(const u32x4*)(Za + (size_t)row * DPOOL + c)); f32x4 s0 = cur.a, s1 = cur.b;
          const float* sp = st + (size_t)(row - MPR) * 15 * DPOOL + c;
          for (int j = 1; j < w; ++j) { s0 += *(const f32x4*)(sp + (15 - j) * DPOOL); s1 += *(const f32x4*)(sp + (15 - j) * DPOOL + 4); }
          const float ic = 1.f / (float)w;
          *(u32x4*)(Yd + (size_t)row * DPOOL + c) = pack8(s0 * ic - cur.a, s1 * ic - cur.b); } }
    }
    const int gt = bid * 512 + tid, ngt = G * 512;
    { const float* sp = p.in[2] + (size_t)l * NS * 15 * DPOOL; float* o = p.out + O_POOL_S + (size_t)l * NS * 15 * DPOOL;
      for (int idx = gt; idx < NS * 14 * (DPOOL / 4); idx += ngt) { const int c = (idx & 127) * 4, r = (idx >> 7) % 14, s = (idx >> 7) / 14;
          *(f32x4*)(o + ((size_t)s * 15 + r) * DPOOL + c) = *(const f32x4*)(sp + ((size_t)s * 15 + r + 1) * DPOOL + c); } }
    { const float* sp = p.in[3] + (size_t)l * NS * 3 * DRNN; float* o = p.out + O_RC_S + (size_t)l * NS * 3 * DRNN;
      for (int idx = gt; idx < NS * 2 * (DRNN / 4); idx += ngt) { const int c = (idx & 255) * 4, r = (idx >> 8) & 1, s = idx >> 9;
          *(f32x4*)(o + ((size_t)s * 3 + r) * DRNN + c) = *(const f32x4*)(sp + ((size_t)s * 3 + r + 1) * DRNN + c); } }
    { const float* sp = p.in[5] + (size_t)l * NS * 2 * DFF; float* o = p.out + O_FF_S + (size_t)l * NS * 2 * DFF;
      for (int idx = gt; idx < NS * (DFF / 4); idx += ngt) { const int c = (idx % 768) * 4, s = idx / 768;
          *(f32x4*)(o + ((size_t)s * 2) * DFF + c) = *(const f32x4*)(sp + ((size_t)s * 2 + 1) * DFF + c); } }
}

__device__ __forceinline__ void phase_scan(const Params& p, int l, LAS unsigned char* lds, int bid, int G, const int wvid) {
    int tid = TIDX; asm volatile("" : "+v"(tid));
    const bf16_t* LA = (const bf16_t*)(p.ws + WS_Z) + UE; const bf16_t* BV = (const bf16_t*)(p.ws + WS_Z) + 5 * UE; const bf16_t* GB = (const bf16_t*)(p.ws + WS_Z) + 3 * UE;
    bf16_t* Y0 = (bf16_t*)(p.ws + WS_Y);
    LAS float* sP = (LAS float*)lds; LAS float* sH = sP + 4096; LAS float* sC = sH + 4096; LAS float* sPg = sC + 4096; LAS float* sHg = sPg + 512;
    for (int item = bid; item < 256; item += G) {
        const int b = item >> 5, c0 = (item & 31) * 32, seg = tid >> 2, lg = tid & 3;
        const size_t base = ((size_t)b * SEQ + seg * 16) * DRNN + c0 + lg * 8;
        f32x4 P0 = (f32x4){1.f, 1.f, 1.f, 1.f}, P1 = P0, h0 = (f32x4){0.f, 0.f, 0.f, 0.f}, h1 = h0;
#pragma unroll
        for (int t = 0; t < 16; ++t) { const F8 la = unpack8(*(const u32x4*)(LA + base + (size_t)t * DRNN)), bv = unpack8(*(const u32x4*)(BV + base + (size_t)t * DRNN));
            f32x4 a0, a1;
#pragma unroll
            for (int e = 0; e < 4; ++e) { a0[e] = __builtin_amdgcn_exp2f(1.442695041f * la.a[e]); a1[e] = __builtin_amdgcn_exp2f(1.442695041f * la.b[e]); }
            h0 = a0 * h0 + bv.a; h1 = a1 * h1 + bv.b; P0 *= a0; P1 *= a1; }
        { const int o = seg * 32 + lg * 8; *(LAS f32x4*)(sP + o) = P0; *(LAS f32x4*)(sP + o + 4) = P1; *(LAS f32x4*)(sH + o) = h0; *(LAS f32x4*)(sH + o + 4) = h1; }
        __syncthreads();
        const int ch = tid & 31, sg = tid >> 5;
        { float Pg = 1.f, hg = 0.f;
#pragma unroll
          for (int k = 0; k < 8; ++k) { const float pp = sP[(sg * 8 + k) * 32 + ch], hh = sH[(sg * 8 + k) * 32 + ch]; hg = pp * hg + hh; Pg *= pp; }
          sPg[sg * 32 + ch] = Pg; sHg[sg * 32 + ch] = hg; }
        __syncthreads();
        { float carry = 0.f;
          for (int k = 0; k < sg; ++k) carry = sPg[k * 32 + ch] * carry + sHg[k * 32 + ch];
#pragma unroll
          for (int k = 0; k < 8; ++k) { const int o = (sg * 8 + k) * 32 + ch; sC[o] = carry; carry = sP[o] * carry + sH[o]; }
          if (sg == 15) p.out[O_H_P + ((size_t)l * NB + b) * DRNN + c0 + ch] = carry; }
        __syncthreads();
        { const int o = seg * 32 + lg * 8; h0 = *(LAS f32x4*)(sC + o); h1 = *(LAS f32x4*)(sC + o + 4); }
#pragma unroll
        for (int t = 0; t < 16; ++t) { const F8 la = unpack8(*(const u32x4*)(LA + base + (size_t)t * DRNN)), bv = unpack8(*(const u32x4*)(BV + base + (size_t)t * DRNN)), gt = unpack8(*(const u32x4*)(GB + base + (size_t)t * DRNN));
            f32x4 a0, a1;
#pragma unroll
            for (int e = 0; e < 4; ++e) { a0[e] = __builtin_amdgcn_exp2f(1.442695041f * la.a[e]); a1[e] = __builtin_amdgcn_exp2f(1.442695041f * la.b[e]); }
            h0 = a0 * h0 + bv.a; h1 = a1 * h1 + bv.b;
            *(u32x4*)(Y0 + base + (size_t)t * DRNN) = pack8(gt.a * h0, gt.b * h1); }
        __syncthreads();
    }
    { const float* hin = p.in[4] + (size_t)l * NS * DRNN; float* oh = p.out + O_H_S + (size_t)l * NS * DRNN;
      for (int idx = bid * 512 + tid; idx < NS * DRNN; idx += G * 512) { const size_t off = (size_t)MPR * DRNN + idx;
          const float a = __expf(bf2f(LA[off])), h = a * hin[idx] + bf2f(BV[off]); oh[idx] = h; Y0[off] = f2bf(bf2f(GB[off]) * h); } }
}

__device__ __forceinline__ void phase_merge(const Params& p, int bid, int NG, const int wvid) {
    const bf16_t* G = (const bf16_t*)(p.ws + WS_Z); bf16_t* XN = (bf16_t*)(p.ws + WS_XN);
    int tid = TIDX; asm volatile("" : "+v"(tid));
    for (int idx = bid * 512 + tid; idx < MPAD * 128; idx += NG * 512) { const int row = idx >> 7, c = (idx & 127) * 8;
        const bf16_t* gr = G + (size_t)row * 3072 + c; const F8 a = unpack8(*(const u32x4*)gr), b = unpack8(*(const u32x4*)(gr + 1024)), d = unpack8(*(const u32x4*)(gr + 2048));
        *(u32x4*)(XN + (size_t)row * DM + c) = pack8(a.a + b.a + d.a, a.b + b.b + d.b); }
}

__device__ __forceinline__ void phase_final(const Params& p, int bid, int G, const int wvid) {
    int tid = TIDX; asm volatile("" : "+v"(tid));
    const int wave = tid >> 6, lane = tid & 63; const float* g = p.in[30];
    for (int row = MPR + bid * 8 + wave; row < MROWS; row += G * 8) {
        f32x4* xr = (f32x4*)(p.out + (size_t)row * DM) + lane; f32x4 v[4]; float s = 0.f;
#pragma unroll
        for (int j = 0; j < 4; ++j) { v[j] = xr[64 * j]; s += (v[j][0] * v[j][0] + v[j][1] * v[j][1]) + (v[j][2] * v[j][2] + v[j][3] * v[j][3]); }
        const float rstd = rsqrtf(wave_sum(s) * (1.f / DM) + 1e-6f); const f32x4* gr = (const f32x4*)g + lane;
#pragma unroll
        for (int j = 0; j < 4; ++j) xr[64 * j] = v[j] * rstd * gr[64 * j];
    }
}


#define XB_TMO      128
#define XB_XCNT(j)  (256  + 64 * (j))
#define XB_XSUB(j)  (1280 + 64 * (j))
#define XB_XGEN(j)  (2304 + 64 * (j))
#define XB_TOP      3328
#define XB_TOPGEN   3392
#define XCD_BAR_WORDS 3456
#define XB_SPIN_CAP (1u << 18)
__device__ __forceinline__ unsigned xb_ld(unsigned* p)              { return __hip_atomic_load(p, __ATOMIC_RELAXED, __HIP_MEMORY_SCOPE_AGENT); }
__device__ __forceinline__ unsigned xb_add(unsigned* p, unsigned v) { return __hip_atomic_fetch_add(p, v, __ATOMIC_RELAXED, __HIP_MEMORY_SCOPE_AGENT); }
__device__ __forceinline__ unsigned xb_xcc_id() { return (unsigned)__builtin_amdgcn_s_getreg((3 << 11) | 20) & 0xFu; }
#define XB_SPIN(cond, bar) do { unsigned _sp = 0; while (cond) { __builtin_amdgcn_s_sleep(1); \
    if ((++_sp & 255u) == 0u) { if (xb_ld(&(bar)[XB_TMO])) break; if (_sp > XB_SPIN_CAP) { atomicAdd(&(bar)[XB_TMO], 1u); break; } } } } while (0)
__device__ __forceinline__ void xcd_barrier_complete(unsigned* bar, unsigned x, unsigned G, unsigned& nloc, unsigned& nx) {
    unsigned sum, cnt, mine, sp = 0u;
    for (;;) {
        sum = 0u; cnt = 0u; mine = 0u;
#pragma unroll
        for (unsigned j = 0; j < 16; ++j) { const unsigned c = xb_ld(&bar[XB_XCNT(j)]); sum += c; cnt += (c > 0u) ? 1u : 0u; mine = (j == x) ? c : mine; }
        if (sum == G) break;
        __builtin_amdgcn_s_sleep(1);
        if ((++sp & 255u) == 0u) { if (xb_ld(&bar[XB_TMO])) break; if (sp > XB_SPIN_CAP) { atomicAdd(&bar[XB_TMO], 1u); break; } }
    }
    nloc = mine > 0u ? mine : 1u; nx = cnt > 0u ? cnt : 1u;
}
__device__ __forceinline__ void xcd_barrier(unsigned* bar, volatile LAS unsigned* st, unsigned G, const int wvid) {
    asm volatile("s_waitcnt vmcnt(0)" ::: "memory");
    __syncthreads();
    if (TIDX == 0) {
        const unsigned x = xb_xcc_id();
        __builtin_amdgcn_s_waitcnt(0);
        unsigned nloc = st[0], nx = st[1];
        if (nloc == 0u) { xcd_barrier_complete(bar, x, G, nloc, nx); st[0] = nloc; st[1] = nx; }
        const unsigned old = xb_add(&bar[XB_XSUB(x)], 1u);
        const unsigned gen = old / nloc;
        if (old + 1u == (gen + 1u) * nloc) {
            __builtin_amdgcn_fence(__ATOMIC_RELEASE, "agent");
            asm volatile("s_waitcnt vmcnt(0)" ::: "memory");
            const unsigned og = xb_add(&bar[XB_TOP], 1u);
            const unsigned tg = og / nx;
            if (og + 1u == (tg + 1u) * nx) xb_add(&bar[XB_TOPGEN], 1u);
            else XB_SPIN(xb_ld(&bar[XB_TOPGEN]) == tg, bar);
            __builtin_amdgcn_fence(__ATOMIC_ACQUIRE, "agent");
            xb_add(&bar[XB_XGEN(x)], 1u);
            asm volatile("s_waitcnt vmcnt(0)" ::: "memory");
        } else {
            XB_SPIN(xb_ld(&bar[XB_XGEN(x)]) == gen, bar);
            __builtin_amdgcn_fence(__ATOMIC_ACQUIRE, "agent");
            asm volatile("s_waitcnt vmcnt(0)" ::: "memory");
        }
    }
    __syncthreads();
}

__global__ void __launch_bounds__(512, 2) mega(Params pk) {
    extern __shared__ __attribute__((aligned(16))) unsigned char shm[];
    LAS unsigned char* lds = (LAS unsigned char*)shm;
    cg::grid_group grid = cg::this_grid();
    const int wvid = __builtin_amdgcn_readfirstlane((int)threadIdx.x >> 6);
    volatile LAS unsigned* bst = (volatile LAS unsigned*)(lds + 131072 + 1024);
    if (TIDX < 2) bst[TIDX] = 0u;
    if (blockIdx.x == 0) { for (int i = TIDX; i < XCD_BAR_WORDS; i += 512) ((unsigned*)(pk.ws + WS_BAR))[i] = 0u;
                           for (int i = TIDX; i < CNT_WORDS; i += 512) ((unsigned*)(pk.ws + WS_CNT))[i] = 0u; }
    __syncthreads();
    bool posted = false;
    for (int ph = pk.ph_lo; ph < pk.ph_hi; ++ph) {
        Params p = pk; int G = gridDim.x, bid = blockIdx.x;
        asm volatile("" : "+s"(p.ws), "+s"(p.out), "+s"(G), "+s"(bid));
        bf16_t* XN = (bf16_t*)(p.ws + WS_XN); bf16_t* Z = (bf16_t*)(p.ws + WS_Z); bf16_t* Y0 = (bf16_t*)(p.ws + WS_Y); bf16_t* W = (bf16_t*)(p.ws + WS_W); bf16_t* H = (bf16_t*)(p.ws + WS_H);
        if (ph == NPH - 1) { phase_final(p, bid, G, wvid); }
        else {
            const int l = ph / PH_PER_LAYER, k = ph % PH_PER_LAYER;
            const float* xp = l == 0 ? p.in[0] : p.out; const float* xs = l == 0 ? p.in[1] : p.out + (size_t)MPR * DM;
            pg8::Order S; pg8::Gemm g;
            for (int rep = ((REPMASK >> k) & 1u) ? 2 : 1; rep > 0; --rep)
            switch (k) {
            case 0: phase_prep(p, l, lds, xp, xs, bid, G, wvid); break;
            case 1: { S.init(NTM, ZC / 256, G, bid, 0); g = {XN, W + W_IN, DM, DM, DM}; EpiZ E{Z, p.out, l}; pg8::gemm_phase(lds, g, S, E, wvid); } break;
            case 2: phase_mix(p, l, lds, bid, G, wvid); break;
            case 3: { S.init(64, 8, G, bid, 1); g = {Y0, W + W_RI, DRNN, 256, 256};
                      EpiRI E{Y0, Z + UE, Z + 5 * UE, p.in[13] + (size_t)l * DRNN, p.in[15] + (size_t)l * DRNN, (const float*)(p.ws + WS_SP)}; pg8::gemm_phase(lds, g, S, E, wvid);
                      sample_gemm<true>(lds, Y0 + (size_t)MPR * DRNN, DRNN, W + W_RI, 256, 256, 64, bid, G, E, wvid); } break;
            case 4: phase_scan(p, l, lds, bid, G, wvid); break;
            case 5: { S.init(64, 12, G, bid, 0); g = {XN, W + W_IN + (size_t)ZC * DM, DM, DM, DM}; EpiG E{Z}; pg8::gemm_phase(lds, g, S, E, wvid);
                      sample_gemm<false>(lds, XN + (size_t)MPR * DM, DM, W + W_IN + (size_t)ZC * DM, DM, DM, 3072 / 16, bid, G, E, wvid); } break;
            case 6: { { S.init(64, 4, G, bid, 0); g = {Y0 + 2 * UE, W + W_PA, DPOOL, DPOOL, DPOOL}; EpiP E{Z, XN, 0, 1}; pg8::gemm_phase(lds, g, S, E, wvid);
                        sample_gemm<false>(lds, Y0 + 2 * UE + (size_t)MPR * DPOOL, DPOOL, W + W_PA, DPOOL, DPOOL, 64, bid, G, E, wvid); }
                      { S.init(64, 4, G, bid, 0); g = {Y0, W + W_PB, DRNN, DRNN, DRNN}; EpiP E{Z, XN, 1024, 0}; pg8::gemm_phase(lds, g, S, E, wvid);
                        sample_gemm<false>(lds, Y0 + (size_t)MPR * DRNN, DRNN, W + W_PB, DRNN, DRNN, 64, bid, G, E, wvid); }
                      { S.init(64, 4, G, bid, 0); g = {Y0 + 3 * UE, W + W_PC, DCH, DCH, DCH}; EpiP E{Z, XN, 2048, 0}; pg8::gemm_phase(lds, g, S, E, wvid);
                        sample_gemm<false>(lds, Y0 + 3 * UE + (size_t)MPR * DCH, DCH, W + W_PC, DCH, DCH, 64, bid, G, E, wvid); } } break;
            case 7: break;
            case 8: { S.init(64, 4, G, bid, 0); g = {XN, W + W_O, DM, DM, DM}; EpiX E{xp, xs, p.out, 1, (float*)(p.ws + WS_SSP), (unsigned*)(p.ws + WS_CNT) + (l * 2) * 64 * 16, p.in[24] + (size_t)l * DM, XN, lds}; pg8::gemm_phase(lds, g, S, E, wvid);
                      sample_gemm<false>(lds, XN + (size_t)MPR * DM, DM, W + W_O, DM, DM, 64, bid, G, E, wvid); } break;
            case 9: { int tid = TIDX; asm volatile("" : "+v"(tid)); const int wave = tid >> 6, lane = tid & 63; rms_rows(p.out, p.out + (size_t)MPR * DM, p.in[24] + (size_t)l * DM, XN, bid * 8 + wave, G * 8, lane, MPR); } break;
            case 10: { S.init(64, 12, G, bid, 0); g = {XN, W + W_G, DM, DM, DM}; EpiGpre E{Z, p.out, l}; pg8::gemm_phase(lds, g, S, E, wvid);
                       sample_gemm<false>(lds, XN + (size_t)MPR * DM, DM, W + W_G, DM, DM, 192, bid, G, E, wvid); } break;
            case 11: { S.init(64, 12, G, bid, 0); g = {XN, W + W_U, DM, DM, DM};
                       EpiH E{Z, H, p.in[27] + (size_t)l * 3 * DFF, p.in[28] + (size_t)l * DFF, p.in[5] + (size_t)l * NS * 2 * DFF}; pg8::gemm_phase(lds, g, S, E, wvid);
                       sample_gemm<false>(lds, XN + (size_t)MPR * DM, DM, W + W_U, DM, DM, 192, bid, G, E, wvid); } break;
            default: { S.init(64, 4, G, bid, 0); g = {H, W + W_D, DFF, DFF, DFF}; EpiX E{p.out, p.out + (size_t)MPR * DM, p.out, l + 1 < NLAYER ? 1 : 2, (float*)(p.ws + WS_SSP), (unsigned*)(p.ws + WS_CNT) + (l * 2 + 1) * 64 * 16, l + 1 < NLAYER ? p.in[6] + (size_t)(l + 1) * DM : p.in[30], XN, lds}; pg8::gemm_phase(lds, g, S, E, wvid);
                       sample_gemm<false>(lds, H + (size_t)MPR * DFF, DFF, W + W_D, DFF, DFF, 64, bid, G, E, wvid); } break;
            }
        }
        if (ph + 1 < pk.ph_hi && (ph % PH_PER_LAYER) != 7) {
            if (!posted) {
                grid.sync(); posted = true;
                if (TIDX == 0) (void)xb_add(&((unsigned*)(pk.ws + WS_BAR))[XB_XCNT(xb_xcc_id())], 1u);
            } else xcd_barrier((unsigned*)(pk.ws + WS_BAR), bst, (unsigned)gridDim.x, wvid);
            for (int e = 0; e < EXTRA_SYNCS; ++e) xcd_barrier((unsigned*)(pk.ws + WS_BAR), bst, (unsigned)gridDim.x, wvid);
        }
    }
}

extern "C" void kernel_launch(void* const* d_in, const int* in_sizes, int n_in, void* d_out, int out_size, void* d_ws, size_t ws_size, hipStream_t stream) {
    static int grid = 0;
    if (grid == 0) {
        int dev = 0, cus = 0, per_cu = 0;
        hipGetDevice(&dev);
        hipDeviceGetAttribute(&cus, hipDeviceAttributeMultiprocessorCount, dev);
        if (hipFuncSetAttribute((const void*)mega, hipFuncAttributeMaxDynamicSharedMemorySize, LDS_BYTES) != hipSuccess) fprintf(stderr, "kernel_launch: hipFuncSetAttribute failed\n");
        if (hipOccupancyMaxActiveBlocksPerMultiprocessor(&per_cu, (const void*)mega, 512, LDS_BYTES) != hipSuccess || per_cu < 1) { fprintf(stderr, "kernel_launch: occupancy query says %d blocks per CU\n", per_cu); per_cu = 1; }
        (void)hipGetLastError();
        grid = cus;
        if (n_in != 31 || ws_size < WS_END) fprintf(stderr, "kernel_launch: unexpected n_in %d / ws_size %zu (need %zu)\n", n_in, ws_size, (size_t)WS_END);
    }
    Params p{};
    for (int i = 0; i < 31; ++i) p.in[i] = (const float*)d_in[i];
    p.out = (float*)d_out; p.ws = (unsigned char*)d_ws; p.ph_lo = 0; p.ph_hi = NPH;
    void* args[] = {&p};
    hipError_t e = hipLaunchCooperativeKernel((const void*)mega, dim3(grid), dim3(512), args, LDS_BYTES, stream);
    if (e != hipSuccess) fprintf(stderr, "cooperative launch failed: %s (grid %d)\n", hipGetErrorString(e), grid);
}
```
